# Optimizing an MI355X kernel written in HIP

```python
import jax, jax.numpy as jnp
from jax import lax
import numpy as np

D_MODEL = 1024
BATCH = 32
SEQ = 2048
DEPTH = 1
DEC_BATCH = 2
DEC_SEQ = 16384
PAST_LEN = 128

N_Q_HEADS = 8
N_KV_HEADS = 2
HEAD_DIM = 64
ATTN_WIDTH = N_Q_HEADS * HEAD_DIM
KV_WIDTH = N_KV_HEADS * HEAD_DIM
WINDOW = 128
BLOCK = 128
ROPE_THETA = 10000.0
LRU_WIDTH = 512
LRU_BLOCKS = 8
LRU_BLOCK_DIM = LRU_WIDTH // LRU_BLOCKS
LRU_C = 8.0
CONV_WIDTH = 4
CONV_LEFT = 2
MIX_WIDTH = ATTN_WIDTH + LRU_WIDTH
IN_WIDTH = ATTN_WIDTH + 2 * KV_WIDTH + 2 * LRU_WIDTH
PEER_HEADS = 8
PEER_NKEYS = 128
PEER_EXPERTS = PEER_NKEYS * PEER_NKEYS
PEER_DKEY = 256
PEER_HALF = PEER_DKEY // 2
PEER_TOPK = 16
PEER_CHUNK = 128
PLE_DIM = 256
EPS = 1e-6

kernel_name = 'hymba_swa_rglru_peer_encoder'


def rms_norm(x, g):
    xf = x.astype(jnp.float32)
    y = xf * lax.rsqrt(jnp.mean(xf * xf, axis=-1, keepdims=True) + EPS)
    return (y * g.astype(jnp.float32)).astype(x.dtype)


def apply_rope(t):
    seq = t.shape[1]
    half = HEAD_DIM // 2
    inv_freq = ROPE_THETA ** (-jnp.arange(half, dtype=jnp.float32) / half)
    ang = jnp.arange(seq, dtype=jnp.float32)[:, None] * inv_freq[None, :]
    cos = jnp.cos(ang)[None, :, None, :]
    sin = jnp.sin(ang)[None, :, None, :]
    tf = t.astype(jnp.float32)
    t1, t2 = tf[..., :half], tf[..., half:]
    return jnp.concatenate([t1 * cos - t2 * sin, t2 * cos + t1 * sin], axis=-1).astype(t.dtype)


def banded_window_attention(q, k, v, sink):
    b, s = q.shape[0], q.shape[1]
    nb = s // BLOCK
    grp = N_Q_HEADS // N_KV_HEADS
    qb = q.astype(jnp.float32).reshape(b, nb, BLOCK, N_KV_HEADS, grp, HEAD_DIM)

    def bands(t):
        tp = jnp.pad(t.astype(jnp.float32), ((0, 0), (BLOCK, BLOCK), (0, 0), (0, 0)))
        tp = tp.reshape(b, nb + 2, BLOCK, N_KV_HEADS, HEAD_DIM)
        return jnp.concatenate([tp[:, :-2], tp[:, 1:-1], tp[:, 2:]], axis=2)

    kb = bands(k)
    vb = bands(v)
    scores = jnp.einsum('bnqkgd,bnckd->bnkgqc', qb, kb) * (HEAD_DIM ** -0.5)
    qpos = jnp.arange(nb)[:, None] * BLOCK + jnp.arange(BLOCK)[None, :]
    kpos = (jnp.arange(nb)[:, None] - 1) * BLOCK + jnp.arange(3 * BLOCK)[None, :]
    valid = ((jnp.abs(qpos[:, :, None] - kpos[:, None, :]) <= WINDOW)
             & (kpos[:, None, :] >= 0) & (kpos[:, None, :] < s))
    scores = jnp.where(valid[None, :, None, None], scores, -jnp.inf)
    sink_l = sink.astype(jnp.float32).reshape(N_KV_HEADS, grp)[None, None, :, :, None, None]
    m = jnp.maximum(jnp.max(scores, axis=-1, keepdims=True), sink_l)
    e = jnp.exp(scores - m)
    denom = jnp.sum(e, axis=-1, keepdims=True) + jnp.exp(sink_l - m)
    out = jnp.einsum('bnkgqc,bnckd->bnqkgd', e / denom, vb)
    return out.reshape(b, s, ATTN_WIDTH)


def centred_dwconv(x, w, bias):
    y = lax.conv_general_dilated(
        x, w[:, None, :].astype(x.dtype), window_strides=(1,),
        padding=[(CONV_LEFT, CONV_WIDTH - 1 - CONV_LEFT)],
        dimension_numbers=('NWC', 'WIO', 'NWC'), feature_group_count=LRU_WIDTH)
    return y + bias.astype(x.dtype)


def linear_combine(left, right):
    a_l, h_l = left
    a_r, h_r = right
    return a_l * a_r, a_r * h_l + h_r


def rglru_scan(xc, wa, ba, wx, bx, lam):
    b, s, _ = xc.shape
    xf = xc.astype(jnp.float32)
    xb = xf.reshape(b, s, LRU_BLOCKS, LRU_BLOCK_DIM)
    gate_r = jax.nn.sigmoid(jnp.einsum('bshi,hij->bshj', xb, wa.astype(jnp.float32)).reshape(b, s, LRU_WIDTH)
                            + ba.astype(jnp.float32))
    gate_i = jax.nn.sigmoid(jnp.einsum('bshi,hij->bshj', xb, wx.astype(jnp.float32)).reshape(b, s, LRU_WIDTH)
                            + bx.astype(jnp.float32))
    log_a = LRU_C * gate_r * jax.nn.log_sigmoid(lam.astype(jnp.float32))
    a = jnp.exp(log_a)
    u = jnp.sqrt(-jnp.expm1(2.0 * log_a)) * (gate_i * xf)
    _, h = lax.associative_scan(linear_combine, (a, u), axis=1)
    return h


def peer_ffn(x, wq, keys, u_tab, v_tab):
    b, s, d = x.shape
    xt = x.reshape(-1, PEER_CHUNK, d)

    def retrieve(xc):
        q = (xc @ wq).astype(jnp.float32).reshape(PEER_CHUNK, PEER_HEADS, 2, PEER_HALF)
        sub = jnp.einsum('thpd,hpkd->thpk', q, keys.astype(jnp.float32))
        sub_s, sub_i = lax.top_k(sub, PEER_TOPK)
        cand_s = (sub_s[:, :, 0, :, None] + sub_s[:, :, 1, None, :]).reshape(PEER_CHUNK, PEER_HEADS, -1)
        cand_i = (sub_i[:, :, 0, :, None] * PEER_NKEYS + sub_i[:, :, 1, None, :]).reshape(PEER_CHUNK, PEER_HEADS, -1)
        best_s, pos = lax.top_k(cand_s, PEER_TOPK)
        idx = jnp.take_along_axis(cand_i, pos, axis=-1)
        g = jax.nn.softmax(best_s, axis=-1)
        u_e = jnp.take(u_tab, idx, axis=0).astype(jnp.float32)
        act = jax.nn.gelu(jnp.einsum('td,thkd->thk', xc.astype(jnp.float32), u_e))
        v_e = jnp.take(v_tab, idx, axis=0).astype(jnp.float32)
        return jnp.einsum('thk,thkd->td', g * act, v_e).astype(xc.dtype)

    return lax.map(retrieve, xt).reshape(b, s, d)


def setup_inputs(seed: int = 0) -> dict:
    key = jax.random.key(seed)
    ks = jax.random.split(key, 26)
    nrm = jax.random.normal
    f32 = jnp.float32
    uu = jax.random.uniform(ks[13], (DEPTH, 2, LRU_WIDTH), f32, minval=0.9, maxval=0.999)
    a0 = uu ** (1.0 / LRU_C)
    lru_lambda = jnp.log(a0) - jnp.log1p(-a0)
    return {
        'x_prompt': nrm(ks[0], (BATCH, SEQ, D_MODEL), f32),
        'x_sample': nrm(ks[1], (DEC_BATCH, DEC_SEQ, D_MODEL), f32),
        'p_prompt': nrm(ks[2], (DEPTH, BATCH, SEQ, PLE_DIM), f32),
        'p_sample': nrm(ks[3], (DEPTH, DEC_BATCH, DEC_SEQ, PLE_DIM), f32),
        'mix_norm_g': 1.0 + 0.05 * nrm(ks[4], (DEPTH, D_MODEL), f32),
        'w_in': nrm(ks[5], (DEPTH, D_MODEL, IN_WIDTH), f32) * D_MODEL ** -0.5,
        'attn_sink': 0.5 * nrm(ks[6], (DEPTH, N_Q_HEADS), f32),
        'conv_w': 0.5 * nrm(ks[7], (DEPTH, CONV_WIDTH, LRU_WIDTH), f32),
        'conv_b': 0.01 * nrm(ks[8], (DEPTH, LRU_WIDTH), f32),
        'lru_wa': nrm(ks[9], (DEPTH, 2, LRU_BLOCKS, LRU_BLOCK_DIM, LRU_BLOCK_DIM), f32) * LRU_BLOCK_DIM ** -0.5,
        'lru_ba': 0.01 * nrm(ks[10], (DEPTH, 2, LRU_WIDTH), f32),
        'lru_wx': nrm(ks[11], (DEPTH, 2, LRU_BLOCKS, LRU_BLOCK_DIM, LRU_BLOCK_DIM), f32) * LRU_BLOCK_DIM ** -0.5,
        'lru_bx': 0.01 * nrm(ks[12], (DEPTH, 2, LRU_WIDTH), f32),
        'lru_lambda': lru_lambda,
        'attn_out_norm_g': 1.0 + 0.05 * nrm(ks[14], (DEPTH, ATTN_WIDTH), f32),
        'lru_out_norm_g': 1.0 + 0.05 * nrm(ks[15], (DEPTH, LRU_WIDTH), f32),
        'w_out': nrm(ks[16], (DEPTH, MIX_WIDTH, D_MODEL), f32) * MIX_WIDTH ** -0.5,
        'ffn_norm_g': 1.0 + 0.05 * nrm(ks[17], (DEPTH, D_MODEL), f32),
        'peer_wq': nrm(ks[18], (DEPTH, D_MODEL, PEER_HEADS * PEER_DKEY), f32) * D_MODEL ** -0.5,
        'peer_keys': nrm(ks[19], (DEPTH, PEER_HEADS, 2, PEER_NKEYS, PEER_HALF), f32) * PEER_HALF ** -0.5,
        'peer_u': nrm(ks[20], (DEPTH, PEER_EXPERTS, D_MODEL), f32) * D_MODEL ** -0.5,
        'peer_v': 0.3 * nrm(ks[21], (DEPTH, PEER_EXPERTS, D_MODEL), f32),
        'ple_norm_g': 1.0 + 0.05 * nrm(ks[22], (DEPTH, D_MODEL), f32),
        'ple_w_gate': nrm(ks[23], (DEPTH, D_MODEL, D_MODEL), f32) * D_MODEL ** -0.5,
        'ple_w_proj': nrm(ks[24], (DEPTH, PLE_DIM, D_MODEL), f32) * PLE_DIM ** -0.5,
        'final_norm_g': 1.0 + 0.05 * nrm(ks[25], (D_MODEL,), f32),
    }


def reference(x_prompt, x_sample, p_prompt, p_sample, mix_norm_g, w_in, attn_sink, conv_w, conv_b,
              lru_wa, lru_ba, lru_wx, lru_bx, lru_lambda, attn_out_norm_g, lru_out_norm_g, w_out,
              ffn_norm_g, peer_wq, peer_keys, peer_u, peer_v, ple_norm_g, ple_w_gate, ple_w_proj,
              final_norm_g):
    o1 = ATTN_WIDTH
    o2 = o1 + KV_WIDTH
    o3 = o2 + KV_WIDTH
    o4 = o3 + LRU_WIDTH

    def encoder(x, p):
        h = x
        b, s, _ = x.shape
        for l in range(DEPTH):
            xn = rms_norm(h, mix_norm_g[l])
            z = xn @ w_in[l]
            q, k, v, xr, gr = jnp.split(z, [o1, o2, o3, o4], axis=-1)
            q = apply_rope(q.reshape(b, s, N_Q_HEADS, HEAD_DIM))
            k = apply_rope(k.reshape(b, s, N_KV_HEADS, HEAD_DIM))
            v = v.reshape(b, s, N_KV_HEADS, HEAD_DIM)
            attn = banded_window_attention(q, k, v, attn_sink[l]).astype(h.dtype)
            xc = centred_dwconv(xr, conv_w[l], conv_b[l])
            h_fwd = rglru_scan(xc, lru_wa[l, 0], lru_ba[l, 0], lru_wx[l, 0], lru_bx[l, 0], lru_lambda[l, 0])
            h_bwd = jnp.flip(rglru_scan(jnp.flip(xc, axis=1), lru_wa[l, 1], lru_ba[l, 1], lru_wx[l, 1],
                                        lru_bx[l, 1], lru_lambda[l, 1]), axis=1)
            lru = (jax.nn.gelu(gr.astype(jnp.float32)) * (h_fwd + h_bwd)).astype(h.dtype)
            merged = jnp.concatenate([rms_norm(attn, attn_out_norm_g[l]), rms_norm(lru, lru_out_norm_g[l])], axis=-1)
            h = h + merged @ w_out[l]
            h = h + peer_ffn(rms_norm(h, ffn_norm_g[l]), peer_wq[l], peer_keys[l], peer_u[l], peer_v[l])
            gate = jax.nn.sigmoid(rms_norm(h, ple_norm_g[l]) @ ple_w_gate[l])
            h = h + gate * (p[l] @ ple_w_proj[l])
        return rms_norm(h, final_norm_g)

    y_prompt = encoder(x_prompt, p_prompt)
    y_sample = encoder(x_sample, p_sample)
    return (y_prompt, y_sample)
```

```cpp
#include <hip/hip_runtime.h>
#include <hip/hip_cooperative_groups.h>
#include <cstdio>
#include <cstdint>
namespace cg = cooperative_groups;

typedef unsigned short bf16_t;
typedef __bf16 bf16x8 __attribute__((ext_vector_type(8)));
typedef __bf16 bf16x2v __attribute__((ext_vector_type(2)));
typedef float f32x4 __attribute__((ext_vector_type(4)));
typedef float f32x16 __attribute__((ext_vector_type(16)));

constexpr int NT = 98304;
constexpr int NTP = 65536;
constexpr float EPS = 1e-6f;
constexpr int LDS_BYTES = 147456;
constexpr int NTHREADS = 512;

constexpr size_t MiB = 1ull << 20;
constexpr size_t OFF_R0 = 0;
constexpr size_t OFF_R1 = 192 * MiB;
constexpr size_t OFF_R2 = 576 * MiB;
constexpr size_t OFF_R3 = 768 * MiB;
constexpr size_t OFF_WIN = OFF_R3;
constexpr size_t OFF_WOUT = OFF_WIN + 1792ull * 1024 * 2;
constexpr size_t OFF_WQ = OFF_WOUT + 1024ull * 1024 * 2;
constexpr size_t OFF_WG = OFF_WQ + 2048ull * 1024 * 2;
constexpr size_t OFF_WP = OFF_WG + 1024ull * 1024 * 2;
constexpr size_t OFF_KEYS = OFF_WP + 1024ull * 256 * 2;
constexpr size_t OFF_UT = OFF_KEYS + 16ull * 128 * 128 * 2;
constexpr size_t OFF_VT = OFF_UT + 16384ull * 1024 * 2;
constexpr size_t OFF_LW = OFF_VT + 16384ull * 1024 * 2;
constexpr size_t OFF_LS = OFF_LW + 2ull * 2 * 8 * 64 * 64 * 2;
constexpr size_t OFF_PB = OFF_LS + 4096;
constexpr size_t OFF_RS1 = OFF_PB + (size_t)NT * 256 * 2;
constexpr size_t OFF_RS3 = OFF_RS1 + (size_t)NT * 4;
constexpr size_t OFF_AGG = OFF_RS3 + (size_t)NT * 4;
constexpr size_t WS_END = OFF_AGG + 768ull * 2 * 1024 * 4;
constexpr size_t OFF_Q = OFF_R1;
constexpr size_t OFF_KB = OFF_R1 + 96 * MiB;
constexpr size_t OFF_VB = OFF_R1 + 120 * MiB;
constexpr size_t OFF_XR = OFF_R1 + 144 * MiB;
constexpr size_t OFF_GR = OFF_R1 + 240 * MiB;
constexpr size_t OFF_QP = OFF_R1;
constexpr size_t OFF_H2B = OFF_R1;
constexpr size_t OFF_G = OFF_R1 + 192 * MiB;
constexpr size_t OFF_AT = OFF_R2;
constexpr size_t OFF_HF = OFF_R2 + 96 * MiB;
constexpr size_t OFF_H1B = OFF_R2;
constexpr size_t OFF_XB = OFF_R0;
constexpr size_t OFF_MRG = OFF_R0;
constexpr size_t OFF_SUBS = OFF_R0;
constexpr size_t OFF_PIDX = OFF_R0 + 96 * MiB;
constexpr size_t OFF_PS = OFF_R0 + 144 * MiB;
constexpr size_t OFF_H3 = OFF_R0;

struct P {
    const float *x_p, *x_s, *p_p, *p_s, *mix_g, *w_in, *sink, *conv_w, *conv_b, *lru_wa, *lru_ba, *lru_wx, *lru_bx, *lru_lam,
        *attn_g, *lru_g, *w_out, *ffn_g, *peer_wq, *peer_keys, *peer_u, *peer_v, *ple_g, *ple_wg, *ple_wp, *fin_g;
    float* out;
    char* ws;
};

__device__ __forceinline__ int opaque_tid(int wv) { unsigned z = 0; asm volatile("" : "+v"(z)); int l = __builtin_amdgcn_mbcnt_hi(~0u, __builtin_amdgcn_mbcnt_lo(~0u, z)); return wv * 64 + l; }
__device__ __forceinline__ unsigned pk2(float lo, float hi) {
    unsigned r;
    asm("v_cvt_pk_bf16_f32 %0, %1, %2" : "=v"(r) : "v"(lo), "v"(hi));
    return r;
}
__device__ __forceinline__ float bflo(unsigned w) { return __uint_as_float(w << 16); }
__device__ __forceinline__ float bfhi(unsigned w) { return __uint_as_float(w & 0xffff0000u); }
__device__ __forceinline__ float bf1(bf16_t h) { return __uint_as_float((unsigned)h << 16); }
__device__ __forceinline__ void st4bf(bf16_t* dst, f32x4 v) {
    uint2 o; o.x = pk2(v[0], v[1]); o.y = pk2(v[2], v[3]);
    *(uint2*)dst = o;
}
__device__ __forceinline__ f32x4 ld4bf(const bf16_t* src) {
    uint2 o = *(const uint2*)src;
    f32x4 v; v[0] = bflo(o.x); v[1] = bfhi(o.x); v[2] = bflo(o.y); v[3] = bfhi(o.y);
    return v;
}
__device__ __forceinline__ float dppf(float v, const int ctrl_sel) {
    int t = 0;
    if (ctrl_sel == 0) t = __builtin_amdgcn_update_dpp(0, __float_as_int(v), 0xB1, 0xf, 0xf, true);
    else if (ctrl_sel == 1) t = __builtin_amdgcn_update_dpp(0, __float_as_int(v), 0x4E, 0xf, 0xf, true);
    else if (ctrl_sel == 2) t = __builtin_amdgcn_update_dpp(0, __float_as_int(v), 0x141, 0xf, 0xf, true);
    else t = __builtin_amdgcn_update_dpp(0, __float_as_int(v), 0x140, 0xf, 0xf, true);
    return __int_as_float(t);
}
__device__ __forceinline__ float row_max16(float v) {
    v = fmaxf(v, dppf(v, 0)); v = fmaxf(v, dppf(v, 1)); v = fmaxf(v, dppf(v, 2)); v = fmaxf(v, dppf(v, 3));
    return v;
}
__device__ __forceinline__ float row_sum16(float v) {
    v += dppf(v, 0); v += dppf(v, 1); v += dppf(v, 2); v += dppf(v, 3);
    return v;
}
__device__ __forceinline__ float wave_sum(float v) {
    v = row_sum16(v);
    v += __int_as_float(__builtin_amdgcn_ds_swizzle(__float_as_int(v), 0x401F));
    return __int_as_float(__builtin_amdgcn_readlane(__float_as_int(v), 0)) + __int_as_float(__builtin_amdgcn_readlane(__float_as_int(v), 32));
}
__device__ __forceinline__ float xor32(float v, int lane) {
    return __int_as_float(__builtin_amdgcn_ds_bpermute((lane ^ 32) << 2, __float_as_int(v)));
}
__device__ __forceinline__ float sigmoidf_(float x) { return 1.f / (1.f + __expf(-x)); }
__device__ __forceinline__ float gelu_tanh(float x) {
    float y = 0.7978845608028654f * (x + 0.044715f * x * x * x);
    float t = 1.f - 2.f / (1.f + __expf(2.f * y));
    return 0.5f * x * (1.f + t);
}
__device__ __forceinline__ int tok_pos(int g) { return g < NTP ? (g & 2047) : (g & 16383); }
__device__ __forceinline__ void tile_seq(int blk, int& c, int& nc) {
    if (blk < 512) { c = blk & 15; nc = 16; } else { c = (blk - 512) & 127; nc = 128; }
}
__device__ __forceinline__ float dot2bf(unsigned a, unsigned b, float acc) {
    return __builtin_amdgcn_fdot2_f32_bf16(__builtin_bit_cast(bf16x2v, a), __builtin_bit_cast(bf16x2v, b), acc, false);
}

__device__ __forceinline__ int lds_byte(int r, int c) {
    int st = (r >> 4) * 2 + (c >> 5), ob = (r & 15) * 64 + (c & 31) * 2;
    return st * 1024 + (ob ^ (((ob >> 9) & 1) << 5));
}
__device__ __forceinline__ void stage_rc(int b, int& R, int& C) {
    int st = b >> 10, sb = b & 1023, swz = sb ^ (((sb >> 9) & 1) << 5);
    R = (st / 2) * 16 + swz / 64;
    C = (st % 2) * 32 + (swz % 64) / 2;
}
#define WAIT_V0() asm volatile("s_waitcnt vmcnt(0)" ::: "memory")

template <class Epi>
__device__ __forceinline__ void gemm_tile(const bf16_t* __restrict__ A, const bf16_t* __restrict__ Bt, const int K,
                                          const int brow, const int bcol, char* shm, const int wv, Epi epi) {
    constexpr int BK = 64, TILE_B = 256 * BK * 2, GL = 4, STAGE_B = 2 * TILE_B;
    const int tid = opaque_tid(wv), wid = tid >> 6, lane = tid & 63, wr = wid >> 2, wc = wid & 3, fr = lane & 15, fq = lane >> 4;
    const bf16_t* Ab = A + (size_t)brow * K;
    const bf16_t* Bb = Bt + (size_t)bcol * K;
    int sR[GL], sC[GL];
#pragma unroll
    for (int i = 0; i < GL; ++i) stage_rc(wid * 1024 + i * 8192 + lane * 16, sR[i], sC[i]);
    f32x4 acc[8][4];
#pragma unroll
    for (int m = 0; m < 8; ++m)
#pragma unroll
        for (int n = 0; n < 4; ++n) acc[m][n] = f32x4{0.f, 0.f, 0.f, 0.f};
    const int nt = K / BK;
#define GSTAGE(buf, kt)                                                                                              \
    do {                                                                                                             \
        _Pragma("unroll") for (int i = 0; i < GL; ++i) {                                                             \
            __builtin_amdgcn_global_load_lds((const unsigned*)(Ab + (size_t)sR[i] * K + (kt) * BK + sC[i]),          \
                                             (unsigned*)(shm + (buf) * STAGE_B + wid * 1024 + i * 8192), 16, 0, 0);   \
            __builtin_amdgcn_global_load_lds((const unsigned*)(Bb + (size_t)sR[i] * K + (kt) * BK + sC[i]),          \
                                             (unsigned*)(shm + (buf) * STAGE_B + TILE_B + wid * 1024 + i * 8192), 16, 0, 0); \
        }                                                                                                            \
    } while (0)
    __syncthreads();
    GSTAGE(0, 0);
    WAIT_V0();
    __syncthreads();
    for (int t = 0; t < nt; ++t) {
        const int cur = t & 1;
        if (t + 1 < nt) GSTAGE(cur ^ 1, t + 1);
        const char* sa = shm + cur * STAGE_B;
        const char* sb = sa + TILE_B;
#pragma unroll
        for (int ks = 0; ks < 2; ++ks) {
            bf16x8 At[8], Bf[4];
#pragma unroll
            for (int m = 0; m < 8; ++m) At[m] = *(const bf16x8*)(sa + lds_byte(wr * 128 + m * 16 + fr, ks * 32 + fq * 8));
#pragma unroll
            for (int n = 0; n < 4; ++n) Bf[n] = *(const bf16x8*)(sb + lds_byte(wc * 64 + n * 16 + fr, ks * 32 + fq * 8));
#pragma unroll
            for (int m = 0; m < 8; ++m)
#pragma unroll
                for (int n = 0; n < 4; ++n) acc[m][n] = __builtin_amdgcn_mfma_f32_16x16x32_bf16(Bf[n], At[m], acc[m][n], 0, 0, 0);
            __builtin_amdgcn_sched_barrier(0);
        }
        WAIT_V0();
        __syncthreads();
    }
#undef GSTAGE
#pragma unroll
    for (int m = 0; m < 8; ++m) {
        const int row = brow + wr * 128 + m * 16 + fr;
#pragma unroll
        for (int np = 0; np < 2; ++np) {
            const int col = bcol + wc * 64 + np * 32 + fq * 4;
            epi(row, col, acc[m][2 * np], acc[m][2 * np + 1]);
        }
    }
}

__device__ __forceinline__ bool gemm_next(int i, int nN, int nTiles, int& pm, int& pn) {
    const int G = gridDim.x, b = blockIdx.x;
    int v = b;
    if ((G & 7) == 0) v = (b & 7) * (G >> 3) + (b >> 3);
    const int L = i * G + v;
    if (L >= nTiles) return false;
    pm = L / nN; pn = L % nN;
    return true;
}

template <class NMap, class Scale>
__device__ __forceinline__ void prep_wT(const float* __restrict__ src, bf16_t* __restrict__ dst, int K, int N, int gtid, int gstride,
                                        NMap nmap, Scale scale) {
    const int items = N * (K / 8);
    for (int it = gtid; it < items; it += gstride) {
        const int n = it % N, k0 = (it / N) * 8;
        const int ns = nmap(n);
        float v[8];
#pragma unroll
        for (int i = 0; i < 8; ++i) v[i] = src[(size_t)(k0 + i) * N + ns] * scale(k0 + i);
        uint4 o; o.x = pk2(v[0], v[1]); o.y = pk2(v[2], v[3]); o.z = pk2(v[4], v[5]); o.w = pk2(v[6], v[7]);
        *(uint4*)(dst + (size_t)n * K + k0) = o;
    }
}

__device__ __forceinline__ void phase_prep(const P& p, const int wv) {
    const int gtid = blockIdx.x * NTHREADS + opaque_tid(wv), gstride = gridDim.x * NTHREADS;
    const int lane = gtid & 63, gw = gtid >> 6, nw = gstride >> 6;
    char* ws = p.ws;
    {
        const float* g = p.mix_g;
        prep_wT(p.w_in, (bf16_t*)(ws + OFF_WIN), 1024, 1792, gtid, gstride,
                [](int n) { if (n >= 640) return n; int pp = n & 63; return (n & ~63) + (pp >> 5) * 16 + ((pp >> 4) & 1) * 32 + (pp & 15); },
                [g](int k) { return g[k]; });
    }
    {
        const float *ga = p.attn_g, *gl = p.lru_g;
        prep_wT(p.w_out, (bf16_t*)(ws + OFF_WOUT), 1024, 1024, gtid, gstride, [](int n) { return n; },
                [ga, gl](int k) { return k < 512 ? ga[k] : gl[k - 512]; });
    }
    {
        const float* g = p.ffn_g;
        prep_wT(p.peer_wq, (bf16_t*)(ws + OFF_WQ), 1024, 2048, gtid, gstride, [](int n) { return n; }, [g](int k) { return g[k]; });
    }
    {
        const float* g = p.ple_g;
        prep_wT(p.ple_wg, (bf16_t*)(ws + OFF_WG), 1024, 1024, gtid, gstride, [](int n) { return n; }, [g](int k) { return g[k]; });
    }
    prep_wT(p.ple_wp, (bf16_t*)(ws + OFF_WP), 256, 1024, gtid, gstride, [](int n) { return n; }, [](int) { return 1.f; });
    {
        bf16_t* kb = (bf16_t*)(ws + OFF_KEYS);
        for (int i = gtid; i < 16 * 128 * 128 / 2; i += gstride) {
            float2 v = ((const float2*)p.peer_keys)[i];
            ((unsigned*)kb)[i] = pk2(v.x, v.y);
        }
    }
    {
        bf16_t* lw = (bf16_t*)(ws + OFF_LW);
        for (int i = gtid; i < 2 * 2 * 8 * 64 * 64; i += gstride) {
            const int s = i & 63, j = (i >> 6) & 63, h = (i >> 12) & 7, mat = (i >> 15) & 1, dir = (i >> 16) & 1;
            const int ks = s >> 4, hf = (s >> 3) & 1, e = s & 7;
            const int ii = 16 * ks + 8 * (e >> 2) + 4 * hf + (e & 3);
            const float* src = mat ? p.lru_wx : p.lru_wa;
            const float v = src[(((size_t)dir * 8 + h) * 64 + ii) * 64 + j];
            lw[i] = (bf16_t)(pk2(v, 0.f) & 0xffff);
        }
        float* ls = (float*)(ws + OFF_LS);
        for (int i = gtid; i < 1024; i += gstride) {
            const float lam = p.lru_lam[i];
            ls[i] = lam >= 0.f ? -log1pf(expf(-lam)) : lam - log1pf(expf(lam));
        }
    }
    {
        const float* g = p.ffn_g;
        const float4* us = (const float4*)p.peer_u;
        const float4* vs = (const float4*)p.peer_v;
        uint2* ud = (uint2*)(ws + OFF_UT);
        uint2* vd = (uint2*)(ws + OFF_VT);
        for (int i = gtid; i < 16384 * 256; i += gstride) {
            const float4 u = us[i], v = vs[i];
            const float4 gg = ((const float4*)g)[i & 255];
            uint2 a, b;
            a.x = pk2(u.x * gg.x, u.y * gg.y); a.y = pk2(u.z * gg.z, u.w * gg.w);
            b.x = pk2(v.x, v.y); b.y = pk2(v.z, v.w);
            ud[i] = a; vd[i] = b;
        }
    }
    {
        uint2* pd = (uint2*)(ws + OFF_PB);
        for (int i = gtid; i < NT * 64; i += gstride) {
            const float4 v = i < NTP * 64 ? ((const float4*)p.p_p)[i] : ((const float4*)p.p_s)[i - NTP * 64];
            uint2 a; a.x = pk2(v.x, v.y); a.y = pk2(v.z, v.w);
            pd[i] = a;
        }
    }
    {
        bf16_t* xb = (bf16_t*)(ws + OFF_XB);
        float* rs1 = (float*)(ws + OFF_RS1);
        for (int tok = gw; tok < NT; tok += nw) {
            const float4* xr = (const float4*)(tok < NTP ? p.x_p + (size_t)tok * 1024 : p.x_s + (size_t)(tok - NTP) * 1024);
            float s = 0.f;
            uint2* od = (uint2*)(xb + (size_t)tok * 1024);
#pragma unroll
            for (int j = 0; j < 4; ++j) {
                const float4 v = xr[lane + 64 * j];
                s += v.x * v.x + v.y * v.y + v.z * v.z + v.w * v.w;
                uint2 a; a.x = pk2(v.x, v.y); a.y = pk2(v.z, v.w);
                od[lane + 64 * j] = a;
            }
            s = wave_sum(s);
            if (lane == 0) rs1[tok] = rsqrtf(s * (1.f / 1024.f) + EPS);
        }
    }
}

__device__ __forceinline__ void phase_inproj(const P& p, char* shm, const int wv) {
    char* ws = p.ws;
    const bf16_t* XB = (const bf16_t*)(ws + OFF_XB);
    const bf16_t* W = (const bf16_t*)(ws + OFF_WIN);
    const float* RS1 = (const float*)(ws + OFF_RS1);
    bf16_t* Q = (bf16_t*)(ws + OFF_Q);
    bf16_t* KB = (bf16_t*)(ws + OFF_KB);
    bf16_t* VB = (bf16_t*)(ws + OFF_VB);
    bf16_t* XR = (bf16_t*)(ws + OFF_XR);
    bf16_t* GR = (bf16_t*)(ws + OFF_GR);
    auto epi = [=](int row, int col, f32x4 v0, f32x4 v1) {
        const float rs = RS1[row];
        v0 *= rs; v1 *= rs;
        if (col < 640) {
            const int pos = tok_pos(row);
            const int d0 = ((col & 63) >> 5) * 16 + (col & 15);
            f32x4 o0, o1;
#pragma unroll
            for (int j = 0; j < 4; ++j) {
                const float invf = exp2f(-(float)(d0 + j) * 0.41524101186092029f);
                const float ang = (float)pos * invf;
                const float nrev = rintf(ang * 0.15915494309189535f);
                float rr = fmaf(-nrev, 6.28125f, ang);
                rr = fmaf(-nrev, 0.0019353071795864769f, rr);
                const float cs = __cosf(rr), sn = __sinf(rr);
                o0[j] = v0[j] * cs - v1[j] * sn;
                o1[j] = v1[j] * cs + v0[j] * sn;
            }
            if (col < 512) {
                o0 *= 0.125f; o1 *= 0.125f;
                bf16_t* dst = Q + (size_t)row * 512 + (col & ~63) + d0;
                st4bf(dst, o0); st4bf(dst + 32, o1);
            } else {
                bf16_t* dst = KB + (size_t)row * 128 + ((col - 512) & ~63) + d0;
                st4bf(dst, o0); st4bf(dst + 32, o1);
            }
        } else if (col < 768) {
            bf16_t* dst = VB + (size_t)row * 128 + (col - 640);
            st4bf(dst, v0); st4bf(dst + 16, v1);
        } else if (col < 1280) {
            bf16_t* dst = XR + (size_t)row * 512 + (col - 768);
            st4bf(dst, v0); st4bf(dst + 16, v1);
        } else {
            bf16_t* dst = GR + (size_t)row * 512 + (col - 1280);
            f32x4 g0, g1;
#pragma unroll
            for (int j = 0; j < 4; ++j) { g0[j] = gelu_tanh(v0[j]); g1[j] = gelu_tanh(v1[j]); }
            st4bf(dst, g0); st4bf(dst + 16, g1);
        }
    };
    int pm, pn;
    for (int i = 0; gemm_next(i, 7, 384 * 7, pm, pn); ++i) gemm_tile(XB, W, 1024, pm * 256, pn * 256, shm, wv, epi);
}

__device__ __forceinline__ void attn_unit(const P& p, char* shm, int unit, const int wv) {
    char* ws = p.ws;
    const int blk = unit >> 1, kvh = unit & 1;
    int c, nc; tile_seq(blk, c, nc);
    const int g0 = blk * 128;
    bf16_t* Ks = (bf16_t*)shm;
    bf16_t* Vt = (bf16_t*)(shm + 55296);
    const bf16_t* KB = (const bf16_t*)(ws + OFF_KB);
    const bf16_t* VB = (const bf16_t*)(ws + OFF_VB);
    const bf16_t* Q = (const bf16_t*)(ws + OFF_Q);
    bf16_t* AT = (bf16_t*)(ws + OFF_AT);
    const int tid = opaque_tid(wv), w = tid >> 6, lane = tid & 63, half = lane >> 5, tl = lane & 31;
    __syncthreads();
    for (int item = tid; item < 384 * 8; item += NTHREADS) {
        const int key = item % 384, part = item / 384;
        const int ch = key >> 7;
        if ((ch == 0 && c == 0) || (ch == 2 && c == nc - 1)) continue;
        const size_t tok = (size_t)(g0 - 128 + key);
        const uint4 kv = *(const uint4*)(KB + tok * 128 + kvh * 64 + part * 8);
        *(uint4*)(Ks + key * 72 + part * 8) = kv;
        const uint4 vv = *(const uint4*)(VB + tok * 128 + kvh * 64 + part * 8);
        bf16_t* vd = Vt + (part * 8) * 388 + key;
        vd[0 * 388] = (bf16_t)(vv.x & 0xffff); vd[1 * 388] = (bf16_t)(vv.x >> 16);
        vd[2 * 388] = (bf16_t)(vv.y & 0xffff); vd[3 * 388] = (bf16_t)(vv.y >> 16);
        vd[4 * 388] = (bf16_t)(vv.z & 0xffff); vd[5 * 388] = (bf16_t)(vv.z >> 16);
        vd[6 * 388] = (bf16_t)(vv.w & 0xffff); vd[7 * 388] = (bf16_t)(vv.w >> 16);
    }
    __syncthreads();
    for (int it = 0; it < 2; ++it) {
        const int task = w + 8 * it;
        const int qhl = task & 3, rg = task >> 2;
        const int hq = kvh * 4 + qhl;
        const int qrow = rg * 32 + tl;
        const bf16_t* qp = Q + (size_t)(g0 + qrow) * 512 + hq * 64 + half * 8;
        bf16x8 qf[4];
#pragma unroll
        for (int ks = 0; ks < 4; ++ks) qf[ks] = *(const bf16x8*)(qp + ks * 16);
        float m = p.sink[hq];
        float l = half == 0 ? 1.f : 0.f;
        f32x16 O0, O1;
#pragma unroll
        for (int i = 0; i < 16; ++i) { O0[i] = 0.f; O1[i] = 0.f; }
        for (int ch = 0; ch < 3; ++ch) {
            if ((ch == 0 && c == 0) || (ch == 2 && c == nc - 1)) continue;
            f32x16 S[4];
#pragma unroll
            for (int kb = 0; kb < 4; ++kb) {
#pragma unroll
                for (int i = 0; i < 16; ++i) S[kb][i] = 0.f;
#pragma unroll
                for (int ks = 0; ks < 4; ++ks) {
                    const bf16x8 kf = *(const bf16x8*)(Ks + (ch * 128 + kb * 32 + tl) * 72 + ks * 16 + half * 8);
                    S[kb] = __builtin_amdgcn_mfma_f32_32x32x16_bf16(kf, qf[ks], S[kb], 0, 0, 0);
                }
            }
            float mx = -INFINITY;
#pragma unroll
            for (int kb = 0; kb < 4; ++kb)
#pragma unroll
                for (int i = 0; i < 16; ++i) {
                    const int kk = kb * 32 + 8 * (i >> 2) + 4 * half + (i & 3);
                    const bool valid = (ch == 1) || (ch == 0 ? kk >= qrow : kk <= qrow);
                    const float s = valid ? S[kb][i] : -INFINITY;
                    S[kb][i] = s;
                    mx = fmaxf(mx, s);
                }
            mx = fmaxf(mx, xor32(mx, lane));
            const float mn = fmaxf(m, mx);
            const float alpha = __expf(m - mn);
            m = mn;
            float ps = 0.f;
#pragma unroll
            for (int kb = 0; kb < 4; ++kb)
#pragma unroll
                for (int i = 0; i < 16; ++i) {
                    const float pv = __expf(S[kb][i] - mn);
                    S[kb][i] = pv;
                    ps += pv;
                }
            l = l * alpha + ps;
#pragma unroll
            for (int i = 0; i < 16; ++i) { O0[i] *= alpha; O1[i] *= alpha; }
#pragma unroll
            for (int kb = 0; kb < 4; ++kb)
#pragma unroll
                for (int s2 = 0; s2 < 2; ++s2) {
                    uint4 pw;
                    pw.x = pk2(S[kb][8 * s2 + 0], S[kb][8 * s2 + 1]); pw.y = pk2(S[kb][8 * s2 + 2], S[kb][8 * s2 + 3]);
                    pw.z = pk2(S[kb][8 * s2 + 4], S[kb][8 * s2 + 5]); pw.w = pk2(S[kb][8 * s2 + 6], S[kb][8 * s2 + 7]);
                    const bf16x8 pf = __builtin_bit_cast(bf16x8, pw);
                    const bf16_t* vp = Vt + tl * 388 + ch * 128 + kb * 32 + 16 * s2 + 4 * half;
                    uint4 vw;
                    uint2 a0 = *(const uint2*)vp, a1 = *(const uint2*)(vp + 8);
                    vw.x = a0.x; vw.y = a0.y; vw.z = a1.x; vw.w = a1.y;
                    O0 = __builtin_amdgcn_mfma_f32_32x32x16_bf16(__builtin_bit_cast(bf16x8, vw), pf, O0, 0, 0, 0);
                    const bf16_t* vp1 = vp + 32 * 388;
                    a0 = *(const uint2*)vp1; a1 = *(const uint2*)(vp1 + 8);
                    vw.x = a0.x; vw.y = a0.y; vw.z = a1.x; vw.w = a1.y;
                    O1 = __builtin_amdgcn_mfma_f32_32x32x16_bf16(__builtin_bit_cast(bf16x8, vw), pf, O1, 0, 0, 0);
                }
        }
        const float lt = l + xor32(l, lane);
        const float inv = 1.f / lt;
        bf16_t* op = AT + (size_t)(g0 + qrow) * 512 + hq * 64 + 4 * half;
#pragma unroll
        for (int i4 = 0; i4 < 4; ++i4) {
            f32x4 a, b;
#pragma unroll
            for (int q = 0; q < 4; ++q) { a[q] = O0[4 * i4 + q] * inv; b[q] = O1[4 * i4 + q] * inv; }
            st4bf(op + 8 * i4, a);
            st4bf(op + 32 + 8 * i4, b);
        }
    }
}

template <bool FINAL>
__device__ __forceinline__ void lru_unit(const P& p, char* shm, int blk, const int wv) {
    char* ws = p.ws;
    int c, nc; tile_seq(blk, c, nc);
    const int g0 = blk * 128;
    const int seq_lo = g0 - c * 128, seq_hi = seq_lo + nc * 128;
    const int tid = opaque_tid(wv), w = tid >> 6, lane = tid & 63, half = lane >> 5, tl = lane & 31;
    float* abuf = (float*)shm + w * (2 * 32 * 68);
    float* ubuf = abuf + 32 * 68;
    float* ssq = (float*)(shm + 139264);
    const bf16_t* XR = (const bf16_t*)(ws + OFF_XR);
    const bf16_t* GR = (const bf16_t*)(ws + OFF_GR);
    const bf16_t* LW = (const bf16_t*)(ws + OFF_LW);
    const float* LS = (const float*)(ws + OFF_LS);
    float* AGG = (float*)(ws + OFF_AGG);
    bf16_t* HF = (bf16_t*)(ws + OFF_HF);
    bf16_t* MRG = (bf16_t*)(ws + OFF_MRG);
    const int chn = w * 64 + lane;
    if (FINAL) {
        __syncthreads();
        if (tid < 32) ssq[tid] = 0.f;
    }
    for (int dir = 0; dir < 2; ++dir) {
        float h = 0.f, Ap = 1.f;
        if (FINAL) {
            if (dir == 0) {
                for (int cc = 0; cc < c; ++cc) {
                    const int tile = blk - c + cc;
                    const float A_ = AGG[(size_t)(tile * 2 + 0) * 1024 + chn], H_ = AGG[(size_t)(tile * 2 + 0) * 1024 + 512 + chn];
                    h = A_ * h + H_;
                }
            } else {
                for (int cc = nc - 1; cc > c; --cc) {
                    const int tile = blk - c + cc;
                    const float A_ = AGG[(size_t)(tile * 2 + 1) * 1024 + chn], H_ = AGG[(size_t)(tile * 2 + 1) * 1024 + 512 + chn];
                    h = A_ * h + H_;
                }
            }
        }
        for (int ibi = 0; ibi < 4; ++ibi) {
            const int ib = dir ? 3 - ibi : ibi;
            const int t0 = g0 + ib * 32;
            const int t = t0 + tl;
            float xcv[4][8];
#pragma unroll
            for (int ks = 0; ks < 4; ++ks)
#pragma unroll
                for (int grp = 0; grp < 2; ++grp) {
                    const int cb4 = w * 64 + 16 * ks + 8 * grp + 4 * half;
                    f32x4 a = *(const f32x4*)(p.conv_b + cb4);
#pragma unroll
                    for (int j = 0; j < 4; ++j) {
                        const int tt = t + j - 2;
                        if (tt >= seq_lo && tt < seq_hi) {
                            const f32x4 xv = ld4bf(XR + (size_t)tt * 512 + cb4);
                            const f32x4 wv = *(const f32x4*)(p.conv_w + j * 512 + cb4);
                            a += wv * xv;
                        }
                    }
#pragma unroll
                    for (int q = 0; q < 4; ++q) xcv[ks][grp * 4 + q] = a[q];
                }
            bf16x8 xb[4];
#pragma unroll
            for (int ks = 0; ks < 4; ++ks) {
                uint4 pw;
                pw.x = pk2(xcv[ks][0], xcv[ks][1]); pw.y = pk2(xcv[ks][2], xcv[ks][3]);
                pw.z = pk2(xcv[ks][4], xcv[ks][5]); pw.w = pk2(xcv[ks][6], xcv[ks][7]);
                xb[ks] = __builtin_bit_cast(bf16x8, pw);
            }
            __syncthreads();
#pragma unroll
            for (int cb = 0; cb < 2; ++cb) {
                f32x16 aa, ax;
#pragma unroll
                for (int i = 0; i < 16; ++i) { aa[i] = 0.f; ax[i] = 0.f; }
#pragma unroll
                for (int ks = 0; ks < 4; ++ks) {
                    const bf16x8 wa = *(const bf16x8*)(LW + ((size_t)((dir * 2 + 0) * 8 + w) * 64 + cb * 32 + tl) * 64 + ks * 16 + half * 8);
                    const bf16x8 wx = *(const bf16x8*)(LW + ((size_t)((dir * 2 + 1) * 8 + w) * 64 + cb * 32 + tl) * 64 + ks * 16 + half * 8);
                    aa = __builtin_amdgcn_mfma_f32_32x32x16_bf16(wa, xb[ks], aa, 0, 0, 0);
                    ax = __builtin_amdgcn_mfma_f32_32x32x16_bf16(wx, xb[ks], ax, 0, 0, 0);
                }
#pragma unroll
                for (int r4 = 0; r4 < 4; ++r4) {
                    const int j0 = cb * 32 + 8 * r4 + 4 * half;
                    const int ch4 = w * 64 + j0;
                    const f32x4 ba4 = *(const f32x4*)(p.lru_ba + dir * 512 + ch4);
                    const f32x4 bx4 = *(const f32x4*)(p.lru_bx + dir * 512 + ch4);
                    const f32x4 ls4 = *(const f32x4*)(LS + dir * 512 + ch4);
                    f32x4 av, uv;
#pragma unroll
                    for (int q = 0; q < 4; ++q) {
                        const int r = 4 * r4 + q;
                        const float xcval = xcv[2 * cb + (r4 >> 1)][4 * (r4 & 1) + q];
                        const float rgate = sigmoidf_(aa[r] + ba4[q]);
                        const float igate = sigmoidf_(ax[r] + bx4[q]);
                        const float la = 8.f * rgate * ls4[q];
                        av[q] = __expf(la);
                        uv[q] = sqrtf(fmaxf(0.f, 1.f - __expf(2.f * la))) * igate * xcval;
                    }
                    *(f32x4*)(abuf + tl * 68 + j0) = av;
                    *(f32x4*)(ubuf + tl * 68 + j0) = uv;
                }
            }
            __syncthreads();
            float val[32];
#pragma unroll
            for (int tt = 0; tt < 32; ++tt) {
                const int tloc = dir ? 31 - tt : tt;
                const float a = abuf[tloc * 68 + lane], u = ubuf[tloc * 68 + lane];
                h = a * h + u;
                Ap *= a;
                if (FINAL) {
                    const size_t off = (size_t)(t0 + tloc) * 512 + chn;
                    if (dir == 0) {
                        HF[off] = (bf16_t)(pk2(h, 0.f) & 0xffff);
                    } else {
                        const float hf = bf1(HF[off]);
                        const float gg = bf1(GR[off]);
                        const float v = gg * (hf + h);
                        val[tt] = v;
                        const float s = wave_sum(v * v);
                        if (lane == 0) atomicAdd(&ssq[tloc], s);
                    }
                }
            }
            if (FINAL && dir == 1) {
                __syncthreads();
#pragma unroll
                for (int tt = 0; tt < 32; ++tt) {
                    const int tloc = 31 - tt;
                    const float rs = rsqrtf(ssq[tloc] * (1.f / 512.f) + EPS);
                    MRG[(size_t)(t0 + tloc) * 1024 + 512 + chn] = (bf16_t)(pk2(val[tt] * rs, 0.f) & 0xffff);
                }
                __syncthreads();
                if (tid < 32) ssq[tid] = 0.f;
            }
        }
        if (!FINAL) {
            AGG[(size_t)(blk * 2 + dir) * 1024 + chn] = Ap;
            AGG[(size_t)(blk * 2 + dir) * 1024 + 512 + chn] = h;
        }
    }
}

__device__ __forceinline__ void score_unit(const P& p, char* shm, int unit, const int wv) {
    char* ws = p.ws;
    const int sp = unit & 15, tg = unit >> 4;
    const int tid = opaque_tid(wv), w = tid >> 6, lane = tid & 63, fr = lane & 15, fq = lane >> 4;
    bf16_t* KL = (bf16_t*)shm;
    const bf16_t* KEYS = (const bf16_t*)(ws + OFF_KEYS) + (size_t)sp * 16384;
    const bf16_t* QP = (const bf16_t*)(ws + OFF_QP);
    float* SUBS = (float*)(ws + OFF_SUBS);
    __syncthreads();
    for (int i = tid; i < 2048; i += NTHREADS) {
        const int r = i >> 4, cpart = i & 15;
        *(uint4*)(KL + r * 136 + cpart * 8) = *(const uint4*)(KEYS + r * 128 + cpart * 8);
    }
    __syncthreads();
    for (int tt = 0; tt < 8; ++tt) {
        const int gb = (tg * 8 + tt) * 128 + w * 16;
        bf16x8 af[4];
#pragma unroll
        for (int ks = 0; ks < 4; ++ks) af[ks] = *(const bf16x8*)(QP + (size_t)(gb + fr) * 2048 + sp * 128 + ks * 32 + fq * 8);
        float v[4][8];
#pragma unroll
        for (int nb = 0; nb < 8; ++nb) {
            f32x4 acc = {0.f, 0.f, 0.f, 0.f};
#pragma unroll
            for (int ks = 0; ks < 4; ++ks) {
                const bf16x8 bf = *(const bf16x8*)(KL + (nb * 16 + fr) * 136 + ks * 32 + fq * 8);
                acc = __builtin_amdgcn_mfma_f32_16x16x32_bf16(af[ks], bf, acc, 0, 0, 0);
            }
#pragma unroll
            for (int i = 0; i < 4; ++i) v[i][nb] = __uint_as_float((__float_as_uint(acc[i]) & ~127u) | (unsigned)(nb * 16 + fr));
        }
        float keep[4] = {0.f, 0.f, 0.f, 0.f};
        for (int r = 0; r < 16; ++r) {
#pragma unroll
            for (int i = 0; i < 4; ++i) {
                float lm = v[i][0];
#pragma unroll
                for (int nb = 1; nb < 8; ++nb) lm = fmaxf(lm, v[i][nb]);
                const float rm = row_max16(lm);
                keep[i] = (fr == r) ? rm : keep[i];
#pragma unroll
                for (int nb = 0; nb < 8; ++nb) v[i][nb] = (v[i][nb] == rm) ? -INFINITY : v[i][nb];
            }
        }
#pragma unroll
        for (int i = 0; i < 4; ++i) SUBS[(size_t)(gb + 4 * fq + i) * 256 + sp * 16 + fr] = keep[i];
    }
}

__device__ __forceinline__ void phase_stage2(const P& p, const int wv) {
    char* ws = p.ws;
    const float* SUBS = (const float*)(ws + OFF_SUBS);
    int* PIDX = (int*)(ws + OFF_PIDX);
    float* PS = (float*)(ws + OFF_PS);
    const int gtid = blockIdx.x * NTHREADS + opaque_tid(wv), gstride = gridDim.x * NTHREADS;
    for (int idx = gtid; idx < NT * 8; idx += gstride) {
        const int tok = idx >> 3, hh = idx & 7;
        const float* s0p = SUBS + (size_t)tok * 256 + hh * 32;
        const float* s1p = s0p + 16;
        float s0[16], s1[16];
#pragma unroll
        for (int i = 0; i < 4; ++i) {
            const f32x4 a = *(const f32x4*)(s0p + 4 * i), b = *(const f32x4*)(s1p + 4 * i);
#pragma unroll
            for (int q = 0; q < 4; ++q) { s0[4 * i + q] = a[q]; s1[4 * i + q] = b[q]; }
        }
        float L[16];
#pragma unroll
        for (int i = 0; i < 16; ++i) L[i] = -INFINITY;
#pragma unroll
        for (int a = 0; a < 16; ++a)
#pragma unroll
            for (int b = 0; b < 16; ++b) {
                if ((a + 1) * (b + 1) <= 16) {
                    float nv = __uint_as_float((__float_as_uint(s0[a] + s1[b]) & ~255u) | (unsigned)(a * 16 + b));
#pragma unroll
                    for (int i = 0; i < 16; ++i) {
                        const float hi = fmaxf(L[i], nv);
                        nv = fminf(L[i], nv);
                        L[i] = hi;
                    }
                }
            }
        int ids[16];
#pragma unroll
        for (int k = 0; k < 16; ++k) {
            const unsigned code = __float_as_uint(L[k]) & 255u;
            const unsigned i0 = __float_as_uint(s0p[code >> 4]) & 127u;
            const unsigned i1 = __float_as_uint(s1p[code & 15]) & 127u;
            ids[k] = (int)(i0 * 128 + i1);
        }
        int4* pi = (int4*)(PIDX + (size_t)tok * 128 + hh * 16);
        f32x4* pf = (f32x4*)(PS + (size_t)tok * 128 + hh * 16);
#pragma unroll
        for (int i = 0; i < 4; ++i) {
            pi[i] = make_int4(ids[4 * i], ids[4 * i + 1], ids[4 * i + 2], ids[4 * i + 3]);
            pf[i] = f32x4{L[4 * i], L[4 * i + 1], L[4 * i + 2], L[4 * i + 3]};
        }
    }
}

__device__ __forceinline__ void unpack8(const uint4 w, float* f) {
    f[0] = bflo(w.x); f[1] = bfhi(w.x); f[2] = bflo(w.y); f[3] = bfhi(w.y);
    f[4] = bflo(w.z); f[5] = bfhi(w.z); f[6] = bflo(w.w); f[7] = bfhi(w.w);
}
__device__ __forceinline__ void phase_gather(const P& p, char* shm, const int wv) {
    char* ws = p.ws;
    const int tid = opaque_tid(wv), w = tid >> 6, lane = tid & 63;
    const int gw = blockIdx.x * 8 + w, nw = gridDim.x * 8;
    const bf16_t* H1B = (const bf16_t*)(ws + OFF_H1B);
    bf16_t* H2B = (bf16_t*)(ws + OFF_H2B);
    const int* PIDX = (const int*)(ws + OFF_PIDX);
    const float* PS = (const float*)(ws + OFF_PS);
    const bf16_t* UT = (const bf16_t*)(ws + OFF_UT);
    const bf16_t* VT = (const bf16_t*)(ws + OFF_VT);
    float* RS3 = (float*)(ws + OFF_RS3);
    int* eidx = (int*)shm + w * 256;
    float* ew = (float*)shm + w * 256 + 128;
    for (int tok = gw; tok < NT; tok += nw) {
        const uint4* hp = (const uint4*)(H1B + (size_t)tok * 1024);
        const uint4 xa = hp[lane], xb = hp[64 + lane];
        float xf[16];
        unpack8(xa, xf); unpack8(xb, xf + 8);
        float s = 0.f;
#pragma unroll
        for (int i = 0; i < 16; ++i) s += xf[i] * xf[i];
        s = wave_sum(s);
        const float rs2 = rsqrtf(s * (1.f / 1024.f) + EPS);
        const float sc0 = PS[(size_t)tok * 128 + lane] * rs2, sc1 = PS[(size_t)tok * 128 + 64 + lane] * rs2;
        const int id0 = PIDX[(size_t)tok * 128 + lane], id1 = PIDX[(size_t)tok * 128 + 64 + lane];
        const float m0 = row_max16(sc0), m1 = row_max16(sc1);
        const float p0 = __expf(sc0 - m0), p1 = __expf(sc1 - m1);
        const float g0 = p0 / row_sum16(p0), g1 = p1 / row_sum16(p1);
        asm volatile("s_waitcnt lgkmcnt(0)" ::: "memory");
        eidx[lane] = id0; eidx[64 + lane] = id1;
        asm volatile("s_waitcnt lgkmcnt(0)" ::: "memory");
        __builtin_amdgcn_wave_barrier();
        float d0 = 0.f, d1 = 0.f;
#pragma unroll 4
        for (int e = 0; e < 128; ++e) {
            const int id = __builtin_amdgcn_readfirstlane(eidx[e]);
            const uint4* up = (const uint4*)(UT + (size_t)id * 1024);
            const uint4 ua = up[lane], ub = up[64 + lane];
            float d = 0.f, dd = 0.f;
            d = dot2bf(ua.x, xa.x, d); dd = dot2bf(ua.y, xa.y, dd); d = dot2bf(ua.z, xa.z, d); dd = dot2bf(ua.w, xa.w, dd);
            d = dot2bf(ub.x, xb.x, d); dd = dot2bf(ub.y, xb.y, dd); d = dot2bf(ub.z, xb.z, d); dd = dot2bf(ub.w, xb.w, dd);
            d = wave_sum(d + dd);
            if (e < 64) d0 = (lane == e) ? d : d0; else d1 = (lane == e - 64) ? d : d1;
        }
        const float w0 = g0 * gelu_tanh(rs2 * d0), w1 = g1 * gelu_tanh(rs2 * d1);
        ew[lane] = w0; ew[64 + lane] = w1;
        asm volatile("s_waitcnt lgkmcnt(0)" ::: "memory");
        __builtin_amdgcn_wave_barrier();
        float acc[16];
#pragma unroll
        for (int i = 0; i < 16; ++i) acc[i] = 0.f;
#pragma unroll 4
        for (int e = 0; e < 128; ++e) {
            const int id = __builtin_amdgcn_readfirstlane(eidx[e]);
            const float wg = ew[e];
            const uint4* vp = (const uint4*)(VT + (size_t)id * 1024);
            const uint4 va = vp[lane], vb = vp[64 + lane];
            float vf[16];
            unpack8(va, vf); unpack8(vb, vf + 8);
#pragma unroll
            for (int i = 0; i < 16; ++i) acc[i] += wg * vf[i];
        }
        float s3 = 0.f;
#pragma unroll
        for (int i = 0; i < 16; ++i) { acc[i] += xf[i]; }
        uint4 oa, ob;
        oa.x = pk2(acc[0], acc[1]); oa.y = pk2(acc[2], acc[3]); oa.z = pk2(acc[4], acc[5]); oa.w = pk2(acc[6], acc[7]);
        ob.x = pk2(acc[8], acc[9]); ob.y = pk2(acc[10], acc[11]); ob.z = pk2(acc[12], acc[13]); ob.w = pk2(acc[14], acc[15]);
        float of[16];
        unpack8(oa, of); unpack8(ob, of + 8);
#pragma unroll
        for (int i = 0; i < 16; ++i) s3 += of[i] * of[i];
        uint4* op = (uint4*)(H2B + (size_t)tok * 1024);
        op[lane] = oa; op[64 + lane] = ob;
        s3 = wave_sum(s3);
        if (lane == 0) RS3[tok] = rsqrtf(s3 * (1.f / 1024.f) + EPS);
        asm volatile("s_waitcnt lgkmcnt(0)" ::: "memory");
        __builtin_amdgcn_wave_barrier();
    }
}

__global__ void __launch_bounds__(NTHREADS, 2) mega(P p) {
    extern __shared__ __attribute__((aligned(1024))) char shm[];
    cg::grid_group grid = cg::this_grid();
    char* ws = p.ws;
    const int wv = __builtin_amdgcn_readfirstlane((int)(threadIdx.x >> 6));
    const int w = wv;
    const int gw = blockIdx.x * 8 + w, nw = gridDim.x * 8;

    phase_prep(p, wv);
    grid.sync();
    phase_inproj(p, shm, wv);
    grid.sync();
    for (int u = blockIdx.x; u < 1536 + 768; u += gridDim.x) {
        if (u < 1536) attn_unit(p, shm, u, wv); else lru_unit<false>(p, shm, u - 1536, wv);
    }
    grid.sync();
    for (int u = blockIdx.x; u < 768; u += gridDim.x) lru_unit<true>(p, shm, u, wv);
    {
        const bf16_t* AT = (const bf16_t*)(ws + OFF_AT);
        bf16_t* MRG = (bf16_t*)(ws + OFF_MRG);
        const int lane = opaque_tid(wv) & 63;
        for (int tok = gw; tok < NT; tok += nw) {
            const uint4 a = ((const uint4*)(AT + (size_t)tok * 512))[lane];
            float f[8];
            unpack8(a, f);
            float s = 0.f;
#pragma unroll
            for (int i = 0; i < 8; ++i) s += f[i] * f[i];
            s = wave_sum(s);
            const float rs = rsqrtf(s * (1.f / 512.f) + EPS);
            uint4 o;
            o.x = pk2(f[0] * rs, f[1] * rs); o.y = pk2(f[2] * rs, f[3] * rs); o.z = pk2(f[4] * rs, f[5] * rs); o.w = pk2(f[6] * rs, f[7] * rs);
            ((uint4*)(MRG + (size_t)tok * 1024))[lane] = o;
        }
    }
    grid.sync();
    {
        const bf16_t* MRG = (const bf16_t*)(ws + OFF_MRG);
        const bf16_t* W = (const bf16_t*)(ws + OFF_WOUT);
        bf16_t* H1B = (bf16_t*)(ws + OFF_H1B);
        const float *xp = p.x_p, *xs = p.x_s;
        auto epi = [=](int row, int col, f32x4 v0, f32x4 v1) {
            const float* xr = (row < NTP ? xp + (size_t)row * 1024 : xs + (size_t)(row - NTP) * 1024) + col;
            const f32x4 x0 = *(const f32x4*)xr, x1 = *(const f32x4*)(xr + 16);
            bf16_t* dst = H1B + (size_t)row * 1024 + col;
            st4bf(dst, v0 + x0); st4bf(dst + 16, v1 + x1);
        };
        int pm, pn;
        for (int i = 0; gemm_next(i, 4, 384 * 4, pm, pn); ++i) gemm_tile(MRG, W, 1024, pm * 256, pn * 256, shm, wv, epi);
    }
    grid.sync();
    {
        const bf16_t* H1B = (const bf16_t*)(ws + OFF_H1B);
        const bf16_t* W = (const bf16_t*)(ws + OFF_WQ);
        bf16_t* QP = (bf16_t*)(ws + OFF_QP);
        auto epi = [=](int row, int col, f32x4 v0, f32x4 v1) {
            bf16_t* dst = QP + (size_t)row * 2048 + col;
            st4bf(dst, v0); st4bf(dst + 16, v1);
        };
        int pm, pn;
        for (int i = 0; gemm_next(i, 8, 384 * 8, pm, pn); ++i) gemm_tile(H1B, W, 1024, pm * 256, pn * 256, shm, wv, epi);
    }
    grid.sync();
    for (int u = blockIdx.x; u < 1536; u += gridDim.x) score_unit(p, shm, u, wv);
    grid.sync();
    phase_stage2(p, wv);
    grid.sync();
    phase_gather(p, shm, wv);
    grid.sync();
    {
        const bf16_t* H2B = (const bf16_t*)(ws + OFF_H2B);
        const bf16_t* WG = (const bf16_t*)(ws + OFF_WG);
        const bf16_t* PB = (const bf16_t*)(ws + OFF_PB);
        const bf16_t* WP = (const bf16_t*)(ws + OFF_WP);
        const float* RS3 = (const float*)(ws + OFF_RS3);
        bf16_t* G = (bf16_t*)(ws + OFF_G);
        bf16_t* H3 = (bf16_t*)(ws + OFF_H3);
        auto epi_g = [=](int row, int col, f32x4 v0, f32x4 v1) {
            const float rs = RS3[row];
            f32x4 a, b;
#pragma unroll
            for (int j = 0; j < 4; ++j) { a[j] = sigmoidf_(v0[j] * rs); b[j] = sigmoidf_(v1[j] * rs); }
            bf16_t* dst = G + (size_t)row * 1024 + col;
            st4bf(dst, a); st4bf(dst + 16, b);
        };
        auto epi_p = [=](int row, int col, f32x4 v0, f32x4 v1) {
            const size_t off = (size_t)row * 1024 + col;
            const f32x4 g0 = ld4bf(G + off), g1 = ld4bf(G + off + 16);
            const f32x4 h0 = ld4bf(H2B + off), h1 = ld4bf(H2B + off + 16);
            st4bf(H3 + off, h0 + g0 * v0); st4bf(H3 + off + 16, h1 + g1 * v1);
        };
        int pm, pn;
        for (int i = 0; gemm_next(i, 4, 384 * 4, pm, pn); ++i) gemm_tile(H2B, WG, 1024, pm * 256, pn * 256, shm, wv, epi_g);
        for (int i = 0; gemm_next(i, 4, 384 * 4, pm, pn); ++i) gemm_tile(PB, WP, 256, pm * 256, pn * 256, shm, wv, epi_p);
    }
    grid.sync();
    {
        const bf16_t* H3 = (const bf16_t*)(ws + OFF_H3);
        const int lane = opaque_tid(wv) & 63;
        for (int tok = gw; tok < NT; tok += nw) {
            const uint2* hp = (const uint2*)(H3 + (size_t)tok * 1024);
            float f[16];
            float s = 0.f;
#pragma unroll
            for (int j = 0; j < 4; ++j) {
                const uint2 a = hp[lane + 64 * j];
                f[4 * j] = bflo(a.x); f[4 * j + 1] = bfhi(a.x); f[4 * j + 2] = bflo(a.y); f[4 * j + 3] = bfhi(a.y);
            }
#pragma unroll
            for (int i = 0; i < 16; ++i) s += f[i] * f[i];
            s = wave_sum(s);
            const float rs = rsqrtf(s * (1.f / 1024.f) + EPS);
            float4* op = (float4*)(p.out + (size_t)tok * 1024);
#pragma unroll
            for (int j = 0; j < 4; ++j) {
                const float4 g = ((const float4*)p.fin_g)[lane + 64 * j];
                float4 o;
                o.x = f[4 * j] * rs * g.x; o.y = f[4 * j + 1] * rs * g.y; o.z = f[4 * j + 2] * rs * g.z; o.w = f[4 * j + 3] * rs * g.w;
                op[lane + 64 * j] = o;
            }
        }
    }
}

extern "C" void kernel_launch(void* const* d_in, const int* in_sizes, int n_in, void* d_out, int out_size, void* d_ws, size_t ws_size,
                              hipStream_t stream) {
    static int grid = 0;
    if (grid == 0) {
        if (n_in != 26 || ws_size < WS_END) {
            fprintf(stderr, "kernel_launch: unexpected n_in %d or ws_size %zu (< %zu)\n", n_in, ws_size, (size_t)WS_END);
            grid = -1;
            return;
        }
        int dev = 0, cus = 0, per_cu = 0;
        hipGetDevice(&dev);
        hipDeviceGetAttribute(&cus, hipDeviceAttributeMultiprocessorCount, dev);
        hipFuncSetAttribute((const void*)mega, hipFuncAttributeMaxDynamicSharedMemorySize, LDS_BYTES);
        hipOccupancyMaxActiveBlocksPerMultiprocessor(&per_cu, (const void*)mega, NTHREADS, LDS_BYTES);
        if (per_cu < 1) { fprintf(stderr, "kernel_launch: occupancy query says %d blocks/CU\n", per_cu); per_cu = 1; }
        grid = cus * 1;
        (void)hipGetLastError();
    }
    if (grid < 0) return;
    P p{};
    const float** pp = (const float**)&p;
    for (int i = 0; i < 26; ++i) pp[i] = (const float*)d_in[i];
    p.out = (float*)d_out;
    p.ws = (char*)d_ws;
    void* args[] = {&p};
    hipError_t e = hipLaunchCooperativeKernel((const void*)mega, dim3(grid), dim3(NTHREADS), args, LDS_BYTES, stream);
    if (e != hipSuccess) fprintf(stderr, "cooperative launch failed: %s (grid %d)\n", hipGetErrorString(e), grid);
}
```

```cpp
#include <hip/hip_runtime.h>
#include <hip/hip_cooperative_groups.h>
#include <cstdio>
#include <cstdint>
namespace cg = cooperative_groups;

typedef unsigned short bf16_t;
typedef __bf16 bf16x8 __attribute__((ext_vector_type(8)));
typedef __bf16 bf16x2v __attribute__((ext_vector_type(2)));
typedef float f32x4 __attribute__((ext_vector_type(4)));
typedef float f32x16 __attribute__((ext_vector_type(16)));
typedef float f32x2 __attribute__((ext_vector_type(2)));

constexpr int NT = 98304;
constexpr int NTP = 65536;
constexpr float EPS = 1e-6f;
constexpr int LDS_BYTES = 147456;
constexpr int NTHREADS = 512;

constexpr size_t MiB = 1ull << 20;
constexpr size_t OFF_R0 = 0;
constexpr size_t OFF_R1 = 192 * MiB;
constexpr size_t OFF_R2 = 576 * MiB;
constexpr size_t OFF_R3 = 768 * MiB;
constexpr size_t OFF_WIN = OFF_R3;
constexpr size_t OFF_WOUT = OFF_WIN + 1792ull * 1024 * 2;
constexpr size_t OFF_WQ = OFF_WOUT + 1024ull * 1024 * 2;
constexpr size_t OFF_WG = OFF_WQ + 2048ull * 1024 * 2;
constexpr size_t OFF_WP = OFF_WG + 1024ull * 1024 * 2;
constexpr size_t OFF_KEYS = OFF_WP + 1024ull * 256 * 2;
constexpr size_t OFF_UT = OFF_KEYS + 16ull * 128 * 128 * 2;
constexpr size_t OFF_VT = OFF_UT + 16384ull * 1024 * 2;
constexpr size_t OFF_LW = OFF_VT + 16384ull * 1024 * 2;
constexpr size_t OFF_LS = OFF_LW + 2ull * 2 * 8 * 64 * 64 * 2;
constexpr size_t OFF_PB = OFF_LS + 4096;
constexpr size_t OFF_RS1 = OFF_PB + (size_t)NT * 256 * 2;
constexpr size_t OFF_RS3 = OFF_RS1 + (size_t)NT * 4;
constexpr size_t OFF_AGG = OFF_RS3 + (size_t)NT * 4;
constexpr size_t WS_END = OFF_AGG + 768ull * 2 * 1024 * 4;
constexpr size_t OFF_Q = OFF_R1;
constexpr size_t OFF_KB = OFF_R1 + 96 * MiB;
constexpr size_t OFF_VB = OFF_R1 + 120 * MiB;
constexpr size_t OFF_XR = OFF_R1 + 144 * MiB;
constexpr size_t OFF_GR = OFF_R1 + 240 * MiB;
constexpr size_t OFF_QP = OFF_R1;
constexpr size_t OFF_H2B = OFF_R1;
constexpr size_t OFF_G = OFF_R1 + 192 * MiB;
constexpr size_t OFF_AT = OFF_R2;
constexpr size_t OFF_HF = OFF_R2 + 96 * MiB;
constexpr size_t OFF_H1B = OFF_R2;
constexpr size_t OFF_XB = OFF_R0;
constexpr size_t OFF_MRG = OFF_R0;
constexpr size_t OFF_SUBS = OFF_R0;
constexpr size_t OFF_PIDX = OFF_R0 + 96 * MiB;
constexpr size_t OFF_PS = OFF_R0 + 144 * MiB;
constexpr size_t OFF_H3 = OFF_R0;

struct P {
    const float *x_p, *x_s, *p_p, *p_s, *mix_g, *w_in, *sink, *conv_w, *conv_b, *lru_wa, *lru_ba, *lru_wx, *lru_bx, *lru_lam,
        *attn_g, *lru_g, *w_out, *ffn_g, *peer_wq, *peer_keys, *peer_u, *peer_v, *ple_g, *ple_wg, *ple_wp, *fin_g;
    float* out;
    char* ws;
};

__device__ __forceinline__ int opaque_tid(int wv) { unsigned z = 0; asm volatile("" : "+v"(z)); int l = __builtin_amdgcn_mbcnt_hi(~0u, __builtin_amdgcn_mbcnt_lo(~0u, z)); return wv * 64 + l; }
__device__ __forceinline__ unsigned pk2(float lo, float hi) {
    unsigned r;
    asm("v_cvt_pk_bf16_f32 %0, %1, %2" : "=v"(r) : "v"(lo), "v"(hi));
    return r;
}
__device__ __forceinline__ float bflo(unsigned w) { return __uint_as_float(w << 16); }
__device__ __forceinline__ float bfhi(unsigned w) { return __uint_as_float(w & 0xffff0000u); }
__device__ __forceinline__ float bf1(bf16_t h) { return __uint_as_float((unsigned)h << 16); }
__device__ __forceinline__ void st4bf(bf16_t* dst, f32x4 v) {
    uint2 o; o.x = pk2(v[0], v[1]); o.y = pk2(v[2], v[3]);
    *(uint2*)dst = o;
}
__device__ __forceinline__ f32x4 ld4bf(const bf16_t* src) {
    uint2 o = *(const uint2*)src;
    f32x4 v; v[0] = bflo(o.x); v[1] = bfhi(o.x); v[2] = bflo(o.y); v[3] = bfhi(o.y);
    return v;
}
__device__ __forceinline__ float dppf(float v, const int ctrl_sel) {
    int t = 0;
    if (ctrl_sel == 0) t = __builtin_amdgcn_update_dpp(0, __float_as_int(v), 0xB1, 0xf, 0xf, true);
    else if (ctrl_sel == 1) t = __builtin_amdgcn_update_dpp(0, __float_as_int(v), 0x4E, 0xf, 0xf, true);
    else if (ctrl_sel == 2) t = __builtin_amdgcn_update_dpp(0, __float_as_int(v), 0x141, 0xf, 0xf, true);
    else t = __builtin_amdgcn_update_dpp(0, __float_as_int(v), 0x140, 0xf, 0xf, true);
    return __int_as_float(t);
}
__device__ __forceinline__ float row_max16(float v) {
    v = fmaxf(v, dppf(v, 0)); v = fmaxf(v, dppf(v, 1)); v = fmaxf(v, dppf(v, 2)); v = fmaxf(v, dppf(v, 3));
    return v;
}
__device__ __forceinline__ float row_sum16(float v) {
    v += dppf(v, 0); v += dppf(v, 1); v += dppf(v, 2); v += dppf(v, 3);
    return v;
}
__device__ __forceinline__ float wave_sum(float v) {
    v = row_sum16(v);
    v += __int_as_float(__builtin_amdgcn_ds_swizzle(__float_as_int(v), 0x401F));
    return __int_as_float(__builtin_amdgcn_readlane(__float_as_int(v), 0)) + __int_as_float(__builtin_amdgcn_readlane(__float_as_int(v), 32));
}
__device__ __forceinline__ float xor32(float v, int lane) {
    return __int_as_float(__builtin_amdgcn_ds_bpermute((lane ^ 32) << 2, __float_as_int(v)));
}
__device__ __forceinline__ float sigmoidf_(float x) { return 1.f / (1.f + __expf(-x)); }
__device__ __forceinline__ float gelu_tanh(float x) {
    float y = 0.7978845608028654f * (x + 0.044715f * x * x * x);
    float t = 1.f - 2.f / (1.f + __expf(2.f * y));
    return 0.5f * x * (1.f + t);
}
__device__ __forceinline__ int tok_pos(int g) { return g < NTP ? (g & 2047) : (g & 16383); }
__device__ __forceinline__ void tile_seq(int blk, int& c, int& nc) {
    if (blk < 512) { c = blk & 15; nc = 16; } else { c = (blk - 512) & 127; nc = 128; }
}
__device__ __forceinline__ float dot2bf(unsigned a, unsigned b, float acc) {
    return __builtin_amdgcn_fdot2_f32_bf16(__builtin_bit_cast(bf16x2v, a), __builtin_bit_cast(bf16x2v, b), acc, false);
}

__device__ __forceinline__ int lds_byte(int r, int c) {
    int st = (r >> 4) * 2 + (c >> 5), ob = (r & 15) * 64 + (c & 31) * 2;
    return st * 1024 + (ob ^ (((ob >> 9) & 1) << 5));
}
__device__ __forceinline__ void stage_rc(int b, int& R, int& C) {
    int st = b >> 10, sb = b & 1023, swz = sb ^ (((sb >> 9) & 1) << 5);
    R = (st / 2) * 16 + swz / 64;
    C = (st % 2) * 32 + (swz % 64) / 2;
}
#define WAIT_V0() asm volatile("s_waitcnt vmcnt(0)" ::: "memory")

template <class Epi>
__device__ __forceinline__ void gemm_tile(const bf16_t* __restrict__ A, const bf16_t* __restrict__ Bt, const int K,
                                          const int brow, const int bcol, char* shm, const int wv, Epi epi) {
    constexpr int BK = 64, TILE_B = 256 * BK * 2, GL = 4, STAGE_B = 2 * TILE_B;
    const int tid = opaque_tid(wv), wid = tid >> 6, lane = tid & 63, wr = wid >> 2, wc = wid & 3, fr = lane & 15, fq = lane >> 4;
    const bf16_t* Ab = A + (size_t)brow * K;
    const bf16_t* Bb = Bt + (size_t)bcol * K;
    int sR[GL], sC[GL];
#pragma unroll
    for (int i = 0; i < GL; ++i) stage_rc(wid * 1024 + i * 8192 + lane * 16, sR[i], sC[i]);
    f32x4 acc[8][4];
#pragma unroll
    for (int m = 0; m < 8; ++m)
#pragma unroll
        for (int n = 0; n < 4; ++n) acc[m][n] = f32x4{0.f, 0.f, 0.f, 0.f};
    const int nt = K / BK;
#define GSTAGE(buf, kt)                                                                                              \
    do {                                                                                                             \
        _Pragma("unroll") for (int i = 0; i < GL; ++i) {                                                             \
            __builtin_amdgcn_global_load_lds((const unsigned*)(Ab + (size_t)sR[i] * K + (kt) * BK + sC[i]),          \
                                             (unsigned*)(shm + (buf) * STAGE_B + wid * 1024 + i * 8192), 16, 0, 0);   \
            __builtin_amdgcn_global_load_lds((const unsigned*)(Bb + (size_t)sR[i] * K + (kt) * BK + sC[i]),          \
                                             (unsigned*)(shm + (buf) * STAGE_B + TILE_B + wid * 1024 + i * 8192), 16, 0, 0); \
        }                                                                                                            \
    } while (0)
    __syncthreads();
    GSTAGE(0, 0);
    WAIT_V0();
    __syncthreads();
    for (int t = 0; t < nt; ++t) {
        const int cur = t & 1;
        if (t + 1 < nt) GSTAGE(cur ^ 1, t + 1);
        const char* sa = shm + cur * STAGE_B;
        const char* sb = sa + TILE_B;
#pragma unroll
        for (int ks = 0; ks < 2; ++ks) {
            bf16x8 At[8], Bf[4];
#pragma unroll
            for (int m = 0; m < 8; ++m) At[m] = *(const bf16x8*)(sa + lds_byte(wr * 128 + m * 16 + fr, ks * 32 + fq * 8));
#pragma unroll
            for (int n = 0; n < 4; ++n) Bf[n] = *(const bf16x8*)(sb + lds_byte(wc * 64 + n * 16 + fr, ks * 32 + fq * 8));
#pragma unroll
            for (int m = 0; m < 8; ++m)
#pragma unroll
                for (int n = 0; n < 4; ++n) acc[m][n] = __builtin_amdgcn_mfma_f32_16x16x32_bf16(Bf[n], At[m], acc[m][n], 0, 0, 0);
            __builtin_amdgcn_sched_barrier(0);
        }
        WAIT_V0();
        __syncthreads();
    }
#undef GSTAGE
#pragma unroll
    for (int m = 0; m < 8; ++m) {
        const int row = brow + wr * 128 + m * 16 + fr;
#pragma unroll
        for (int np = 0; np < 2; ++np) {
            const int col = bcol + wc * 64 + np * 32 + fq * 4;
            epi(row, col, acc[m][2 * np], acc[m][2 * np + 1]);
        }
    }
}

__device__ __forceinline__ bool gemm_next(int i, int nN, int nTiles, int& pm, int& pn) {
    const int G = gridDim.x, b = blockIdx.x;
    int v = b;
    if ((G & 7) == 0) v = (b & 7) * (G >> 3) + (b >> 3);
    const int L = i * G + v;
    if (L >= nTiles) return false;
    pm = L / nN; pn = L % nN;
    return true;
}

template <class NMap, class Scale>
__device__ __forceinline__ void prep_wT(const float* __restrict__ src, bf16_t* __restrict__ dst, int K, int N, int gtid, int gstride,
                                        NMap nmap, Scale scale) {
    const int items = N * (K / 8);
    for (int it = gtid; it < items; it += gstride) {
        const int n = it % N, k0 = (it / N) * 8;
        const int ns = nmap(n);
        float v[8];
#pragma unroll
        for (int i = 0; i < 8; ++i) v[i] = src[(size_t)(k0 + i) * N + ns] * scale(k0 + i);
        uint4 o; o.x = pk2(v[0], v[1]); o.y = pk2(v[2], v[3]); o.z = pk2(v[4], v[5]); o.w = pk2(v[6], v[7]);
        *(uint4*)(dst + (size_t)n * K + k0) = o;
    }
}

__device__ __forceinline__ void phase_prep(const P& p, const int wv) {
    const int gtid = blockIdx.x * NTHREADS + opaque_tid(wv), gstride = gridDim.x * NTHREADS;
    const int lane = gtid & 63, gw = gtid >> 6, nw = gstride >> 6;
    char* ws = p.ws;
    {
        const float* g = p.mix_g;
        prep_wT(p.w_in, (bf16_t*)(ws + OFF_WIN), 1024, 1792, gtid, gstride,
                [](int n) { if (n >= 640) return n; int pp = n & 63; return (n & ~63) + (pp >> 5) * 16 + ((pp >> 4) & 1) * 32 + (pp & 15); },
                [g](int k) { return g[k]; });
    }
    {
        const float *ga = p.attn_g, *gl = p.lru_g;
        prep_wT(p.w_out, (bf16_t*)(ws + OFF_WOUT), 1024, 1024, gtid, gstride, [](int n) { return n; },
                [ga, gl](int k) { return k < 512 ? ga[k] : gl[k - 512]; });
    }
    {
        const float* g = p.ffn_g;
        prep_wT(p.peer_wq, (bf16_t*)(ws + OFF_WQ), 1024, 2048, gtid, gstride, [](int n) { return n; }, [g](int k) { return g[k]; });
    }
    {
        const float* g = p.ple_g;
        prep_wT(p.ple_wg, (bf16_t*)(ws + OFF_WG), 1024, 1024, gtid, gstride, [](int n) { return n; }, [g](int k) { return g[k]; });
    }
    prep_wT(p.ple_wp, (bf16_t*)(ws + OFF_WP), 256, 1024, gtid, gstride, [](int n) { return n; }, [](int) { return 1.f; });
    {
        bf16_t* kb = (bf16_t*)(ws + OFF_KEYS);
        for (int i = gtid; i < 16 * 128 * 128 / 2; i += gstride) {
            float2 v = ((const float2*)p.peer_keys)[i];
            ((unsigned*)kb)[i] = pk2(v.x, v.y);
        }
    }
    {
        bf16_t* lw = (bf16_t*)(ws + OFF_LW);
        for (int i = gtid; i < 2 * 2 * 8 * 64 * 64; i += gstride) {
            const int s = i & 63, j = (i >> 6) & 63, h = (i >> 12) & 7, mat = (i >> 15) & 1, dir = (i >> 16) & 1;
            const int ks = s >> 4, hf = (s >> 3) & 1, e = s & 7;
            const int ii = 16 * ks + 8 * (e >> 2) + 4 * hf + (e & 3);
            const float* src = mat ? p.lru_wx : p.lru_wa;
            const float v = src[(((size_t)dir * 8 + h) * 64 + ii) * 64 + j];
            lw[i] = (bf16_t)(pk2(v, 0.f) & 0xffff);
        }
        float* ls = (float*)(ws + OFF_LS);
        for (int i = gtid; i < 1024; i += gstride) {
            const float lam = p.lru_lam[i];
            ls[i] = lam >= 0.f ? -log1pf(expf(-lam)) : lam - log1pf(expf(lam));
        }
    }
    {
        const float* g = p.ffn_g;
        const float4* us = (const float4*)p.peer_u;
        const float4* vs = (const float4*)p.peer_v;
        uint4* ud = (uint4*)(ws + OFF_UT);
        uint4* vd = (uint4*)(ws + OFF_VT);
        for (int i = gtid; i < 16384 * 64; i += gstride) {
            unsigned uo[4], vo[4];
#pragma unroll
            for (int q = 0; q < 4; ++q) {
                const float4 u = us[(size_t)i * 4 + q], v = vs[(size_t)i * 4 + q];
                const float4 gg = ((const float4*)g)[(i * 4 + q) & 255];
                int a = __builtin_amdgcn_cvt_pk_fp8_f32(u.x * gg.x * 64.f, u.y * gg.y * 64.f, 0, false);
                a = __builtin_amdgcn_cvt_pk_fp8_f32(u.z * gg.z * 64.f, u.w * gg.w * 64.f, a, true);
                int b = __builtin_amdgcn_cvt_pk_fp8_f32(v.x * 8.f, v.y * 8.f, 0, false);
                b = __builtin_amdgcn_cvt_pk_fp8_f32(v.z * 8.f, v.w * 8.f, b, true);
                uo[q] = (unsigned)a; vo[q] = (unsigned)b;
            }
            ud[i] = make_uint4(uo[0], uo[1], uo[2], uo[3]);
            vd[i] = make_uint4(vo[0], vo[1], vo[2], vo[3]);
        }
    }
    {
        uint2* pd = (uint2*)(ws + OFF_PB);
        for (int i = gtid; i < NT * 64; i += gstride) {
            const float4 v = i < NTP * 64 ? ((const float4*)p.p_p)[i] : ((const float4*)p.p_s)[i - NTP * 64];
            uint2 a; a.x = pk2(v.x, v.y); a.y = pk2(v.z, v.w);
            pd[i] = a;
        }
    }
    {
        bf16_t* xb = (bf16_t*)(ws + OFF_XB);
        float* rs1 = (float*)(ws + OFF_RS1);
        for (int tok = gw; tok < NT; tok += nw) {
            const float4* xr = (const float4*)(tok < NTP ? p.x_p + (size_t)tok * 1024 : p.x_s + (size_t)(tok - NTP) * 1024);
            float s = 0.f;
            uint2* od = (uint2*)(xb + (size_t)tok * 1024);
#pragma unroll
            for (int j = 0; j < 4; ++j) {
                const float4 v = xr[lane + 64 * j];
                s += v.x * v.x + v.y * v.y + v.z * v.z + v.w * v.w;
                uint2 a; a.x = pk2(v.x, v.y); a.y = pk2(v.z, v.w);
                od[lane + 64 * j] = a;
            }
            s = wave_sum(s);
            if (lane == 0) rs1[tok] = rsqrtf(s * (1.f / 1024.f) + EPS);
        }
    }
}

__device__ __forceinline__ void phase_inproj(const P& p, char* shm, const int wv) {
    char* ws = p.ws;
    const bf16_t* XB = (const bf16_t*)(ws + OFF_XB);
    const bf16_t* W = (const bf16_t*)(ws + OFF_WIN);
    const float* RS1 = (const float*)(ws + OFF_RS1);
    bf16_t* Q = (bf16_t*)(ws + OFF_Q);
    bf16_t* KB = (bf16_t*)(ws + OFF_KB);
    bf16_t* VB = (bf16_t*)(ws + OFF_VB);
    bf16_t* XR = (bf16_t*)(ws + OFF_XR);
    bf16_t* GR = (bf16_t*)(ws + OFF_GR);
    auto epi = [=](int row, int col, f32x4 v0, f32x4 v1) {
        const float rs = RS1[row];
        v0 *= rs; v1 *= rs;
        if (col < 640) {
            const int pos = tok_pos(row);
            const int d0 = ((col & 63) >> 5) * 16 + (col & 15);
            f32x4 o0, o1;
#pragma unroll
            for (int j = 0; j < 4; ++j) {
                const float invf = exp2f(-(float)(d0 + j) * 0.41524101186092029f);
                const float ang = (float)pos * invf;
                const float nrev = rintf(ang * 0.15915494309189535f);
                float rr = fmaf(-nrev, 6.28125f, ang);
                rr = fmaf(-nrev, 0.0019353071795864769f, rr);
                const float cs = __cosf(rr), sn = __sinf(rr);
                o0[j] = v0[j] * cs - v1[j] * sn;
                o1[j] = v1[j] * cs + v0[j] * sn;
            }
            if (col < 512) {
                o0 *= 0.125f; o1 *= 0.125f;
                bf16_t* dst = Q + (size_t)row * 512 + (col & ~63) + d0;
                st4bf(dst, o0); st4bf(dst + 32, o1);
            } else {
                bf16_t* dst = KB + (size_t)row * 128 + ((col - 512) & ~63) + d0;
                st4bf(dst, o0); st4bf(dst + 32, o1);
            }
        } else if (col < 768) {
            bf16_t* dst = VB + (size_t)row * 128 + (col - 640);
            st4bf(dst, v0); st4bf(dst + 16, v1);
        } else if (col < 1280) {
            bf16_t* dst = XR + (size_t)row * 512 + (col - 768);
            st4bf(dst, v0); st4bf(dst + 16, v1);
        } else {
            bf16_t* dst = GR + (size_t)row * 512 + (col - 1280);
            f32x4 g0, g1;
#pragma unroll
            for (int j = 0; j < 4; ++j) { g0[j] = gelu_tanh(v0[j]); g1[j] = gelu_tanh(v1[j]); }
            st4bf(dst, g0); st4bf(dst + 16, g1);
        }
    };
    int pm, pn;
    for (int i = 0; gemm_next(i, 7, 384 * 7, pm, pn); ++i) gemm_tile(XB, W, 1024, pm * 256, pn * 256, shm, wv, epi);
}

__device__ __forceinline__ void attn_unit(const P& p, char* shm, int unit, const int wv) {
    char* ws = p.ws;
    const int blk = unit >> 1, kvh = unit & 1;
    int c, nc; tile_seq(blk, c, nc);
    const int g0 = blk * 128;
    bf16_t* Ks = (bf16_t*)shm;
    bf16_t* Vt = (bf16_t*)(shm + 55296);
    const bf16_t* KB = (const bf16_t*)(ws + OFF_KB);
    const bf16_t* VB = (const bf16_t*)(ws + OFF_VB);
    const bf16_t* Q = (const bf16_t*)(ws + OFF_Q);
    bf16_t* AT = (bf16_t*)(ws + OFF_AT);
    const int tid = opaque_tid(wv), w = tid >> 6, lane = tid & 63, half = lane >> 5, tl = lane & 31;
    __syncthreads();
    for (int item = tid; item < 384 * 8; item += NTHREADS) {
        const int key = item % 384, part = item / 384;
        const int ch = key >> 7;
        if ((ch == 0 && c == 0) || (ch == 2 && c == nc - 1)) continue;
        const size_t tok = (size_t)(g0 - 128 + key);
        const uint4 kv = *(const uint4*)(KB + tok * 128 + kvh * 64 + part * 8);
        *(uint4*)(Ks + key * 72 + part * 8) = kv;
        const uint4 vv = *(const uint4*)(VB + tok * 128 + kvh * 64 + part * 8);
        bf16_t* vd = Vt + (part * 8) * 388 + key;
        vd[0 * 388] = (bf16_t)(vv.x & 0xffff); vd[1 * 388] = (bf16_t)(vv.x >> 16);
        vd[2 * 388] = (bf16_t)(vv.y & 0xffff); vd[3 * 388] = (bf16_t)(vv.y >> 16);
        vd[4 * 388] = (bf16_t)(vv.z & 0xffff); vd[5 * 388] = (bf16_t)(vv.z >> 16);
        vd[6 * 388] = (bf16_t)(vv.w & 0xffff); vd[7 * 388] = (bf16_t)(vv.w >> 16);
    }
    __syncthreads();
    for (int it = 0; it < 2; ++it) {
        const int task = w + 8 * it;
        const int qhl = task & 3, rg = task >> 2;
        const int hq = kvh * 4 + qhl;
        const int qrow = rg * 32 + tl;
        const bf16_t* qp = Q + (size_t)(g0 + qrow) * 512 + hq * 64 + half * 8;
        bf16x8 qf[4];
#pragma unroll
        for (int ks = 0; ks < 4; ++ks) qf[ks] = *(const bf16x8*)(qp + ks * 16);
        float m = p.sink[hq];
        float l = half == 0 ? 1.f : 0.f;
        f32x16 O0, O1;
#pragma unroll
        for (int i = 0; i < 16; ++i) { O0[i] = 0.f; O1[i] = 0.f; }
        for (int ch = 0; ch < 3; ++ch) {
            if ((ch == 0 && c == 0) || (ch == 2 && c == nc - 1)) continue;
            f32x16 S[4];
#pragma unroll
            for (int kb = 0; kb < 4; ++kb) {
#pragma unroll
                for (int i = 0; i < 16; ++i) S[kb][i] = 0.f;
#pragma unroll
                for (int ks = 0; ks < 4; ++ks) {
                    const bf16x8 kf = *(const bf16x8*)(Ks + (ch * 128 + kb * 32 + tl) * 72 + ks * 16 + half * 8);
                    S[kb] = __builtin_amdgcn_mfma_f32_32x32x16_bf16(kf, qf[ks], S[kb], 0, 0, 0);
                }
            }
            float mx = -INFINITY;
#pragma unroll
            for (int kb = 0; kb < 4; ++kb)
#pragma unroll
                for (int i = 0; i < 16; ++i) {
                    const int kk = kb * 32 + 8 * (i >> 2) + 4 * half + (i & 3);
                    const bool valid = (ch == 1) || (ch == 0 ? kk >= qrow : kk <= qrow);
                    const float s = valid ? S[kb][i] : -INFINITY;
                    S[kb][i] = s;
                    mx = fmaxf(mx, s);
                }
            mx = fmaxf(mx, xor32(mx, lane));
            const float mn = fmaxf(m, mx);
            const float alpha = __expf(m - mn);
            m = mn;
            float ps = 0.f;
#pragma unroll
            for (int kb = 0; kb < 4; ++kb)
#pragma unroll
                for (int i = 0; i < 16; ++i) {
                    const float pv = __expf(S[kb][i] - mn);
                    S[kb][i] = pv;
                    ps += pv;
                }
            l = l * alpha + ps;
#pragma unroll
            for (int i = 0; i < 16; ++i) { O0[i] *= alpha; O1[i] *= alpha; }
#pragma unroll
            for (int kb = 0; kb < 4; ++kb)
#pragma unroll
                for (int s2 = 0; s2 < 2; ++s2) {
                    uint4 pw;
                    pw.x = pk2(S[kb][8 * s2 + 0], S[kb][8 * s2 + 1]); pw.y = pk2(S[kb][8 * s2 + 2], S[kb][8 * s2 + 3]);
                    pw.z = pk2(S[kb][8 * s2 + 4], S[kb][8 * s2 + 5]); pw.w = pk2(S[kb][8 * s2 + 6], S[kb][8 * s2 + 7]);
                    const bf16x8 pf = __builtin_bit_cast(bf16x8, pw);
                    const bf16_t* vp = Vt + tl * 388 + ch * 128 + kb * 32 + 16 * s2 + 4 * half;
                    uint4 vw;
                    uint2 a0 = *(const uint2*)vp, a1 = *(const uint2*)(vp + 8);
                    vw.x = a0.x; vw.y = a0.y; vw.z = a1.x; vw.w = a1.y;
                    O0 = __builtin_amdgcn_mfma_f32_32x32x16_bf16(__builtin_bit_cast(bf16x8, vw), pf, O0, 0, 0, 0);
                    const bf16_t* vp1 = vp + 32 * 388;
                    a0 = *(const uint2*)vp1; a1 = *(const uint2*)(vp1 + 8);
                    vw.x = a0.x; vw.y = a0.y; vw.z = a1.x; vw.w = a1.y;
                    O1 = __builtin_amdgcn_mfma_f32_32x32x16_bf16(__builtin_bit_cast(bf16x8, vw), pf, O1, 0, 0, 0);
                }
        }
        const float lt = l + xor32(l, lane);
        const float inv = 1.f / lt;
        bf16_t* op = AT + (size_t)(g0 + qrow) * 512 + hq * 64 + 4 * half;
#pragma unroll
        for (int i4 = 0; i4 < 4; ++i4) {
            f32x4 a, b;
#pragma unroll
            for (int q = 0; q < 4; ++q) { a[q] = O0[4 * i4 + q] * inv; b[q] = O1[4 * i4 + q] * inv; }
            st4bf(op + 8 * i4, a);
            st4bf(op + 32 + 8 * i4, b);
        }
    }
}

template <bool FINAL>
__device__ __forceinline__ void lru_unit(const P& p, char* shm, int blk, const int wv) {
    char* ws = p.ws;
    int c, nc; tile_seq(blk, c, nc);
    const int g0 = blk * 128;
    const int seq_lo = g0 - c * 128, seq_hi = seq_lo + nc * 128;
    const int tid = opaque_tid(wv), w = tid >> 6, lane = tid & 63, half = lane >> 5, tl = lane & 31;
    float* abuf = (float*)shm + w * (2 * 32 * 68);
    float* ubuf = abuf + 32 * 68;
    float* ssq = (float*)(shm + 139264);
    const bf16_t* XR = (const bf16_t*)(ws + OFF_XR);
    const bf16_t* GR = (const bf16_t*)(ws + OFF_GR);
    const bf16_t* LW = (const bf16_t*)(ws + OFF_LW);
    const float* LS = (const float*)(ws + OFF_LS);
    float* AGG = (float*)(ws + OFF_AGG);
    bf16_t* HF = (bf16_t*)(ws + OFF_HF);
    bf16_t* MRG = (bf16_t*)(ws + OFF_MRG);
    const int chn = w * 64 + lane;
    if (FINAL) {
        __syncthreads();
        if (tid < 32) ssq[tid] = 0.f;
    }
    for (int dir = 0; dir < 2; ++dir) {
        float h = 0.f, Ap = 1.f;
        if (FINAL) {
            if (dir == 0) {
                for (int cc = 0; cc < c; ++cc) {
                    const int tile = blk - c + cc;
                    const float A_ = AGG[(size_t)(tile * 2 + 0) * 1024 + chn], H_ = AGG[(size_t)(tile * 2 + 0) * 1024 + 512 + chn];
                    h = A_ * h + H_;
                }
            } else {
                for (int cc = nc - 1; cc > c; --cc) {
                    const int tile = blk - c + cc;
                    const float A_ = AGG[(size_t)(tile * 2 + 1) * 1024 + chn], H_ = AGG[(size_t)(tile * 2 + 1) * 1024 + 512 + chn];
                    h = A_ * h + H_;
                }
            }
        }
        for (int ibi = 0; ibi < 4; ++ibi) {
            const int ib = dir ? 3 - ibi : ibi;
            const int t0 = g0 + ib * 32;
            const int t = t0 + tl;
            float xcv[4][8];
#pragma unroll
            for (int ks = 0; ks < 4; ++ks)
#pragma unroll
                for (int grp = 0; grp < 2; ++grp) {
                    const int cb4 = w * 64 + 16 * ks + 8 * grp + 4 * half;
                    f32x4 a = *(const f32x4*)(p.conv_b + cb4);
#pragma unroll
                    for (int j = 0; j < 4; ++j) {
                        const int tt = t + j - 2;
                        if (tt >= seq_lo && tt < seq_hi) {
                            const f32x4 xv = ld4bf(XR + (size_t)tt * 512 + cb4);
                            const f32x4 wv = *(const f32x4*)(p.conv_w + j * 512 + cb4);
                            a += wv * xv;
                        }
                    }
#pragma unroll
                    for (int q = 0; q < 4; ++q) xcv[ks][grp * 4 + q] = a[q];
                }
            bf16x8 xb[4];
#pragma unroll
            for (int ks = 0; ks < 4; ++ks) {
                uint4 pw;
                pw.x = pk2(xcv[ks][0], xcv[ks][1]); pw.y = pk2(xcv[ks][2], xcv[ks][3]);
                pw.z = pk2(xcv[ks][4], xcv[ks][5]); pw.w = pk2(xcv[ks][6], xcv[ks][7]);
                xb[ks] = __builtin_bit_cast(bf16x8, pw);
            }
            __syncthreads();
#pragma unroll
            for (int cb = 0; cb < 2; ++cb) {
                f32x16 aa, ax;
#pragma unroll
                for (int i = 0; i < 16; ++i) { aa[i] = 0.f; ax[i] = 0.f; }
#pragma unroll
                for (int ks = 0; ks < 4; ++ks) {
                    const bf16x8 wa = *(const bf16x8*)(LW + ((size_t)((dir * 2 + 0) * 8 + w) * 64 + cb * 32 + tl) * 64 + ks * 16 + half * 8);
                    const bf16x8 wx = *(const bf16x8*)(LW + ((size_t)((dir * 2 + 1) * 8 + w) * 64 + cb * 32 + tl) * 64 + ks * 16 + half * 8);
                    aa = __builtin_amdgcn_mfma_f32_32x32x16_bf16(wa, xb[ks], aa, 0, 0, 0);
                    ax = __builtin_amdgcn_mfma_f32_32x32x16_bf16(wx, xb[ks], ax, 0, 0, 0);
                }
#pragma unroll
                for (int r4 = 0; r4 < 4; ++r4) {
                    const int j0 = cb * 32 + 8 * r4 + 4 * half;
                    const int ch4 = w * 64 + j0;
                    const f32x4 ba4 = *(const f32x4*)(p.lru_ba + dir * 512 + ch4);
                    const f32x4 bx4 = *(const f32x4*)(p.lru_bx + dir * 512 + ch4);
                    const f32x4 ls4 = *(const f32x4*)(LS + dir * 512 + ch4);
                    f32x4 av, uv;
#pragma unroll
                    for (int q = 0; q < 4; ++q) {
                        const int r = 4 * r4 + q;
                        const float xcval = xcv[2 * cb + (r4 >> 1)][4 * (r4 & 1) + q];
                        const float rgate = sigmoidf_(aa[r] + ba4[q]);
                        const float igate = sigmoidf_(ax[r] + bx4[q]);
                        const float la = 8.f * rgate * ls4[q];
                        av[q] = __expf(la);
                        uv[q] = sqrtf(fmaxf(0.f, 1.f - __expf(2.f * la))) * igate * xcval;
                    }
                    *(f32x4*)(abuf + tl * 68 + j0) = av;
                    *(f32x4*)(ubuf + tl * 68 + j0) = uv;
                }
            }
            __syncthreads();
            float val[32];
#pragma unroll
            for (int tt = 0; tt < 32; ++tt) {
                const int tloc = dir ? 31 - tt : tt;
                const float a = abuf[tloc * 68 + lane], u = ubuf[tloc * 68 + lane];
                h = a * h + u;
                Ap *= a;
                if (FINAL) {
                    const size_t off = (size_t)(t0 + tloc) * 512 + chn;
                    if (dir == 0) {
                        HF[off] = (bf16_t)(pk2(h, 0.f) & 0xffff);
                    } else {
                        const float hf = bf1(HF[off]);
                        const float gg = bf1(GR[off]);
                        const float v = gg * (hf + h);
                        val[tt] = v;
                        const float s = wave_sum(v * v);
                        if (lane == 0) atomicAdd(&ssq[tloc], s);
                    }
                }
            }
            if (FINAL && dir == 1) {
                __syncthreads();
#pragma unroll
                for (int tt = 0; tt < 32; ++tt) {
                    const int tloc = 31 - tt;
                    const float rs = rsqrtf(ssq[tloc] * (1.f / 512.f) + EPS);
                    MRG[(size_t)(t0 + tloc) * 1024 + 512 + chn] = (bf16_t)(pk2(val[tt] * rs, 0.f) & 0xffff);
                }
                __syncthreads();
                if (tid < 32) ssq[tid] = 0.f;
            }
        }
        if (!FINAL) {
            AGG[(size_t)(blk * 2 + dir) * 1024 + chn] = Ap;
            AGG[(size_t)(blk * 2 + dir) * 1024 + 512 + chn] = h;
        }
    }
}

__device__ __forceinline__ void score_unit(const P& p, char* shm, int unit, const int wv) {
    char* ws = p.ws;
    const int sp = unit & 15, tg = unit >> 4;
    const int tid = opaque_tid(wv), w = tid >> 6, lane = tid & 63, fr = lane & 15, fq = lane >> 4;
    bf16_t* KL = (bf16_t*)shm;
    const bf16_t* KEYS = (const bf16_t*)(ws + OFF_KEYS) + (size_t)sp * 16384;
    const bf16_t* QP = (const bf16_t*)(ws + OFF_QP);
    float* SUBS = (float*)(ws + OFF_SUBS);
    __syncthreads();
    for (int i = tid; i < 2048; i += NTHREADS) {
        const int r = i >> 4, cpart = i & 15;
        *(uint4*)(KL + r * 136 + cpart * 8) = *(const uint4*)(KEYS + r * 128 + cpart * 8);
    }
    __syncthreads();
    for (int tt = 0; tt < 8; ++tt) {
        const int gb = (tg * 8 + tt) * 128 + w * 16;
        bf16x8 af[4];
#pragma unroll
        for (int ks = 0; ks < 4; ++ks) af[ks] = *(const bf16x8*)(QP + (size_t)(gb + fr) * 2048 + sp * 128 + ks * 32 + fq * 8);
        float v[4][8];
#pragma unroll
        for (int nb = 0; nb < 8; ++nb) {
            f32x4 acc = {0.f, 0.f, 0.f, 0.f};
#pragma unroll
            for (int ks = 0; ks < 4; ++ks) {
                const bf16x8 bf = *(const bf16x8*)(KL + (nb * 16 + fr) * 136 + ks * 32 + fq * 8);
                acc = __builtin_amdgcn_mfma_f32_16x16x32_bf16(af[ks], bf, acc, 0, 0, 0);
            }
#pragma unroll
            for (int i = 0; i < 4; ++i) v[i][nb] = __uint_as_float((__float_as_uint(acc[i]) & ~127u) | (unsigned)(nb * 16 + fr));
        }
        float keep[4] = {0.f, 0.f, 0.f, 0.f};
        for (int r = 0; r < 16; ++r) {
#pragma unroll
            for (int i = 0; i < 4; ++i) {
                float lm = v[i][0];
#pragma unroll
                for (int nb = 1; nb < 8; ++nb) lm = fmaxf(lm, v[i][nb]);
                const float rm = row_max16(lm);
                keep[i] = (fr == r) ? rm : keep[i];
#pragma unroll
                for (int nb = 0; nb < 8; ++nb) v[i][nb] = (v[i][nb] == rm) ? -INFINITY : v[i][nb];
            }
        }
#pragma unroll
        for (int i = 0; i < 4; ++i) SUBS[(size_t)(gb + 4 * fq + i) * 256 + sp * 16 + fr] = keep[i];
    }
}

__device__ __forceinline__ void phase_stage2(const P& p, const int wv) {
    char* ws = p.ws;
    const float* SUBS = (const float*)(ws + OFF_SUBS);
    int* PIDX = (int*)(ws + OFF_PIDX);
    float* PS = (float*)(ws + OFF_PS);
    const int gtid = blockIdx.x * NTHREADS + opaque_tid(wv), gstride = gridDim.x * NTHREADS;
    for (int idx = gtid; idx < NT * 8; idx += gstride) {
        const int tok = idx >> 3, hh = idx & 7;
        const float* s0p = SUBS + (size_t)tok * 256 + hh * 32;
        const float* s1p = s0p + 16;
        float s0[16], s1[16];
#pragma unroll
        for (int i = 0; i < 4; ++i) {
            const f32x4 a = *(const f32x4*)(s0p + 4 * i), b = *(const f32x4*)(s1p + 4 * i);
#pragma unroll
            for (int q = 0; q < 4; ++q) { s0[4 * i + q] = a[q]; s1[4 * i + q] = b[q]; }
        }
        float L[16];
#pragma unroll
        for (int i = 0; i < 16; ++i) L[i] = -INFINITY;
#pragma unroll
        for (int a = 0; a < 16; ++a)
#pragma unroll
            for (int b = 0; b < 16; ++b) {
                if ((a + 1) * (b + 1) <= 16) {
                    float nv = __uint_as_float((__float_as_uint(s0[a] + s1[b]) & ~255u) | (unsigned)(a * 16 + b));
#pragma unroll
                    for (int i = 0; i < 16; ++i) {
                        const float hi = fmaxf(L[i], nv);
                        nv = fminf(L[i], nv);
                        L[i] = hi;
                    }
                }
            }
        int ids[16];
#pragma unroll
        for (int k = 0; k < 16; ++k) {
            const unsigned code = __float_as_uint(L[k]) & 255u;
            const unsigned i0 = __float_as_uint(s0p[code >> 4]) & 127u;
            const unsigned i1 = __float_as_uint(s1p[code & 15]) & 127u;
            ids[k] = (int)(i0 * 128 + i1);
        }
        int4* pi = (int4*)(PIDX + (size_t)tok * 128 + hh * 16);
        f32x4* pf = (f32x4*)(PS + (size_t)tok * 128 + hh * 16);
#pragma unroll
        for (int i = 0; i < 4; ++i) {
            pi[i] = make_int4(ids[4 * i], ids[4 * i + 1], ids[4 * i + 2], ids[4 * i + 3]);
            pf[i] = f32x4{L[4 * i], L[4 * i + 1], L[4 * i + 2], L[4 * i + 3]};
        }
    }
}

__device__ __forceinline__ void unpack8(const uint4 w, float* f) {
    f[0] = bflo(w.x); f[1] = bfhi(w.x); f[2] = bflo(w.y); f[3] = bfhi(w.y);
    f[4] = bflo(w.z); f[5] = bfhi(w.z); f[6] = bflo(w.w); f[7] = bfhi(w.w);
}
__device__ __forceinline__ void phase_gather(const P& p, char* shm, const int wv) {
    char* ws = p.ws;
    const int tid = opaque_tid(wv), w = wv, lane = tid & 63, r = lane >> 4, li = lane & 15;
    const int gw = blockIdx.x * 8 + w, nw = gridDim.x * 8;
    const bf16_t* H1B = (const bf16_t*)(ws + OFF_H1B);
    bf16_t* H2B = (bf16_t*)(ws + OFF_H2B);
    const int* PIDX = (const int*)(ws + OFF_PIDX);
    const float* PS = (const float*)(ws + OFF_PS);
    const unsigned char* UT = (const unsigned char*)(ws + OFF_UT);
    const unsigned char* VT = (const unsigned char*)(ws + OFF_VT);
    float* RS3 = (float*)(ws + OFF_RS3);
    int* eidx = (int*)shm + w * 256;
    float* eg = (float*)shm + w * 256 + 128;
    const bool hi32 = (lane & 32) != 0, odd16 = (lane & 16) != 0;
    for (int tok = gw; tok < NT; tok += nw) {
        float xf[64];
        float s = 0.f;
#pragma unroll
        for (int k = 0; k < 4; ++k) {
            const uint4* hp = (const uint4*)(H1B + (size_t)tok * 1024 + k * 256 + li * 16);
            const uint4 a = hp[0], b = hp[1];
            unpack8(a, xf + k * 16); unpack8(b, xf + k * 16 + 8);
        }
#pragma unroll
        for (int i = 0; i < 64; ++i) s += xf[i] * xf[i];
        s = row_sum16(s);
        const float rs2 = rsqrtf(s * (1.f / 1024.f) + EPS);
        const float sc0 = PS[(size_t)tok * 128 + lane] * rs2, sc1 = PS[(size_t)tok * 128 + 64 + lane] * rs2;
        const int id0 = PIDX[(size_t)tok * 128 + lane], id1 = PIDX[(size_t)tok * 128 + 64 + lane];
        const float m0 = row_max16(sc0), m1 = row_max16(sc1);
        const float p0 = __expf(sc0 - m0), p1 = __expf(sc1 - m1);
        const float g0 = p0 / row_sum16(p0), g1 = p1 / row_sum16(p1);
        eidx[lane] = id0; eidx[64 + lane] = id1;
        eg[lane] = g0; eg[64 + lane] = g1;
        asm volatile("s_waitcnt lgkmcnt(0)" ::: "memory");
        __builtin_amdgcn_wave_barrier();
        float acc[64];
#pragma unroll
        for (int i = 0; i < 64; ++i) acc[i] = 0.f;
        const float uscale = rs2 * (1.f / 64.f);
#pragma unroll 2
        for (int j = 0; j < 32; ++j) {
            const int e = 4 * j + r;
            const int id = eidx[e];
            const float gg = eg[e];
            const uint4* up = (const uint4*)(UT + (size_t)id * 1024 + li * 16);
            const uint4* vp = (const uint4*)(VT + (size_t)id * 1024 + li * 16);
            uint4 uu[4], vv[4];
#pragma unroll
            for (int k = 0; k < 4; ++k) { uu[k] = up[k * 16]; vv[k] = vp[k * 16]; }
            f32x2 d2 = {0.f, 0.f}, d3 = {0.f, 0.f};
#pragma unroll
            for (int k = 0; k < 4; ++k) {
                const unsigned wd[4] = {uu[k].x, uu[k].y, uu[k].z, uu[k].w};
#pragma unroll
                for (int q = 0; q < 4; ++q) {
                    const f32x2 lo = __builtin_amdgcn_cvt_pk_f32_fp8((int)wd[q], false);
                    const f32x2 hi = __builtin_amdgcn_cvt_pk_f32_fp8((int)wd[q], true);
                    const f32x2 xlo = {xf[k * 16 + q * 4 + 0], xf[k * 16 + q * 4 + 1]};
                    const f32x2 xhi = {xf[k * 16 + q * 4 + 2], xf[k * 16 + q * 4 + 3]};
                    d2 = lo * xlo + d2;
                    d3 = hi * xhi + d3;
                }
            }
            float d = (d2.x + d2.y) + (d3.x + d3.y);
            d = row_sum16(d);
            const float wgt = gg * gelu_tanh(d * uscale) * 0.125f;
            const f32x2 w2 = {wgt, wgt};
#pragma unroll
            for (int k = 0; k < 4; ++k) {
                const unsigned wd[4] = {vv[k].x, vv[k].y, vv[k].z, vv[k].w};
#pragma unroll
                for (int q = 0; q < 4; ++q) {
                    const f32x2 lo = __builtin_amdgcn_cvt_pk_f32_fp8((int)wd[q], false);
                    const f32x2 hi = __builtin_amdgcn_cvt_pk_f32_fp8((int)wd[q], true);
                    f32x2 a0 = {acc[k * 16 + q * 4 + 0], acc[k * 16 + q * 4 + 1]};
                    f32x2 a1 = {acc[k * 16 + q * 4 + 2], acc[k * 16 + q * 4 + 3]};
                    a0 = lo * w2 + a0;
                    a1 = hi * w2 + a1;
                    acc[k * 16 + q * 4 + 0] = a0.x; acc[k * 16 + q * 4 + 1] = a0.y;
                    acc[k * 16 + q * 4 + 2] = a1.x; acc[k * 16 + q * 4 + 3] = a1.y;
                }
            }
        }
        float t1[32];
#pragma unroll
        for (int q = 0; q < 32; ++q) {
            const float keep = hi32 ? acc[32 + q] : acc[q];
            const float send = hi32 ? acc[q] : acc[32 + q];
            t1[q] = keep + xor32(send, lane);
        }
        float fin[16];
#pragma unroll
        for (int q = 0; q < 16; ++q) {
            const float keep = odd16 ? t1[16 + q] : t1[q];
            const float send = odd16 ? t1[q] : t1[16 + q];
            fin[q] = keep + __int_as_float(__builtin_amdgcn_ds_swizzle(__float_as_int(send), 0x401F));
        }
        {
            const uint4* hp = (const uint4*)(H1B + (size_t)tok * 1024 + r * 256 + li * 16);
            const uint4 a = hp[0], b = hp[1];
            float xo[16];
            unpack8(a, xo); unpack8(b, xo + 8);
            float s3 = 0.f;
#pragma unroll
            for (int q = 0; q < 16; ++q) { fin[q] += xo[q]; s3 += fin[q] * fin[q]; }
            uint4 oa, ob;
            oa.x = pk2(fin[0], fin[1]); oa.y = pk2(fin[2], fin[3]); oa.z = pk2(fin[4], fin[5]); oa.w = pk2(fin[6], fin[7]);
            ob.x = pk2(fin[8], fin[9]); ob.y = pk2(fin[10], fin[11]); ob.z = pk2(fin[12], fin[13]); ob.w = pk2(fin[14], fin[15]);
            uint4* op = (uint4*)(H2B + (size_t)tok * 1024 + r * 256 + li * 16);
            op[0] = oa; op[1] = ob;
            s3 = wave_sum(s3);
            if (lane == 0) RS3[tok] = rsqrtf(s3 * (1.f / 1024.f) + EPS);
        }
        asm volatile("s_waitcnt lgkmcnt(0)" ::: "memory");
        __builtin_amdgcn_wave_barrier();
    }
}

__global__ void __launch_bounds__(NTHREADS, 2) mega(P p) {
    extern __shared__ __attribute__((aligned(1024))) char shm[];
    cg::grid_group grid = cg::this_grid();
    char* ws = p.ws;
    const int wv = __builtin_amdgcn_readfirstlane((int)(threadIdx.x >> 6));
    const int w = wv;
    const int gw = blockIdx.x * 8 + w, nw = gridDim.x * 8;

    phase_prep(p, wv);
    grid.sync();
    phase_inproj(p, shm, wv);
    grid.sync();
    for (int u = blockIdx.x; u < 1536 + 768; u += gridDim.x) {
        if (u < 1536) attn_unit(p, shm, u, wv); else lru_unit<false>(p, shm, u - 1536, wv);
    }
    grid.sync();
    for (int u = blockIdx.x; u < 768; u += gridDim.x) lru_unit<true>(p, shm, u, wv);
    {
        const bf16_t* AT = (const bf16_t*)(ws + OFF_AT);
        bf16_t* MRG = (bf16_t*)(ws + OFF_MRG);
        const int lane = opaque_tid(wv) & 63;
        for (int tok = gw; tok < NT; tok += nw) {
            const uint4 a = ((const uint4*)(AT + (size_t)tok * 512))[lane];
            float f[8];
            unpack8(a, f);
            float s = 0.f;
#pragma unroll
            for (int i = 0; i < 8; ++i) s += f[i] * f[i];
            s = wave_sum(s);
            const float rs = rsqrtf(s * (1.f / 512.f) + EPS);
            uint4 o;
            o.x = pk2(f[0] * rs, f[1] * rs); o.y = pk2(f[2] * rs, f[3] * rs); o.z = pk2(f[4] * rs, f[5] * rs); o.w = pk2(f[6] * rs, f[7] * rs);
            ((uint4*)(MRG + (size_t)tok * 1024))[lane] = o;
        }
    }
    grid.sync();
    {
        const bf16_t* MRG = (const bf16_t*)(ws + OFF_MRG);
        const bf16_t* W = (const bf16_t*)(ws + OFF_WOUT);
        bf16_t* H1B = (bf16_t*)(ws + OFF_H1B);
        const float *xp = p.x_p, *xs = p.x_s;
        auto epi = [=](int row, int col, f32x4 v0, f32x4 v1) {
            const float* xr = (row < NTP ? xp + (size_t)row * 1024 : xs + (size_t)(row - NTP) * 1024) + col;
            const f32x4 x0 = *(const f32x4*)xr, x1 = *(const f32x4*)(xr + 16);
            bf16_t* dst = H1B + (size_t)row * 1024 + col;
            st4bf(dst, v0 + x0); st4bf(dst + 16, v1 + x1);
        };
        int pm, pn;
        for (int i = 0; gemm_next(i, 4, 384 * 4, pm, pn); ++i) gemm_tile(MRG, W, 1024, pm * 256, pn * 256, shm, wv, epi);
    }
    grid.sync();
    {
        const bf16_t* H1B = (const bf16_t*)(ws + OFF_H1B);
        const bf16_t* W = (const bf16_t*)(ws + OFF_WQ);
        bf16_t* QP = (bf16_t*)(ws + OFF_QP);
        auto epi = [=](int row, int col, f32x4 v0, f32x4 v1) {
            bf16_t* dst = QP + (size_t)row * 2048 + col;
            st4bf(dst, v0); st4bf(dst + 16, v1);
        };
        int pm, pn;
        for (int i = 0; gemm_next(i, 8, 384 * 8, pm, pn); ++i) gemm_tile(H1B, W, 1024, pm * 256, pn * 256, shm, wv, epi);
    }
    grid.sync();
    for (int u = blockIdx.x; u < 1536; u += gridDim.x) score_unit(p, shm, u, wv);
    grid.sync();
    phase_stage2(p, wv);
    grid.sync();
    phase_gather(p, shm, wv);
    grid.sync();
    {
        const bf16_t* H2B = (const bf16_t*)(ws + OFF_H2B);
        const bf16_t* WG = (const bf16_t*)(ws + OFF_WG);
        const bf16_t* PB = (const bf16_t*)(ws + OFF_PB);
        const bf16_t* WP = (const bf16_t*)(ws + OFF_WP);
        const float* RS3 = (const float*)(ws + OFF_RS3);
        bf16_t* G = (bf16_t*)(ws + OFF_G);
        bf16_t* H3 = (bf16_t*)(ws + OFF_H3);
        auto epi_g = [=](int row, int col, f32x4 v0, f32x4 v1) {
            const float rs = RS3[row];
            f32x4 a, b;
#pragma unroll
            for (int j = 0; j < 4; ++j) { a[j] = sigmoidf_(v0[j] * rs); b[j] = sigmoidf_(v1[j] * rs); }
            bf16_t* dst = G + (size_t)row * 1024 + col;
            st4bf(dst, a); st4bf(dst + 16, b);
        };
        auto epi_p = [=](int row, int col, f32x4 v0, f32x4 v1) {
            const size_t off = (size_t)row * 1024 + col;
            const f32x4 g0 = ld4bf(G + off), g1 = ld4bf(G + off + 16);
            const f32x4 h0 = ld4bf(H2B + off), h1 = ld4bf(H2B + off + 16);
            st4bf(H3 + off, h0 + g0 * v0); st4bf(H3 + off + 16, h1 + g1 * v1);
        };
        int pm, pn;
        for (int i = 0; gemm_next(i, 4, 384 * 4, pm, pn); ++i) gemm_tile(H2B, WG, 1024, pm * 256, pn * 256, shm, wv, epi_g);
        for (int i = 0; gemm_next(i, 4, 384 * 4, pm, pn); ++i) gemm_tile(PB, WP, 256, pm * 256, pn * 256, shm, wv, epi_p);
    }
    grid.sync();
    {
        const bf16_t* H3 = (const bf16_t*)(ws + OFF_H3);
        const int lane = opaque_tid(wv) & 63;
        for (int tok = gw; tok < NT; tok += nw) {
            const uint2* hp = (const uint2*)(H3 + (size_t)tok * 1024);
            float f[16];
            float s = 0.f;
#pragma unroll
            for (int j = 0; j < 4; ++j) {
                const uint2 a = hp[lane + 64 * j];
                f[4 * j] = bflo(a.x); f[4 * j + 1] = bfhi(a.x); f[4 * j + 2] = bflo(a.y); f[4 * j + 3] = bfhi(a.y);
            }
#pragma unroll
            for (int i = 0; i < 16; ++i) s += f[i] * f[i];
            s = wave_sum(s);
            const float rs = rsqrtf(s * (1.f / 1024.f) + EPS);
            float4* op = (float4*)(p.out + (size_t)tok * 1024);
#pragma unroll
            for (int j = 0; j < 4; ++j) {
                const float4 g = ((const float4*)p.fin_g)[lane + 64 * j];
                float4 o;
                o.x = f[4 * j] * rs * g.x; o.y = f[4 * j + 1] * rs * g.y; o.z = f[4 * j + 2] * rs * g.z; o.w = f[4 * j + 3] * rs * g.w;
                op[lane + 64 * j] = o;
            }
        }
    }
}

extern "C" void kernel_launch(void* const* d_in, const int* in_sizes, int n_in, void* d_out, int out_size, void* d_ws, size_t ws_size,
                              hipStream_t stream) {
    static int grid = 0;
    if (grid == 0) {
        if (n_in != 26 || ws_size < WS_END) {
            fprintf(stderr, "kernel_launch: unexpected n_in %d or ws_size %zu (< %zu)\n", n_in, ws_size, (size_t)WS_END);
            grid = -1;
            return;
        }
        int dev = 0, cus = 0, per_cu = 0;
        hipGetDevice(&dev);
        hipDeviceGetAttribute(&cus, hipDeviceAttributeMultiprocessorCount, dev);
        hipFuncSetAttribute((const void*)mega, hipFuncAttributeMaxDynamicSharedMemorySize, LDS_BYTES);
        hipOccupancyMaxActiveBlocksPerMultiprocessor(&per_cu, (const void*)mega, NTHREADS, LDS_BYTES);
        if (per_cu < 1) { fprintf(stderr, "kernel_launch: occupancy query says %d blocks/CU\n", per_cu); per_cu = 1; }
        grid = cus * 1;
        (void)hipGetLastError();
    }
    if (grid < 0) return;
    P p{};
    const float** pp = (const float**)&p;
    for (int i = 0; i < 26; ++i) pp[i] = (const float*)d_in[i];
    p.out = (float*)d_out;
    p.ws = (char*)d_ws;
    void* args[] = {&p};
    hipError_t e = hipLaunchCooperativeKernel((const void*)mega, dim3(grid), dim3(NTHREADS), args, LDS_BYTES, stream);
    if (e != hipSuccess) fprintf(stderr, "cooperative launch failed: %s (grid %d)\n", hipGetErrorString(e), grid);
}
```

```cpp
#include <hip/hip_runtime.h>
#include <hip/hip_cooperative_groups.h>
#include <cstdio>
#include <cstdint>
namespace cg = cooperative_groups;

typedef unsigned short bf16_t;
typedef __bf16 bf16x8 __attribute__((ext_vector_type(8)));
typedef __bf16 bf16x2v __attribute__((ext_vector_type(2)));
typedef float f32x4 __attribute__((ext_vector_type(4)));
typedef float f32x16 __attribute__((ext_vector_type(16)));
typedef float f32x2 __attribute__((ext_vector_type(2)));

constexpr int NT = 98304;
constexpr int NTP = 65536;
constexpr float EPS = 1e-6f;
constexpr int LDS_BYTES = 147456;
constexpr int NTHREADS = 512;
#define REP_GEMM 1
#define REP_MIX 1
#define REP_PEER 1

constexpr size_t MiB = 1ull << 20;
constexpr size_t OFF_R0 = 0;
constexpr size_t OFF_R1 = 192 * MiB;
constexpr size_t OFF_R2 = 576 * MiB;
constexpr size_t OFF_R3 = 768 * MiB;
constexpr size_t OFF_WIN = OFF_R3;
constexpr size_t OFF_WOUT = OFF_WIN + 1792ull * 1024 * 2;
constexpr size_t OFF_WQ = OFF_WOUT + 1024ull * 1024 * 2;
constexpr size_t OFF_WG = OFF_WQ + 2048ull * 1024 * 2;
constexpr size_t OFF_WP = OFF_WG + 1024ull * 1024 * 2;
constexpr size_t OFF_KEYS = OFF_WP + 1024ull * 256 * 2;
constexpr size_t OFF_UT = OFF_KEYS + 16ull * 128 * 128 * 2;
constexpr size_t OFF_VT = OFF_UT + 16384ull * 1024 * 2;
constexpr size_t OFF_LW = OFF_VT + 16384ull * 1024 * 2;
constexpr size_t OFF_LS = OFF_LW + 2ull * 2 * 8 * 64 * 64 * 2;
constexpr size_t OFF_PB = OFF_LS + 4096;
constexpr size_t OFF_RS1 = OFF_PB + (size_t)NT * 256 * 2;
constexpr size_t OFF_RS3 = OFF_RS1 + (size_t)NT * 4;
constexpr size_t OFF_AGG = OFF_RS3 + (size_t)NT * 4;
constexpr size_t OFF_SSQ3 = OFF_AGG + 768ull * 2 * 1024 * 4;
constexpr size_t OFF_CTL = OFF_SSQ3 + (size_t)NT * 4;
constexpr size_t WS_END = OFF_CTL + 256;
constexpr size_t OFF_Q = OFF_R1;
constexpr size_t OFF_KB = OFF_R1 + 96 * MiB;
constexpr size_t OFF_VB = OFF_R1 + 120 * MiB;
constexpr size_t OFF_XR = OFF_R1 + 144 * MiB;
constexpr size_t OFF_GR = OFF_R1 + 240 * MiB;
constexpr size_t OFF_QP = OFF_R1;
constexpr size_t OFF_H2B = OFF_R1;
constexpr size_t OFF_G = OFF_R1 + 192 * MiB;
constexpr size_t OFF_PART = OFF_R1 + 192 * MiB;
constexpr size_t OFF_AT = OFF_R2;
constexpr size_t OFF_HF = OFF_R2 + 96 * MiB;
constexpr size_t OFF_H1B = OFF_R2;
constexpr size_t OFF_XB = OFF_R0;
constexpr size_t OFF_MRG = OFF_R0;
constexpr size_t OFF_SUBS = OFF_R0;
constexpr size_t OFF_WGT = OFF_R0;
constexpr size_t OFF_PIDX = OFF_R0 + 96 * MiB;
constexpr size_t OFF_PS = OFF_R0 + 144 * MiB;
constexpr size_t OFF_H3 = OFF_R0;

struct P {
    const float *x_p, *x_s, *p_p, *p_s, *mix_g, *w_in, *sink, *conv_w, *conv_b, *lru_wa, *lru_ba, *lru_wx, *lru_bx, *lru_lam,
        *attn_g, *lru_g, *w_out, *ffn_g, *peer_wq, *peer_keys, *peer_u, *peer_v, *ple_g, *ple_wg, *ple_wp, *fin_g;
    float* out;
    char* ws;
};

__device__ __forceinline__ int opaque_tid(int wv) { unsigned z = 0; asm volatile("" : "+v"(z)); int l = __builtin_amdgcn_mbcnt_hi(~0u, __builtin_amdgcn_mbcnt_lo(~0u, z)); return wv * 64 + l; }
__device__ __forceinline__ unsigned pk2(float lo, float hi) {
    unsigned r;
    asm("v_cvt_pk_bf16_f32 %0, %1, %2" : "=v"(r) : "v"(lo), "v"(hi));
    return r;
}
__device__ __forceinline__ float bflo(unsigned w) { return __uint_as_float(w << 16); }
__device__ __forceinline__ float bfhi(unsigned w) { return __uint_as_float(w & 0xffff0000u); }
__device__ __forceinline__ float bf1(bf16_t h) { return __uint_as_float((unsigned)h << 16); }
__device__ __forceinline__ void st4bf(bf16_t* dst, f32x4 v) {
    uint2 o; o.x = pk2(v[0], v[1]); o.y = pk2(v[2], v[3]);
    *(uint2*)dst = o;
}
__device__ __forceinline__ f32x4 ld4bf(const bf16_t* src) {
    uint2 o = *(const uint2*)src;
    f32x4 v; v[0] = bflo(o.x); v[1] = bfhi(o.x); v[2] = bflo(o.y); v[3] = bfhi(o.y);
    return v;
}
__device__ __forceinline__ float dppf(float v, const int ctrl_sel) {
    int t = 0;
    if (ctrl_sel == 0) t = __builtin_amdgcn_update_dpp(0, __float_as_int(v), 0xB1, 0xf, 0xf, true);
    else if (ctrl_sel == 1) t = __builtin_amdgcn_update_dpp(0, __float_as_int(v), 0x4E, 0xf, 0xf, true);
    else if (ctrl_sel == 2) t = __builtin_amdgcn_update_dpp(0, __float_as_int(v), 0x141, 0xf, 0xf, true);
    else t = __builtin_amdgcn_update_dpp(0, __float_as_int(v), 0x140, 0xf, 0xf, true);
    return __int_as_float(t);
}
__device__ __forceinline__ float row_max16(float v) {
    v = fmaxf(v, dppf(v, 0)); v = fmaxf(v, dppf(v, 1)); v = fmaxf(v, dppf(v, 2)); v = fmaxf(v, dppf(v, 3));
    return v;
}
__device__ __forceinline__ float row_sum16(float v) {
    v += dppf(v, 0); v += dppf(v, 1); v += dppf(v, 2); v += dppf(v, 3);
    return v;
}
__device__ __forceinline__ float wave_sum(float v) {
    v = row_sum16(v);
    v += __int_as_float(__builtin_amdgcn_ds_swizzle(__float_as_int(v), 0x401F));
    return __int_as_float(__builtin_amdgcn_readlane(__float_as_int(v), 0)) + __int_as_float(__builtin_amdgcn_readlane(__float_as_int(v), 32));
}
__device__ __forceinline__ float xor32(float v, int lane) {
    return __int_as_float(__builtin_amdgcn_ds_bpermute((lane ^ 32) << 2, __float_as_int(v)));
}
__device__ __forceinline__ void grid_bar(unsigned* cnt, const unsigned target, const int wv) {
    __syncthreads();
    if (wv == 0) {
        const int l = opaque_tid(0);
        if (l == 0) {
            __builtin_amdgcn_fence(__ATOMIC_RELEASE, "agent");
            asm volatile("s_waitcnt vmcnt(0)" ::: "memory");
            __hip_atomic_fetch_add(cnt, 1u, __ATOMIC_RELAXED, __HIP_MEMORY_SCOPE_AGENT);
            while (__hip_atomic_load(cnt, __ATOMIC_RELAXED, __HIP_MEMORY_SCOPE_AGENT) < target) __builtin_amdgcn_s_sleep(2);
            __builtin_amdgcn_fence(__ATOMIC_ACQUIRE, "agent");
            asm volatile("s_waitcnt vmcnt(0)" ::: "memory");
        }
    }
    __syncthreads();
}
__device__ __forceinline__ float fexp(float x) { return __builtin_amdgcn_exp2f(x * 1.4426950408889634f); }
__device__ __forceinline__ float frcp(float x) { return __builtin_amdgcn_rcpf(x); }
__device__ __forceinline__ float fsqrt(float x) { return __builtin_amdgcn_sqrtf(x); }
__device__ __forceinline__ float frsq(float x) { return __builtin_amdgcn_rsqf(x); }
__device__ __forceinline__ float sigmoidf_(float x) { return frcp(1.f + fexp(-x)); }
__device__ __forceinline__ float gelu_tanh(float x) {
    const float y2 = 1.5957691216057308f * (x + 0.044715f * x * x * x);
    return x * frcp(1.f + fexp(-y2));
}
__device__ __forceinline__ int tok_pos(int g) { return g < NTP ? (g & 2047) : (g & 16383); }
__device__ __forceinline__ void tile_seq(int blk, int& c, int& nc) {
    if (blk < 512) { c = blk & 15; nc = 16; } else { c = (blk - 512) & 127; nc = 128; }
}
__device__ __forceinline__ float dot2bf(unsigned a, unsigned b, float acc) {
    return __builtin_amdgcn_fdot2_f32_bf16(__builtin_bit_cast(bf16x2v, a), __builtin_bit_cast(bf16x2v, b), acc, false);
}

__device__ __forceinline__ int lds_byte(int r, int c) {
    int st = (r >> 4) * 2 + (c >> 5), ob = (r & 15) * 64 + (c & 31) * 2;
    return st * 1024 + (ob ^ (((ob >> 9) & 1) << 5));
}
__device__ __forceinline__ void stage_rc(int b, int& R, int& C) {
    int st = b >> 10, sb = b & 1023, swz = sb ^ (((sb >> 9) & 1) << 5);
    R = (st / 2) * 16 + swz / 64;
    C = (st % 2) * 32 + (swz % 64) / 2;
}
#define WAIT_V0() asm volatile("s_waitcnt vmcnt(0)" ::: "memory")

template <class Epi>
__device__ __forceinline__ void gemm_tile(const bf16_t* __restrict__ A, const bf16_t* __restrict__ Bt, const int K,
                                          const int brow, const int bcol, char* shm, const int wv, Epi epi) {
    constexpr int BK = 64, TILE_B = 256 * BK * 2, GL = 4, STAGE_B = 2 * TILE_B;
    const int tid = opaque_tid(wv), wid = tid >> 6, lane = tid & 63, wr = wid >> 2, wc = wid & 3, fr = lane & 15, fq = lane >> 4;
    const bf16_t* Ab = A + (size_t)brow * K;
    const bf16_t* Bb = Bt + (size_t)bcol * K;
    int sR[GL], sC[GL];
#pragma unroll
    for (int i = 0; i < GL; ++i) stage_rc(wid * 1024 + i * 8192 + lane * 16, sR[i], sC[i]);
    f32x4 acc[8][4];
#pragma unroll
    for (int m = 0; m < 8; ++m)
#pragma unroll
        for (int n = 0; n < 4; ++n) acc[m][n] = f32x4{0.f, 0.f, 0.f, 0.f};
    const int nt = K / BK;
#define GSTAGE(buf, kt)                                                                                              \
    do {                                                                                                             \
        _Pragma("unroll") for (int i = 0; i < GL; ++i) {                                                             \
            __builtin_amdgcn_global_load_lds((const unsigned*)(Ab + (size_t)sR[i] * K + (kt) * BK + sC[i]),          \
                                             (unsigned*)(shm + (buf) * STAGE_B + wid * 1024 + i * 8192), 16, 0, 0);   \
            __builtin_amdgcn_global_load_lds((const unsigned*)(Bb + (size_t)sR[i] * K + (kt) * BK + sC[i]),          \
                                             (unsigned*)(shm + (buf) * STAGE_B + TILE_B + wid * 1024 + i * 8192), 16, 0, 0); \
        }                                                                                                            \
    } while (0)
    __syncthreads();
    GSTAGE(0, 0);
    WAIT_V0();
    __syncthreads();
    for (int t = 0; t < nt; ++t) {
        const int cur = t & 1;
        if (t + 1 < nt) GSTAGE(cur ^ 1, t + 1);
        const char* sa = shm + cur * STAGE_B;
        const char* sb = sa + TILE_B;
#pragma unroll
        for (int ks = 0; ks < 2; ++ks) {
            bf16x8 At[8], Bf[4];
#pragma unroll
            for (int m = 0; m < 8; ++m) At[m] = *(const bf16x8*)(sa + lds_byte(wr * 128 + m * 16 + fr, ks * 32 + fq * 8));
#pragma unroll
            for (int n = 0; n < 4; ++n) Bf[n] = *(const bf16x8*)(sb + lds_byte(wc * 64 + n * 16 + fr, ks * 32 + fq * 8));
#pragma unroll
            for (int m = 0; m < 8; ++m)
#pragma unroll
                for (int n = 0; n < 4; ++n) acc[m][n] = __builtin_amdgcn_mfma_f32_16x16x32_bf16(Bf[n], At[m], acc[m][n], 0, 0, 0);
            __builtin_amdgcn_sched_barrier(0);
        }
        WAIT_V0();
        __syncthreads();
    }
#undef GSTAGE
#pragma unroll
    for (int m = 0; m < 8; ++m) {
        const int row = brow + wr * 128 + m * 16 + fr;
#pragma unroll
        for (int np = 0; np < 2; ++np) {
            const int col = bcol + wc * 64 + np * 32 + fq * 4;
            epi(row, col, acc[m][2 * np], acc[m][2 * np + 1]);
        }
    }
}

__device__ __forceinline__ bool gemm_next(int i, int nN, int nTiles, int& pm, int& pn) {
    const int G = gridDim.x, b = blockIdx.x;
    int v = b;
    if ((G & 7) == 0) v = (b & 7) * (G >> 3) + (b >> 3);
    const int L = i * G + v;
    if (L >= nTiles) return false;
    pm = L / nN; pn = L % nN;
    return true;
}

template <class NMap, class Scale>
__device__ __forceinline__ void prep_wT(const float* __restrict__ src, bf16_t* __restrict__ dst, int K, int N, int gtid, int gstride,
                                        NMap nmap, Scale scale) {
    const int items = N * (K / 8);
    for (int it = gtid; it < items; it += gstride) {
        const int n = it % N, k0 = (it / N) * 8;
        const int ns = nmap(n);
        float v[8];
#pragma unroll
        for (int i = 0; i < 8; ++i) v[i] = src[(size_t)(k0 + i) * N + ns] * scale(k0 + i);
        uint4 o; o.x = pk2(v[0], v[1]); o.y = pk2(v[2], v[3]); o.z = pk2(v[4], v[5]); o.w = pk2(v[6], v[7]);
        *(uint4*)(dst + (size_t)n * K + k0) = o;
    }
}

__device__ __forceinline__ void phase_prep(const P& p, const int wv) {
    const int gtid = blockIdx.x * NTHREADS + opaque_tid(wv), gstride = gridDim.x * NTHREADS;
    const int lane = gtid & 63, gw = gtid >> 6, nw = gstride >> 6;
    char* ws = p.ws;
    {
        const float* g = p.mix_g;
        prep_wT(p.w_in, (bf16_t*)(ws + OFF_WIN), 1024, 1792, gtid, gstride,
                [](int n) { if (n >= 640) return n; int pp = n & 63; return (n & ~63) + (pp >> 5) * 16 + ((pp >> 4) & 1) * 32 + (pp & 15); },
                [g](int k) { return g[k]; });
    }
    {
        const float *ga = p.attn_g, *gl = p.lru_g;
        prep_wT(p.w_out, (bf16_t*)(ws + OFF_WOUT), 1024, 1024, gtid, gstride, [](int n) { return n; },
                [ga, gl](int k) { return k < 512 ? ga[k] : gl[k - 512]; });
    }
    {
        const float* g = p.ffn_g;
        prep_wT(p.peer_wq, (bf16_t*)(ws + OFF_WQ), 1024, 2048, gtid, gstride, [](int n) { return n; }, [g](int k) { return g[k]; });
    }
    {
        const float* g = p.ple_g;
        prep_wT(p.ple_wg, (bf16_t*)(ws + OFF_WG), 1024, 1024, gtid, gstride, [](int n) { return n; }, [g](int k) { return g[k]; });
    }
    prep_wT(p.ple_wp, (bf16_t*)(ws + OFF_WP), 256, 1024, gtid, gstride, [](int n) { return n; }, [](int) { return 1.f; });
    {
        bf16_t* kb = (bf16_t*)(ws + OFF_KEYS);
        for (int i = gtid; i < 16 * 128 * 128 / 2; i += gstride) {
            float2 v = ((const float2*)p.peer_keys)[i];
            ((unsigned*)kb)[i] = pk2(v.x, v.y);
        }
    }
    {
        bf16_t* lw = (bf16_t*)(ws + OFF_LW);
        for (int i = gtid; i < 2 * 2 * 8 * 64 * 64; i += gstride) {
            const int e = i & 7, ln = (i >> 3) & 63, ks = (i >> 9) & 3, cb = (i >> 11) & 1, h = (i >> 12) & 7, mat = (i >> 15) & 1, dir = (i >> 16) & 1;
            const int tl = ln & 31, hf = ln >> 5;
            const int j = cb * 32 + tl;
            const int ii = 16 * ks + 8 * (e >> 2) + 4 * hf + (e & 3);
            const float* srcw = mat ? p.lru_wx : p.lru_wa;
            const float v = srcw[(((size_t)dir * 8 + h) * 64 + ii) * 64 + j];
            lw[i] = (bf16_t)(pk2(v, 0.f) & 0xffff);
        }
        float* ls = (float*)(ws + OFF_LS);
        for (int i = gtid; i < 1024; i += gstride) {
            const float lam = p.lru_lam[i];
            ls[i] = lam >= 0.f ? -log1pf(expf(-lam)) : lam - log1pf(expf(lam));
        }
    }
    {
        const float* g = p.ffn_g;
        const float4* us = (const float4*)p.peer_u;
        const float4* vs = (const float4*)p.peer_v;
        uint4* ud = (uint4*)(ws + OFF_UT);
        uint4* vd = (uint4*)(ws + OFF_VT);
        for (int i = gtid; i < 16384 * 64; i += gstride) {
            unsigned uo[4], vo[4];
#pragma unroll
            for (int q = 0; q < 4; ++q) {
                const float4 u = us[(size_t)i * 4 + q], v = vs[(size_t)i * 4 + q];
                const float4 gg = ((const float4*)g)[(i * 4 + q) & 255];
                int a = __builtin_amdgcn_cvt_pk_fp8_f32(u.x * gg.x * 64.f, u.y * gg.y * 64.f, 0, false);
                a = __builtin_amdgcn_cvt_pk_fp8_f32(u.z * gg.z * 64.f, u.w * gg.w * 64.f, a, true);
                int b = __builtin_amdgcn_cvt_pk_fp8_f32(v.x * 8.f, v.y * 8.f, 0, false);
                b = __builtin_amdgcn_cvt_pk_fp8_f32(v.z * 8.f, v.w * 8.f, b, true);
                uo[q] = (unsigned)a; vo[q] = (unsigned)b;
            }
            const int e_ = i >> 6, c16 = i & 63;
            const size_t di = ((size_t)(c16 >> 3) * 16384 + e_) * 8 + (c16 & 7);
            ud[di] = make_uint4(uo[0], uo[1], uo[2], uo[3]);
            vd[di] = make_uint4(vo[0], vo[1], vo[2], vo[3]);
        }
    }
    {
        float* sq = (float*)(ws + OFF_SSQ3);
        for (int i = gtid; i < NT; i += gstride) sq[i] = 0.f;
    }
    {
        uint2* pd = (uint2*)(ws + OFF_PB);
        for (int i = gtid; i < NT * 64; i += gstride) {
            const float4 v = i < NTP * 64 ? ((const float4*)p.p_p)[i] : ((const float4*)p.p_s)[i - NTP * 64];
            uint2 a; a.x = pk2(v.x, v.y); a.y = pk2(v.z, v.w);
            pd[i] = a;
        }
    }
    {
        bf16_t* xb = (bf16_t*)(ws + OFF_XB);
        float* rs1 = (float*)(ws + OFF_RS1);
        for (int tok = gw; tok < NT; tok += nw) {
            const float4* xr = (const float4*)(tok < NTP ? p.x_p + (size_t)tok * 1024 : p.x_s + (size_t)(tok - NTP) * 1024);
            float s = 0.f;
            uint2* od = (uint2*)(xb + (size_t)tok * 1024);
#pragma unroll
            for (int j = 0; j < 4; ++j) {
                const float4 v = xr[lane + 64 * j];
                s += v.x * v.x + v.y * v.y + v.z * v.z + v.w * v.w;
                uint2 a; a.x = pk2(v.x, v.y); a.y = pk2(v.z, v.w);
                od[lane + 64 * j] = a;
            }
            s = wave_sum(s);
            if (lane == 0) rs1[tok] = frsq(s * (1.f / 1024.f) + EPS);
        }
    }
}

__device__ __forceinline__ void phase_inproj(const P& p, char* shm, const int wv) {
    char* ws = p.ws;
    const bf16_t* XB = (const bf16_t*)(ws + OFF_XB);
    const bf16_t* W = (const bf16_t*)(ws + OFF_WIN);
    const float* RS1 = (const float*)(ws + OFF_RS1);
    bf16_t* Q = (bf16_t*)(ws + OFF_Q);
    bf16_t* KB = (bf16_t*)(ws + OFF_KB);
    bf16_t* VB = (bf16_t*)(ws + OFF_VB);
    bf16_t* XR = (bf16_t*)(ws + OFF_XR);
    bf16_t* GR = (bf16_t*)(ws + OFF_GR);
    auto epi = [=](int row, int col, f32x4 v0, f32x4 v1) {
        const float rs = RS1[row];
        v0 *= rs; v1 *= rs;
        if (col < 640) {
            const int pos = tok_pos(row);
            const int d0 = ((col & 63) >> 5) * 16 + (col & 15);
            f32x4 o0, o1;
#pragma unroll
            for (int j = 0; j < 4; ++j) {
                const float invf = exp2f(-(float)(d0 + j) * 0.41524101186092029f);
                const float ang = (float)pos * invf;
                const float nrev = rintf(ang * 0.15915494309189535f);
                float rr = fmaf(-nrev, 6.28125f, ang);
                rr = fmaf(-nrev, 0.0019353071795864769f, rr);
                const float cs = __cosf(rr), sn = __sinf(rr);
                o0[j] = v0[j] * cs - v1[j] * sn;
                o1[j] = v1[j] * cs + v0[j] * sn;
            }
            if (col < 512) {
                o0 *= 0.125f; o1 *= 0.125f;
                bf16_t* dst = Q + (size_t)row * 512 + (col & ~63) + d0;
                st4bf(dst, o0); st4bf(dst + 32, o1);
            } else {
                bf16_t* dst = KB + (size_t)row * 128 + ((col - 512) & ~63) + d0;
                st4bf(dst, o0); st4bf(dst + 32, o1);
            }
        } else if (col < 768) {
            bf16_t* dst = VB + (size_t)row * 128 + (col - 640);
            st4bf(dst, v0); st4bf(dst + 16, v1);
        } else if (col < 1280) {
            bf16_t* dst = XR + (size_t)row * 512 + (col - 768);
            st4bf(dst, v0); st4bf(dst + 16, v1);
        } else {
            bf16_t* dst = GR + (size_t)row * 512 + (col - 1280);
            f32x4 g0, g1;
#pragma unroll
            for (int j = 0; j < 4; ++j) { g0[j] = gelu_tanh(v0[j]); g1[j] = gelu_tanh(v1[j]); }
            st4bf(dst, g0); st4bf(dst + 16, g1);
        }
    };
    int pm, pn;
    for (int i = 0; gemm_next(i, 7, 384 * 7, pm, pn); ++i) gemm_tile(XB, W, 1024, pm * 256, pn * 256, shm, wv, epi);
}

__device__ __forceinline__ void attn_unit(const P& p, char* shm, int unit, const int wv) {
    char* ws = p.ws;
    const int blk = unit >> 1, kvh = unit & 1;
    int c, nc; tile_seq(blk, c, nc);
    const int g0 = blk * 128;
    bf16_t* Ks = (bf16_t*)shm;
    bf16_t* Vt = (bf16_t*)(shm + 55296);
    const bf16_t* KB = (const bf16_t*)(ws + OFF_KB);
    const bf16_t* VB = (const bf16_t*)(ws + OFF_VB);
    const bf16_t* Q = (const bf16_t*)(ws + OFF_Q);
    bf16_t* AT = (bf16_t*)(ws + OFF_AT);
    const int tid = opaque_tid(wv), w = tid >> 6, lane = tid & 63, half = lane >> 5, tl = lane & 31;
    __syncthreads();
    for (int item = tid; item < 384 * 8; item += NTHREADS) {
        const int key = item % 384, part = item / 384;
        const int ch = key >> 7;
        if ((ch == 0 && c == 0) || (ch == 2 && c == nc - 1)) continue;
        const size_t tok = (size_t)(g0 - 128 + key);
        const uint4 kv = *(const uint4*)(KB + tok * 128 + kvh * 64 + part * 8);
        *(uint4*)(Ks + key * 72 + part * 8) = kv;
        const uint4 vv = *(const uint4*)(VB + tok * 128 + kvh * 64 + part * 8);
        bf16_t* vd = Vt + (part * 8) * 388 + key;
        vd[0 * 388] = (bf16_t)(vv.x & 0xffff); vd[1 * 388] = (bf16_t)(vv.x >> 16);
        vd[2 * 388] = (bf16_t)(vv.y & 0xffff); vd[3 * 388] = (bf16_t)(vv.y >> 16);
        vd[4 * 388] = (bf16_t)(vv.z & 0xffff); vd[5 * 388] = (bf16_t)(vv.z >> 16);
        vd[6 * 388] = (bf16_t)(vv.w & 0xffff); vd[7 * 388] = (bf16_t)(vv.w >> 16);
    }
    __syncthreads();
    for (int it = 0; it < 2; ++it) {
        const int task = w + 8 * it;
        const int qhl = task & 3, rg = task >> 2;
        const int hq = kvh * 4 + qhl;
        const int qrow = rg * 32 + tl;
        const bf16_t* qp = Q + (size_t)(g0 + qrow) * 512 + hq * 64 + half * 8;
        bf16x8 qf[4];
#pragma unroll
        for (int ks = 0; ks < 4; ++ks) qf[ks] = *(const bf16x8*)(qp + ks * 16);
        float m = p.sink[hq];
        float l = half == 0 ? 1.f : 0.f;
        f32x16 O0, O1;
#pragma unroll
        for (int i = 0; i < 16; ++i) { O0[i] = 0.f; O1[i] = 0.f; }
        for (int ch = 0; ch < 3; ++ch) {
            if ((ch == 0 && c == 0) || (ch == 2 && c == nc - 1)) continue;
            f32x16 S[4];
#pragma unroll
            for (int kb = 0; kb < 4; ++kb) {
#pragma unroll
                for (int i = 0; i < 16; ++i) S[kb][i] = 0.f;
#pragma unroll
                for (int ks = 0; ks < 4; ++ks) {
                    const bf16x8 kf = *(const bf16x8*)(Ks + (ch * 128 + kb * 32 + tl) * 72 + ks * 16 + half * 8);
                    S[kb] = __builtin_amdgcn_mfma_f32_32x32x16_bf16(kf, qf[ks], S[kb], 0, 0, 0);
                }
            }
            float mx = -INFINITY;
#pragma unroll
            for (int kb = 0; kb < 4; ++kb)
#pragma unroll
                for (int i = 0; i < 16; ++i) {
                    const int kk = kb * 32 + 8 * (i >> 2) + 4 * half + (i & 3);
                    const bool valid = (ch == 1) || (ch == 0 ? kk >= qrow : kk <= qrow);
                    const float s = valid ? S[kb][i] : -INFINITY;
                    S[kb][i] = s;
                    mx = fmaxf(mx, s);
                }
            mx = fmaxf(mx, xor32(mx, lane));
            const float mn = fmaxf(m, mx);
            const float alpha = fexp(m - mn);
            m = mn;
            float ps = 0.f;
#pragma unroll
            for (int kb = 0; kb < 4; ++kb)
#pragma unroll
                for (int i = 0; i < 16; ++i) {
                    const float pv = fexp(S[kb][i] - mn);
                    S[kb][i] = pv;
                    ps += pv;
                }
            l = l * alpha + ps;
#pragma unroll
            for (int i = 0; i < 16; ++i) { O0[i] *= alpha; O1[i] *= alpha; }
#pragma unroll
            for (int kb = 0; kb < 4; ++kb)
#pragma unroll
                for (int s2 = 0; s2 < 2; ++s2) {
                    uint4 pw;
                    pw.x = pk2(S[kb][8 * s2 + 0], S[kb][8 * s2 + 1]); pw.y = pk2(S[kb][8 * s2 + 2], S[kb][8 * s2 + 3]);
                    pw.z = pk2(S[kb][8 * s2 + 4], S[kb][8 * s2 + 5]); pw.w = pk2(S[kb][8 * s2 + 6], S[kb][8 * s2 + 7]);
                    const bf16x8 pf = __builtin_bit_cast(bf16x8, pw);
                    const bf16_t* vp = Vt + tl * 388 + ch * 128 + kb * 32 + 16 * s2 + 4 * half;
                    uint4 vw;
                    uint2 a0 = *(const uint2*)vp, a1 = *(const uint2*)(vp + 8);
                    vw.x = a0.x; vw.y = a0.y; vw.z = a1.x; vw.w = a1.y;
                    O0 = __builtin_amdgcn_mfma_f32_32x32x16_bf16(__builtin_bit_cast(bf16x8, vw), pf, O0, 0, 0, 0);
                    const bf16_t* vp1 = vp + 32 * 388;
                    a0 = *(const uint2*)vp1; a1 = *(const uint2*)(vp1 + 8);
                    vw.x = a0.x; vw.y = a0.y; vw.z = a1.x; vw.w = a1.y;
                    O1 = __builtin_amdgcn_mfma_f32_32x32x16_bf16(__builtin_bit_cast(bf16x8, vw), pf, O1, 0, 0, 0);
                }
        }
        const float lt = l + xor32(l, lane);
        const float inv = frcp(lt);
        bf16_t* op = AT + (size_t)(g0 + qrow) * 512 + hq * 64 + 4 * half;
#pragma unroll
        for (int i4 = 0; i4 < 4; ++i4) {
            f32x4 a, b;
#pragma unroll
            for (int q = 0; q < 4; ++q) { a[q] = O0[4 * i4 + q] * inv; b[q] = O1[4 * i4 + q] * inv; }
            st4bf(op + 8 * i4, a);
            st4bf(op + 32 + 8 * i4, b);
        }
    }
}

#define WAVE_LDS_FENCE() asm volatile("s_waitcnt lgkmcnt(0)" ::: "memory")
template <bool FINAL>
__device__ __forceinline__ void lru_unit(const P& p, char* shm, int blk, const int wv) {
    char* ws = p.ws;
    int c, nc; tile_seq(blk, c, nc);
    const int g0 = blk * 128;
    const int seq_lo = g0 - c * 128, seq_hi = seq_lo + nc * 128;
    const int tid = opaque_tid(wv), w = wv, lane = tid & 63, half = lane >> 5, tl = lane & 31;
    float* abuf = (float*)shm + w * (2 * 32 * 68);
    float* ubuf = abuf + 32 * 68;
    bf16_t* xt = (bf16_t*)abuf;
    float* ssq = (float*)(shm + 139264);
    const bf16_t* XR = (const bf16_t*)(ws + OFF_XR);
    const bf16_t* GR = (const bf16_t*)(ws + OFF_GR);
    const bf16_t* LW = (const bf16_t*)(ws + OFF_LW);
    const float* LS = (const float*)(ws + OFF_LS);
    float* AGG = (float*)(ws + OFF_AGG);
    bf16_t* HF = (bf16_t*)(ws + OFF_HF);
    bf16_t* MRG = (bf16_t*)(ws + OFF_MRG);
    const int chn = w * 64 + lane;
    __syncthreads();
    if (FINAL) {
        if (tid < 32) ssq[tid] = 0.f;
        __syncthreads();
    }
    for (int dir = 0; dir < 2; ++dir) {
        float h = 0.f, Ap = 1.f;
        if (FINAL) {
            if (dir == 0) {
                for (int cc = 0; cc < c; ++cc) {
                    const int tile = blk - c + cc;
                    const float A_ = AGG[(size_t)(tile * 2 + 0) * 1024 + chn], H_ = AGG[(size_t)(tile * 2 + 0) * 1024 + 512 + chn];
                    h = A_ * h + H_;
                }
            } else {
                for (int cc = nc - 1; cc > c; --cc) {
                    const int tile = blk - c + cc;
                    const float A_ = AGG[(size_t)(tile * 2 + 1) * 1024 + chn], H_ = AGG[(size_t)(tile * 2 + 1) * 1024 + 512 + chn];
                    h = A_ * h + H_;
                }
            }
        }
        for (int ibi = 0; ibi < 4; ++ibi) {
            const int ib = dir ? 3 - ibi : ibi;
            const int t0 = g0 + ib * 32;
            WAVE_LDS_FENCE();
#pragma unroll
            for (int i = 0; i < 5; ++i) {
                const int rowi = (lane >> 3) + 8 * i;
                const int tt = t0 - 2 + rowi;
                uint4 v = make_uint4(0u, 0u, 0u, 0u);
                if (tt >= seq_lo && tt < seq_hi) v = *(const uint4*)(XR + (size_t)tt * 512 + w * 64 + (lane & 7) * 8);
                uint2* d = (uint2*)(xt + rowi * 68 + (lane & 7) * 8);
                d[0] = make_uint2(v.x, v.y); d[1] = make_uint2(v.z, v.w);
            }
            WAVE_LDS_FENCE();
            float xcv[4][8];
#pragma unroll
            for (int ks = 0; ks < 4; ++ks)
#pragma unroll
                for (int grp = 0; grp < 2; ++grp) {
                    const int cl = 16 * ks + 8 * grp + 4 * half;
                    const int cb4 = w * 64 + cl;
                    f32x4 a = *(const f32x4*)(p.conv_b + cb4);
#pragma unroll
                    for (int j = 0; j < 4; ++j) {
                        const f32x4 xv = ld4bf(xt + (tl + j) * 68 + cl);
                        const f32x4 wv4 = *(const f32x4*)(p.conv_w + j * 512 + cb4);
                        a += wv4 * xv;
                    }
#pragma unroll
                    for (int q = 0; q < 4; ++q) xcv[ks][grp * 4 + q] = a[q];
                }
            bf16x8 xb[4];
#pragma unroll
            for (int ks = 0; ks < 4; ++ks) {
                uint4 pw;
                pw.x = pk2(xcv[ks][0], xcv[ks][1]); pw.y = pk2(xcv[ks][2], xcv[ks][3]);
                pw.z = pk2(xcv[ks][4], xcv[ks][5]); pw.w = pk2(xcv[ks][6], xcv[ks][7]);
                xb[ks] = __builtin_bit_cast(bf16x8, pw);
            }
            WAVE_LDS_FENCE();
#pragma unroll
            for (int cb = 0; cb < 2; ++cb) {
                f32x16 aa, ax;
#pragma unroll
                for (int i = 0; i < 16; ++i) { aa[i] = 0.f; ax[i] = 0.f; }
#pragma unroll
                for (int ks = 0; ks < 4; ++ks) {
                    const bf16x8 wa = *(const bf16x8*)(LW + ((size_t)((((dir * 2 + 0) * 8 + w) * 2 + cb) * 4 + ks) * 64 + lane) * 8);
                    const bf16x8 wx = *(const bf16x8*)(LW + ((size_t)((((dir * 2 + 1) * 8 + w) * 2 + cb) * 4 + ks) * 64 + lane) * 8);
                    aa = __builtin_amdgcn_mfma_f32_32x32x16_bf16(wa, xb[ks], aa, 0, 0, 0);
                    ax = __builtin_amdgcn_mfma_f32_32x32x16_bf16(wx, xb[ks], ax, 0, 0, 0);
                }
#pragma unroll
                for (int r4 = 0; r4 < 4; ++r4) {
                    const int j0 = cb * 32 + 8 * r4 + 4 * half;
                    const int ch4 = w * 64 + j0;
                    const f32x4 ba4 = *(const f32x4*)(p.lru_ba + dir * 512 + ch4);
                    const f32x4 bx4 = *(const f32x4*)(p.lru_bx + dir * 512 + ch4);
                    const f32x4 ls4 = *(const f32x4*)(LS + dir * 512 + ch4);
                    f32x4 av, uv;
#pragma unroll
                    for (int q = 0; q < 4; ++q) {
                        const int r = 4 * r4 + q;
                        const float xcval = xcv[2 * cb + (r4 >> 1)][4 * (r4 & 1) + q];
                        const float rgate = sigmoidf_(aa[r] + ba4[q]);
                        const float igate = sigmoidf_(ax[r] + bx4[q]);
                        const float la = 8.f * rgate * ls4[q];
                        av[q] = fexp(la);
                        uv[q] = fsqrt(fmaxf(0.f, 1.f - av[q] * av[q])) * igate * xcval;
                    }
                    *(f32x4*)(abuf + tl * 68 + j0) = av;
                    *(f32x4*)(ubuf + tl * 68 + j0) = uv;
                }
            }
            WAVE_LDS_FENCE();
            float val[32];
#pragma unroll
            for (int tt = 0; tt < 32; ++tt) {
                const int tloc = dir ? 31 - tt : tt;
                const float a = abuf[tloc * 68 + lane], u = ubuf[tloc * 68 + lane];
                h = a * h + u;
                Ap *= a;
                if (FINAL) {
                    const size_t off = (size_t)(t0 + tloc) * 512 + chn;
                    if (dir == 0) {
                        HF[off] = (bf16_t)(pk2(h, 0.f) & 0xffff);
                    } else {
                        const float hf = bf1(HF[off]);
                        const float gg = bf1(GR[off]);
                        const float v = gg * (hf + h);
                        val[tt] = v;
                        abuf[tloc * 68 + lane] = v;
                    }
                }
            }
            if (FINAL && dir == 1) {
                WAVE_LDS_FENCE();
                {
                    float s = 0.f;
#pragma unroll
                    for (int q = 0; q < 8; ++q) {
                        const f32x4 v4 = *(const f32x4*)(abuf + tl * 68 + half * 32 + q * 4);
                        s += v4[0] * v4[0] + v4[1] * v4[1] + v4[2] * v4[2] + v4[3] * v4[3];
                    }
                    atomicAdd(&ssq[tl], s);
                }
                __syncthreads();
#pragma unroll
                for (int tt = 0; tt < 32; ++tt) {
                    const int tloc = 31 - tt;
                    const float rs = frsq(ssq[tloc] * (1.f / 512.f) + EPS);
                    MRG[(size_t)(t0 + tloc) * 1024 + 512 + chn] = (bf16_t)(pk2(val[tt] * rs, 0.f) & 0xffff);
                }
                __syncthreads();
                if (tid < 32) ssq[tid] = 0.f;
                __syncthreads();
            }
        }
        if (!FINAL) {
            AGG[(size_t)(blk * 2 + dir) * 1024 + chn] = Ap;
            AGG[(size_t)(blk * 2 + dir) * 1024 + 512 + chn] = h;
        }
    }
}

__device__ __forceinline__ void score_unit(const P& p, char* shm, int unit, const int wv) {
    char* ws = p.ws;
    const int sp = unit & 15, tg = unit >> 4;
    const int tid = opaque_tid(wv), w = tid >> 6, lane = tid & 63, fr = lane & 15, fq = lane >> 4;
    bf16_t* KL = (bf16_t*)shm;
    const bf16_t* KEYS = (const bf16_t*)(ws + OFF_KEYS) + (size_t)sp * 16384;
    const bf16_t* QP = (const bf16_t*)(ws + OFF_QP);
    float* SUBS = (float*)(ws + OFF_SUBS);
    __syncthreads();
    for (int i = tid; i < 2048; i += NTHREADS) {
        const int r = i >> 4, cpart = i & 15;
        *(uint4*)(KL + r * 136 + cpart * 8) = *(const uint4*)(KEYS + r * 128 + cpart * 8);
    }
    __syncthreads();
    for (int tt = 0; tt < 8; ++tt) {
        const int gb = (tg * 8 + tt) * 128 + w * 16;
        bf16x8 af[4];
#pragma unroll
        for (int ks = 0; ks < 4; ++ks) af[ks] = *(const bf16x8*)(QP + (size_t)(gb + fr) * 2048 + sp * 128 + ks * 32 + fq * 8);
        float v[4][8];
#pragma unroll
        for (int nb = 0; nb < 8; ++nb) {
            f32x4 acc = {0.f, 0.f, 0.f, 0.f};
#pragma unroll
            for (int ks = 0; ks < 4; ++ks) {
                const bf16x8 bf = *(const bf16x8*)(KL + (nb * 16 + fr) * 136 + ks * 32 + fq * 8);
                acc = __builtin_amdgcn_mfma_f32_16x16x32_bf16(af[ks], bf, acc, 0, 0, 0);
            }
#pragma unroll
            for (int i = 0; i < 4; ++i) v[i][nb] = __uint_as_float((__float_as_uint(acc[i]) & ~127u) | (unsigned)(nb * 16 + fr));
        }
        float keep[4] = {0.f, 0.f, 0.f, 0.f};
        for (int r = 0; r < 16; ++r) {
#pragma unroll
            for (int i = 0; i < 4; ++i) {
                float lm = v[i][0];
#pragma unroll
                for (int nb = 1; nb < 8; ++nb) lm = fmaxf(lm, v[i][nb]);
                const float rm = row_max16(lm);
                keep[i] = (fr == r) ? rm : keep[i];
#pragma unroll
                for (int nb = 0; nb < 8; ++nb) v[i][nb] = (v[i][nb] == rm) ? -INFINITY : v[i][nb];
            }
        }
#pragma unroll
        for (int i = 0; i < 4; ++i) SUBS[(size_t)(gb + 4 * fq + i) * 256 + sp * 16 + fr] = keep[i];
    }
}

__device__ __forceinline__ void phase_stage2(const P& p, const int wv) {
    char* ws = p.ws;
    const float* SUBS = (const float*)(ws + OFF_SUBS);
    int* PIDX = (int*)(ws + OFF_PIDX);
    float* PS = (float*)(ws + OFF_PS);
    const int gtid = blockIdx.x * NTHREADS + opaque_tid(wv), gstride = gridDim.x * NTHREADS;
    for (int idx = gtid; idx < NT * 8; idx += gstride) {
        const int tok = idx >> 3, hh = idx & 7;
        const float* s0p = SUBS + (size_t)tok * 256 + hh * 32;
        const float* s1p = s0p + 16;
        float s0[16], s1[16];
#pragma unroll
        for (int i = 0; i < 4; ++i) {
            const f32x4 a = *(const f32x4*)(s0p + 4 * i), b = *(const f32x4*)(s1p + 4 * i);
#pragma unroll
            for (int q = 0; q < 4; ++q) { s0[4 * i + q] = a[q]; s1[4 * i + q] = b[q]; }
        }
        float L[16];
#pragma unroll
        for (int i = 0; i < 16; ++i) L[i] = -INFINITY;
#pragma unroll
        for (int a = 0; a < 16; ++a)
#pragma unroll
            for (int b = 0; b < 16; ++b) {
                if ((a + 1) * (b + 1) <= 16) {
                    float nv = __uint_as_float((__float_as_uint(s0[a] + s1[b]) & ~255u) | (unsigned)(a * 16 + b));
#pragma unroll
                    for (int i = 0; i < 16; ++i) {
                        const float hi = fmaxf(L[i], nv);
                        nv = fminf(L[i], nv);
                        L[i] = hi;
                    }
                }
            }
        int ids[16];
#pragma unroll
        for (int k = 0; k < 16; ++k) {
            const unsigned code = __float_as_uint(L[k]) & 255u;
            const unsigned i0 = __float_as_uint(s0p[code >> 4]) & 127u;
            const unsigned i1 = __float_as_uint(s1p[code & 15]) & 127u;
            ids[k] = (int)(i0 * 128 + i1);
        }
        int* pi = PIDX + (size_t)tok * 128;
        f32x4* pf = (f32x4*)(PS + (size_t)tok * 128 + hh * 16);
#pragma unroll
        for (int k = 0; k < 16; ++k) pi[(k & 7) * 16 + hh * 2 + (k >> 3)] = ids[k];
#pragma unroll
        for (int i = 0; i < 4; ++i) pf[i] = f32x4{L[4 * i], L[4 * i + 1], L[4 * i + 2], L[4 * i + 3]};
    }
}

__device__ __forceinline__ void unpack8(const uint4 w, float* f) {
    f[0] = bflo(w.x); f[1] = bfhi(w.x); f[2] = bflo(w.y); f[3] = bfhi(w.y);
    f[4] = bflo(w.z); f[5] = bfhi(w.z); f[6] = bflo(w.w); f[7] = bfhi(w.w);
}
__device__ __forceinline__ unsigned xcc_id() { return (unsigned)__builtin_amdgcn_s_getreg((3 << 11) | 20) & 0xFu; }
__device__ __forceinline__ float dpp_ror8(float v) {
    return __int_as_float(__builtin_amdgcn_update_dpp(0, __float_as_int(v), 0x128, 0xf, 0xf, true));
}
__device__ __forceinline__ float swz_x4(float v) { return __int_as_float(__builtin_amdgcn_ds_swizzle(__float_as_int(v), 0x101F)); }
__device__ __forceinline__ float swz_x16(float v) { return __int_as_float(__builtin_amdgcn_ds_swizzle(__float_as_int(v), 0x401F)); }

template <int PASS>
__device__ __forceinline__ void gather_item(const P& p, const int s, const int chunk, const int w, const int lane) {
    char* ws = p.ws;
    const bf16_t* H1B = (const bf16_t*)(ws + OFF_H1B);
    const int* PIDX = (const int*)(ws + OFF_PIDX);
    const int i8 = lane & 7, gq = lane >> 3;
    for (int j = 0; j < 8; ++j) {
        const int tok = chunk * 64 + w * 8 + j;
        int ids[16];
        {
            const int4* ip = (const int4*)(PIDX + (size_t)tok * 128 + gq * 16);
#pragma unroll
            for (int k = 0; k < 4; ++k) { const int4 t = ip[k]; ids[4 * k] = t.x; ids[4 * k + 1] = t.y; ids[4 * k + 2] = t.z; ids[4 * k + 3] = t.w; }
        }
        if (PASS == 0) {
            const unsigned char* UT = (const unsigned char*)(ws + OFF_UT) + (size_t)s * (16384 * 128) + i8 * 16;
            bf16_t* PART = (bf16_t*)(ws + OFF_PART);
            float xs[16];
            {
                const uint4* hp = (const uint4*)(H1B + (size_t)tok * 1024 + s * 128 + i8 * 16);
                const uint4 a = hp[0], b = hp[1];
                unpack8(a, xs); unpack8(b, xs + 8);
            }
            uint4 uu[16];
#pragma unroll
            for (int it = 0; it < 16; ++it) uu[it] = *(const uint4*)(UT + ((size_t)ids[it] << 7));
            float d[16];
#pragma unroll
            for (int it = 0; it < 16; ++it) {
                const unsigned wd[4] = {uu[it].x, uu[it].y, uu[it].z, uu[it].w};
                f32x2 d2 = {0.f, 0.f};
#pragma unroll
                for (int q = 0; q < 4; ++q) {
                    const f32x2 lo = __builtin_amdgcn_cvt_pk_f32_fp8((int)wd[q], false);
                    const f32x2 hi = __builtin_amdgcn_cvt_pk_f32_fp8((int)wd[q], true);
                    const f32x2 xlo = {xs[q * 4 + 0], xs[q * 4 + 1]};
                    const f32x2 xhi = {xs[q * 4 + 2], xs[q * 4 + 3]};
                    d2 = lo * xlo + d2;
                    d2 = hi * xhi + d2;
                }
                d[it] = d2.x + d2.y;
            }
            const bool b0 = (lane & 1) != 0, b1 = (lane & 2) != 0, b2 = (lane & 4) != 0;
            float t8[8], t4[4], t2[2];
#pragma unroll
            for (int q = 0; q < 8; ++q) {
                const float keep = b0 ? d[8 + q] : d[q], send = b0 ? d[q] : d[8 + q];
                t8[q] = keep + dppf(send, 0);
            }
#pragma unroll
            for (int q = 0; q < 4; ++q) {
                const float keep = b1 ? t8[4 + q] : t8[q], send = b1 ? t8[q] : t8[4 + q];
                t4[q] = keep + dppf(send, 1);
            }
#pragma unroll
            for (int q = 0; q < 2; ++q) {
                const float keep = b2 ? t4[2 + q] : t4[q], send = b2 ? t4[q] : t4[2 + q];
                t2[q] = keep + swz_x4(send);
            }
            *(unsigned*)(PART + ((size_t)tok * 8 + s) * 128 + gq * 16 + 2 * i8) = pk2(t2[0], t2[1]);
        } else {
            const unsigned char* VT = (const unsigned char*)(ws + OFF_VT) + (size_t)s * (16384 * 128) + i8 * 16;
            const float* WGT = (const float*)(ws + OFF_WGT);
            bf16_t* H2B = (bf16_t*)(ws + OFF_H2B);
            float* SSQ3 = (float*)(ws + OFF_SSQ3);
            float wg[16];
            {
                const f32x4* wp = (const f32x4*)(WGT + (size_t)tok * 128 + gq * 16);
#pragma unroll
                for (int k = 0; k < 4; ++k) { const f32x4 t = wp[k]; wg[4 * k] = t[0]; wg[4 * k + 1] = t[1]; wg[4 * k + 2] = t[2]; wg[4 * k + 3] = t[3]; }
            }
            uint4 vv[16];
#pragma unroll
            for (int it = 0; it < 16; ++it) vv[it] = *(const uint4*)(VT + ((size_t)ids[it] << 7));
            f32x2 acc[8];
#pragma unroll
            for (int q = 0; q < 8; ++q) acc[q] = f32x2{0.f, 0.f};
#pragma unroll
            for (int it = 0; it < 16; ++it) {
                const unsigned wd[4] = {vv[it].x, vv[it].y, vv[it].z, vv[it].w};
                const f32x2 w2 = {wg[it], wg[it]};
#pragma unroll
                for (int q = 0; q < 4; ++q) {
                    const f32x2 lo = __builtin_amdgcn_cvt_pk_f32_fp8((int)wd[q], false);
                    const f32x2 hi = __builtin_amdgcn_cvt_pk_f32_fp8((int)wd[q], true);
                    acc[2 * q] = lo * w2 + acc[2 * q];
                    acc[2 * q + 1] = hi * w2 + acc[2 * q + 1];
                }
            }
            float a16[16];
#pragma unroll
            for (int q = 0; q < 8; ++q) { a16[2 * q] = acc[q].x; a16[2 * q + 1] = acc[q].y; }
            const bool b5 = (lane & 32) != 0, b4 = (lane & 16) != 0, b3 = (lane & 8) != 0;
            float t8[8], t4[4], t2[2];
#pragma unroll
            for (int q = 0; q < 8; ++q) {
                const float keep = b5 ? a16[8 + q] : a16[q], send = b5 ? a16[q] : a16[8 + q];
                t8[q] = keep + xor32(send, lane);
            }
#pragma unroll
            for (int q = 0; q < 4; ++q) {
                const float keep = b4 ? t8[4 + q] : t8[q], send = b4 ? t8[q] : t8[4 + q];
                t4[q] = keep + swz_x16(send);
            }
#pragma unroll
            for (int q = 0; q < 2; ++q) {
                const float keep = b3 ? t4[2 + q] : t4[q], send = b3 ? t4[q] : t4[2 + q];
                t2[q] = keep + dpp_ror8(send);
            }
            const int dloc = s * 128 + i8 * 16 + (b5 ? 8 : 0) + (b4 ? 4 : 0) + (b3 ? 2 : 0);
            const unsigned hw = *(const unsigned*)(H1B + (size_t)tok * 1024 + dloc);
            const float o0 = bflo(hw) + t2[0], o1 = bfhi(hw) + t2[1];
            *(unsigned*)(H2B + (size_t)tok * 1024 + dloc) = pk2(o0, o1);
            const float sq = wave_sum(o0 * o0 + o1 * o1);
            if (lane == 0) atomicAdd(SSQ3 + tok, sq);
        }
    }
}

template <int PASS>
__device__ __forceinline__ void phase_gather_sliced(const P& p, char* shm, const int wv) {
    const int tid = opaque_tid(wv), w = wv, lane = tid & 63;
    unsigned* q = (unsigned*)(p.ws + OFF_CTL) + 16 + PASS * 8;
    volatile int* sh = (volatile int*)(shm + 139392);
    const int home = (int)(xcc_id() & 7u);
    constexpr int NCH = NT / 64;
    for (int k = 0; k < 8; ++k) {
        const int s = (home + k) & 7;
        __syncthreads();
        if (tid == 0) sh[0] = (int)__hip_atomic_fetch_add(q + s, 1u, __ATOMIC_RELAXED, __HIP_MEMORY_SCOPE_AGENT);
        __syncthreads();
        int cur = sh[0];
        while (cur < NCH) {
            __syncthreads();
            if (tid == 0) sh[0] = (int)__hip_atomic_fetch_add(q + s, 1u, __ATOMIC_RELAXED, __HIP_MEMORY_SCOPE_AGENT);
            gather_item<PASS>(p, s, cur, w, lane);
            __syncthreads();
            cur = sh[0];
        }
    }
}

__device__ __forceinline__ void phase_gather_mid(const P& p, const int wv) {
    char* ws = p.ws;
    const int tid = opaque_tid(wv), w = wv, lane = tid & 63;
    const int gw = blockIdx.x * 8 + w, nw = gridDim.x * 8;
    const bf16_t* H1B = (const bf16_t*)(ws + OFF_H1B);
    const bf16_t* PART = (const bf16_t*)(ws + OFF_PART);
    const float* PS = (const float*)(ws + OFF_PS);
    float* WGT = (float*)(ws + OFF_WGT);
    for (int tok = gw; tok < NT; tok += nw) {
        const uint4* hp = (const uint4*)(H1B + (size_t)tok * 1024);
        float xf[16];
        unpack8(hp[lane], xf); unpack8(hp[64 + lane], xf + 8);
        float s = 0.f;
#pragma unroll
        for (int i = 0; i < 16; ++i) s += xf[i] * xf[i];
        s = wave_sum(s);
        const float rs2 = frsq(s * (1.f / 1024.f) + EPS);
        float wout[2];
        int pos[2];
#pragma unroll
        for (int hsel = 0; hsel < 2; ++hsel) {
            const int e = lane + 64 * hsel;
            const int it = e >> 3, gq = e & 7;
            const int hi3 = it >> 1;
            const int i8 = ((hi3 >> 2) & 1) | (hi3 & 2) | ((hi3 & 1) << 2);
            const int ppos = gq * 16 + 2 * i8 + (it & 1);
            float d = 0.f;
#pragma unroll
            for (int sl = 0; sl < 8; ++sl) d += bf1(PART[((size_t)tok * 8 + sl) * 128 + ppos]);
            const float sc = PS[(size_t)tok * 128 + e] * rs2;
            const float m = row_max16(sc);
            const float pe = fexp(sc - m);
            const float g = pe * frcp(row_sum16(pe));
            wout[hsel] = g * gelu_tanh(d * rs2 * (1.f / 64.f)) * 0.125f;
            pos[hsel] = gq * 16 + it;
        }
        WGT[(size_t)tok * 128 + pos[0]] = wout[0];
        WGT[(size_t)tok * 128 + pos[1]] = wout[1];
    }
}

__global__ void __launch_bounds__(NTHREADS, 2) mega(P p) {
    extern __shared__ __attribute__((aligned(1024))) char shm[];
    cg::grid_group grid = cg::this_grid();
    char* ws = p.ws;
    const int wv = __builtin_amdgcn_readfirstlane((int)(threadIdx.x >> 6));
    const int w = wv;
    const int gw = blockIdx.x * 8 + w, nw = gridDim.x * 8;
    unsigned* bar_cnt = (unsigned*)(ws + OFF_CTL);

    phase_prep(p, wv);
    grid.sync();
    for (int rp = 0; rp < REP_GEMM; ++rp) phase_inproj(p, shm, wv);
    grid_bar(bar_cnt, (unsigned)(1 * gridDim.x), wv);
    for (int rp = 0; rp < REP_MIX; ++rp)
    for (int u = blockIdx.x; u < 1536 + 768; u += gridDim.x) {
        if (u < 1536) attn_unit(p, shm, u, wv); else lru_unit<false>(p, shm, u - 1536, wv);
    }
    grid_bar(bar_cnt, (unsigned)(2 * gridDim.x), wv);
    for (int rp = 0; rp < REP_MIX; ++rp)
    for (int u = blockIdx.x; u < 768; u += gridDim.x) lru_unit<true>(p, shm, u, wv);
    {
        const bf16_t* AT = (const bf16_t*)(ws + OFF_AT);
        bf16_t* MRG = (bf16_t*)(ws + OFF_MRG);
        const int lane = opaque_tid(wv) & 63;
        for (int tok = gw; tok < NT; tok += nw) {
            const uint4 a = ((const uint4*)(AT + (size_t)tok * 512))[lane];
            float f[8];
            unpack8(a, f);
            float s = 0.f;
#pragma unroll
            for (int i = 0; i < 8; ++i) s += f[i] * f[i];
            s = wave_sum(s);
            const float rs = frsq(s * (1.f / 512.f) + EPS);
            uint4 o;
            o.x = pk2(f[0] * rs, f[1] * rs); o.y = pk2(f[2] * rs, f[3] * rs); o.z = pk2(f[4] * rs, f[5] * rs); o.w = pk2(f[6] * rs, f[7] * rs);
            ((uint4*)(MRG + (size_t)tok * 1024))[lane] = o;
        }
    }
    grid_bar(bar_cnt, (unsigned)(3 * gridDim.x), wv);
    {
        const bf16_t* MRG = (const bf16_t*)(ws + OFF_MRG);
        const bf16_t* W = (const bf16_t*)(ws + OFF_WOUT);
        bf16_t* H1B = (bf16_t*)(ws + OFF_H1B);
        const float *xp = p.x_p, *xs = p.x_s;
        auto epi = [=](int row, int col, f32x4 v0, f32x4 v1) {
            const float* xr = (row < NTP ? xp + (size_t)row * 1024 : xs + (size_t)(row - NTP) * 1024) + col;
            const f32x4 x0 = *(const f32x4*)xr, x1 = *(const f32x4*)(xr + 16);
            bf16_t* dst = H1B + (size_t)row * 1024 + col;
            st4bf(dst, v0 + x0); st4bf(dst + 16, v1 + x1);
        };
        int pm, pn;
        for (int rp = 0; rp < REP_GEMM; ++rp)
        for (int i = 0; gemm_next(i, 4, 384 * 4, pm, pn); ++i) gemm_tile(MRG, W, 1024, pm * 256, pn * 256, shm, wv, epi);
    }
    grid_bar(bar_cnt, (unsigned)(4 * gridDim.x), wv);
    {
        const bf16_t* H1B = (const bf16_t*)(ws + OFF_H1B);
        const bf16_t* W = (const bf16_t*)(ws + OFF_WQ);
        bf16_t* QP = (bf16_t*)(ws + OFF_QP);
        auto epi = [=](int row, int col, f32x4 v0, f32x4 v1) {
            bf16_t* dst = QP + (size_t)row * 2048 + col;
            st4bf(dst, v0); st4bf(dst + 16, v1);
        };
        int pm, pn;
        for (int rp = 0; rp < REP_GEMM; ++rp)
        for (int i = 0; gemm_next(i, 8, 384 * 8, pm, pn); ++i) gemm_tile(H1B, W, 1024, pm * 256, pn * 256, shm, wv, epi);
    }
    grid_bar(bar_cnt, (unsigned)(5 * gridDim.x), wv);
    for (int rp = 0; rp < REP_PEER; ++rp)
    for (int u = blockIdx.x; u < 1536; u += gridDim.x) score_unit(p, shm, u, wv);
    grid_bar(bar_cnt, (unsigned)(6 * gridDim.x), wv);
    phase_stage2(p, wv);
    grid_bar(bar_cnt, (unsigned)(7 * gridDim.x), wv);
    phase_gather_sliced<0>(p, shm, wv);
    grid_bar(bar_cnt, (unsigned)(8 * gridDim.x), wv);
    phase_gather_mid(p, wv);
    grid_bar(bar_cnt, (unsigned)(9 * gridDim.x), wv);
    phase_gather_sliced<1>(p, shm, wv);
    grid_bar(bar_cnt, (unsigned)(10 * gridDim.x), wv);
    {
        const bf16_t* H2B = (const bf16_t*)(ws + OFF_H2B);
        const bf16_t* WG = (const bf16_t*)(ws + OFF_WG);
        const bf16_t* PB = (const bf16_t*)(ws + OFF_PB);
        const bf16_t* WP = (const bf16_t*)(ws + OFF_WP);
        const float* SSQ3 = (const float*)(ws + OFF_SSQ3);
        bf16_t* G = (bf16_t*)(ws + OFF_G);
        bf16_t* H3 = (bf16_t*)(ws + OFF_H3);
        auto epi_g = [=](int row, int col, f32x4 v0, f32x4 v1) {
            const float rs = frsq(SSQ3[row] * (1.f / 1024.f) + EPS);
            f32x4 a, b;
#pragma unroll
            for (int j = 0; j < 4; ++j) { a[j] = sigmoidf_(v0[j] * rs); b[j] = sigmoidf_(v1[j] * rs); }
            bf16_t* dst = G + (size_t)row * 1024 + col;
            st4bf(dst, a); st4bf(dst + 16, b);
        };
        auto epi_p = [=](int row, int col, f32x4 v0, f32x4 v1) {
            const size_t off = (size_t)row * 1024 + col;
            const f32x4 g0 = ld4bf(G + off), g1 = ld4bf(G + off + 16);
            const f32x4 h0 = ld4bf(H2B + off), h1 = ld4bf(H2B + off + 16);
            st4bf(H3 + off, h0 + g0 * v0); st4bf(H3 + off + 16, h1 + g1 * v1);
        };
        int pm, pn;
        for (int rp = 0; rp < REP_GEMM; ++rp)
        for (int i = 0; gemm_next(i, 4, 384 * 4, pm, pn); ++i) gemm_tile(H2B, WG, 1024, pm * 256, pn * 256, shm, wv, epi_g);
        for (int rp = 0; rp < REP_GEMM; ++rp)
        for (int i = 0; gemm_next(i, 4, 384 * 4, pm, pn); ++i) gemm_tile(PB, WP, 256, pm * 256, pn * 256, shm, wv, epi_p);
    }
    grid_bar(bar_cnt, (unsigned)(11 * gridDim.x), wv);
    {
        const bf16_t* H3 = (const bf16_t*)(ws + OFF_H3);
        const int lane = opaque_tid(wv) & 63;
        for (int tok = gw; tok < NT; tok += nw) {
            const uint2* hp = (const uint2*)(H3 + (size_t)tok * 1024);
            float f[16];
            float s = 0.f;
#pragma unroll
            for (int j = 0; j < 4; ++j) {
                const uint2 a = hp[lane + 64 * j];
                f[4 * j] = bflo(a.x); f[4 * j + 1] = bfhi(a.x); f[4 * j + 2] = bflo(a.y); f[4 * j + 3] = bfhi(a.y);
            }
#pragma unroll
            for (int i = 0; i < 16; ++i) s += f[i] * f[i];
            s = wave_sum(s);
            const float rs = frsq(s * (1.f / 1024.f) + EPS);
            float4* op = (float4*)(p.out + (size_t)tok * 1024);
#pragma unroll
            for (int j = 0; j < 4; ++j) {
                const float4 g = ((const float4*)p.fin_g)[lane + 64 * j];
                float4 o;
                o.x = f[4 * j] * rs * g.x; o.y = f[4 * j + 1] * rs * g.y; o.z = f[4 * j + 2] * rs * g.z; o.w = f[4 * j + 3] * rs * g.w;
                op[lane + 64 * j] = o;
            }
        }
    }
}

extern "C" void kernel_launch(void* const* d_in, const int* in_sizes, int n_in, void* d_out, int out_size, void* d_ws, size_t ws_size,
                              hipStream_t stream) {
    static int grid = 0;
    if (grid == 0) {
        if (n_in != 26 || ws_size < WS_END) {
            fprintf(stderr, "kernel_launch: unexpected n_in %d or ws_size %zu (< %zu)\n", n_in, ws_size, (size_t)WS_END);
            grid = -1;
            return;
        }
        int dev = 0, cus = 0, per_cu = 0;
        hipGetDevice(&dev);
        hipDeviceGetAttribute(&cus, hipDeviceAttributeMultiprocessorCount, dev);
        hipFuncSetAttribute((const void*)mega, hipFuncAttributeMaxDynamicSharedMemorySize, LDS_BYTES);
        hipOccupancyMaxActiveBlocksPerMultiprocessor(&per_cu, (const void*)mega, NTHREADS, LDS_BYTES);
        if (per_cu < 1) { fprintf(stderr, "kernel_launch: occupancy query says %d blocks/CU\n", per_cu); per_cu = 1; }
        grid = cus * 1;
        (void)hipGetLastError();
    }
    if (grid < 0) return;
    if (hipMemsetAsync((char*)d_ws + OFF_CTL, 0, 256, stream) != hipSuccess) fprintf(stderr, "kernel_launch: memset failed\n");
    P p{};
    const float** pp = (const float**)&p;
    for (int i = 0; i < 26; ++i) pp[i] = (const float*)d_in[i];
    p.out = (float*)d_out;
    p.ws = (char*)d_ws;
    void* args[] = {&p};
    hipError_t e = hipLaunchCooperativeKernel((const void*)mega, dim3(grid), dim3(NTHREADS), args, LDS_BYTES, stream);
    if (e != hipSuccess) fprintf(stderr, "cooperative launch failed: %s (grid %d)\n", hipGetErrorString(e), grid);
}
```

```cpp
#include <hip/hip_runtime.h>
#include <hip/hip_cooperative_groups.h>
#include <cstdio>
#include <cstdint>
namespace cg = cooperative_groups;

typedef unsigned short bf16_t;
typedef __bf16 bf16x8 __attribute__((ext_vector_type(8)));
typedef __bf16 bf16x2v __attribute__((ext_vector_type(2)));
typedef float f32x4 __attribute__((ext_vector_type(4)));
typedef float f32x16 __attribute__((ext_vector_type(16)));
typedef float f32x2 __attribute__((ext_vector_type(2)));

constexpr int NT = 98304;
constexpr int NTP = 65536;
constexpr float EPS = 1e-6f;
constexpr int LDS_BYTES = 147456;
constexpr int NTHREADS = 512;
#define REP_GEMM 1
#define REP_MIX 1
#define REP_PEER 1

constexpr size_t MiB = 1ull << 20;
constexpr size_t OFF_R0 = 0;
constexpr size_t OFF_R1 = 192 * MiB;
constexpr size_t OFF_R2 = 576 * MiB;
constexpr size_t OFF_R3 = 768 * MiB;
constexpr size_t OFF_WIN = OFF_R3;
constexpr size_t OFF_WOUT = OFF_WIN + 1792ull * 1024 * 2;
constexpr size_t OFF_WQ = OFF_WOUT + 1024ull * 1024 * 2;
constexpr size_t OFF_WG = OFF_WQ + 2048ull * 1024 * 2;
constexpr size_t OFF_WP = OFF_WG + 1024ull * 1024 * 2;
constexpr size_t OFF_KEYS = OFF_WP + 1024ull * 256 * 2;
constexpr size_t OFF_UT = OFF_KEYS + 16ull * 128 * 128 * 2;
constexpr size_t OFF_VT = OFF_UT + 16384ull * 1024 * 2;
constexpr size_t OFF_LW = OFF_VT + 16384ull * 1024 * 2;
constexpr size_t OFF_LS = OFF_LW + 2ull * 2 * 8 * 64 * 64 * 2;
constexpr size_t OFF_PB = OFF_LS + 4096;
constexpr size_t OFF_RS1 = OFF_PB + (size_t)NT * 256 * 2;
constexpr size_t OFF_RS3 = OFF_RS1 + (size_t)NT * 4;
constexpr size_t OFF_AGG = OFF_RS3 + (size_t)NT * 4;
constexpr size_t OFF_SSQ3 = OFF_AGG + 768ull * 2 * 1024 * 4;
constexpr size_t OFF_CTL = OFF_SSQ3 + (size_t)NT * 4;
constexpr size_t WS_END = OFF_CTL + 256;
constexpr size_t OFF_Q = OFF_R1;
constexpr size_t OFF_KB = OFF_R1 + 96 * MiB;
constexpr size_t OFF_VB = OFF_R1 + 120 * MiB;
constexpr size_t OFF_XR = OFF_R1 + 144 * MiB;
constexpr size_t OFF_GR = OFF_R1 + 240 * MiB;
constexpr size_t OFF_QP = OFF_R1;
constexpr size_t OFF_H2B = OFF_R1;
constexpr size_t OFF_G = OFF_R1 + 192 * MiB;
constexpr size_t OFF_PART = OFF_R1 + 192 * MiB;
constexpr size_t OFF_AT = OFF_R2;
constexpr size_t OFF_HF = OFF_R2 + 96 * MiB;
constexpr size_t OFF_H1B = OFF_R2;
constexpr size_t OFF_XB = OFF_R0;
constexpr size_t OFF_MRG = OFF_R0;
constexpr size_t OFF_SUBS = OFF_R0;
constexpr size_t OFF_WGT = OFF_R0;
constexpr size_t OFF_PIDX = OFF_R0 + 96 * MiB;
constexpr size_t OFF_PS = OFF_R0 + 144 * MiB;
constexpr size_t OFF_H3 = OFF_R0;

struct P {
    const float *x_p, *x_s, *p_p, *p_s, *mix_g, *w_in, *sink, *conv_w, *conv_b, *lru_wa, *lru_ba, *lru_wx, *lru_bx, *lru_lam,
        *attn_g, *lru_g, *w_out, *ffn_g, *peer_wq, *peer_keys, *peer_u, *peer_v, *ple_g, *ple_wg, *ple_wp, *fin_g;
    float* out;
    char* ws;
};

__device__ __forceinline__ int opaque_tid(int wv) { unsigned z = 0; asm volatile("" : "+v"(z)); int l = __builtin_amdgcn_mbcnt_hi(~0u, __builtin_amdgcn_mbcnt_lo(~0u, z)); return wv * 64 + l; }
__device__ __forceinline__ unsigned pk2(float lo, float hi) {
    unsigned r;
    asm("v_cvt_pk_bf16_f32 %0, %1, %2" : "=v"(r) : "v"(lo), "v"(hi));
    return r;
}
__device__ __forceinline__ float bflo(unsigned w) { return __uint_as_float(w << 16); }
__device__ __forceinline__ float bfhi(unsigned w) { return __uint_as_float(w & 0xffff0000u); }
__device__ __forceinline__ float bf1(bf16_t h) { return __uint_as_float((unsigned)h << 16); }
__device__ __forceinline__ void st4bf(bf16_t* dst, f32x4 v) {
    uint2 o; o.x = pk2(v[0], v[1]); o.y = pk2(v[2], v[3]);
    *(uint2*)dst = o;
}
__device__ __forceinline__ f32x4 ld4bf(const bf16_t* src) {
    uint2 o = *(const uint2*)src;
    f32x4 v; v[0] = bflo(o.x); v[1] = bfhi(o.x); v[2] = bflo(o.y); v[3] = bfhi(o.y);
    return v;
}
__device__ __forceinline__ float dppf(float v, const int ctrl_sel) {
    int t = 0;
    if (ctrl_sel == 0) t = __builtin_amdgcn_update_dpp(0, __float_as_int(v), 0xB1, 0xf, 0xf, true);
    else if (ctrl_sel == 1) t = __builtin_amdgcn_update_dpp(0, __float_as_int(v), 0x4E, 0xf, 0xf, true);
    else if (ctrl_sel == 2) t = __builtin_amdgcn_update_dpp(0, __float_as_int(v), 0x141, 0xf, 0xf, true);
    else t = __builtin_amdgcn_update_dpp(0, __float_as_int(v), 0x140, 0xf, 0xf, true);
    return __int_as_float(t);
}
__device__ __forceinline__ float row_max16(float v) {
    v = fmaxf(v, dppf(v, 0)); v = fmaxf(v, dppf(v, 1)); v = fmaxf(v, dppf(v, 2)); v = fmaxf(v, dppf(v, 3));
    return v;
}
__device__ __forceinline__ float row_sum16(float v) {
    v += dppf(v, 0); v += dppf(v, 1); v += dppf(v, 2); v += dppf(v, 3);
    return v;
}
__device__ __forceinline__ float wave_sum(float v) {
    v = row_sum16(v);
    v += __int_as_float(__builtin_amdgcn_ds_swizzle(__float_as_int(v), 0x401F));
    return __int_as_float(__builtin_amdgcn_readlane(__float_as_int(v), 0)) + __int_as_float(__builtin_amdgcn_readlane(__float_as_int(v), 32));
}
__device__ __forceinline__ float xor32(float v, int lane) {
    return __int_as_float(__builtin_amdgcn_ds_bpermute((lane ^ 32) << 2, __float_as_int(v)));
}
__device__ __forceinline__ void grid_bar(unsigned* cnt, const unsigned target, const int wv) {
    __syncthreads();
    if (wv == 0) {
        const int l = opaque_tid(0);
        if (l == 0) {
            __builtin_amdgcn_fence(__ATOMIC_RELEASE, "agent");
            asm volatile("s_waitcnt vmcnt(0)" ::: "memory");
            __hip_atomic_fetch_add(cnt, 1u, __ATOMIC_RELAXED, __HIP_MEMORY_SCOPE_AGENT);
            while (__hip_atomic_load(cnt, __ATOMIC_RELAXED, __HIP_MEMORY_SCOPE_AGENT) < target) __builtin_amdgcn_s_sleep(2);
            __builtin_amdgcn_fence(__ATOMIC_ACQUIRE, "agent");
            asm volatile("s_waitcnt vmcnt(0)" ::: "memory");
        }
    }
    __syncthreads();
}
__device__ __forceinline__ float fexp(float x) { return __builtin_amdgcn_exp2f(x * 1.4426950408889634f); }
__device__ __forceinline__ float frcp(float x) { return __builtin_amdgcn_rcpf(x); }
__device__ __forceinline__ float fsqrt(float x) { return __builtin_amdgcn_sqrtf(x); }
__device__ __forceinline__ float frsq(float x) { return __builtin_amdgcn_rsqf(x); }
__device__ __forceinline__ float sigmoidf_(float x) { return frcp(1.f + fexp(-x)); }
__device__ __forceinline__ float gelu_tanh(float x) {
    const float y2 = 1.5957691216057308f * (x + 0.044715f * x * x * x);
    return x * frcp(1.f + fexp(-y2));
}
__device__ __forceinline__ int tok_pos(int g) { return g < NTP ? (g & 2047) : (g & 16383); }
__device__ __forceinline__ void tile_seq(int blk, int& c, int& nc) {
    if (blk < 512) { c = blk & 15; nc = 16; } else { c = (blk - 512) & 127; nc = 128; }
}
__device__ __forceinline__ float dot2bf(unsigned a, unsigned b, float acc) {
    return __builtin_amdgcn_fdot2_f32_bf16(__builtin_bit_cast(bf16x2v, a), __builtin_bit_cast(bf16x2v, b), acc, false);
}

__device__ __forceinline__ int lds_byte(int r, int c) {
    int st = (r >> 4) * 2 + (c >> 5), ob = (r & 15) * 64 + (c & 31) * 2;
    return st * 1024 + (ob ^ (((ob >> 9) & 1) << 5));
}
__device__ __forceinline__ void stage_rc(int b, int& R, int& C) {
    int st = b >> 10, sb = b & 1023, swz = sb ^ (((sb >> 9) & 1) << 5);
    R = (st / 2) * 16 + swz / 64;
    C = (st % 2) * 32 + (swz % 64) / 2;
}
#define WAIT_V0() asm volatile("s_waitcnt vmcnt(0)" ::: "memory")

template <class Epi>
__device__ __forceinline__ void gemm_tile(const bf16_t* __restrict__ A, const bf16_t* __restrict__ Bt, const int K,
                                          const int brow, const int bcol, char* shm, const int wv, Epi epi) {
    constexpr int BK = 64, TILE_B = 256 * BK * 2, GL = 4, STAGE_B = 2 * TILE_B;
    const int tid = opaque_tid(wv), wid = tid >> 6, lane = tid & 63, wr = wid >> 2, wc = wid & 3, fr = lane & 15, fq = lane >> 4;
    const bf16_t* Ab = A + (size_t)brow * K;
    const bf16_t* Bb = Bt + (size_t)bcol * K;
    int sR[GL], sC[GL];
#pragma unroll
    for (int i = 0; i < GL; ++i) stage_rc(wid * 1024 + i * 8192 + lane * 16, sR[i], sC[i]);
    f32x4 acc[8][4];
#pragma unroll
    for (int m = 0; m < 8; ++m)
#pragma unroll
        for (int n = 0; n < 4; ++n) acc[m][n] = f32x4{0.f, 0.f, 0.f, 0.f};
    const int nt = K / BK;
#define GSTAGE(buf, kt)                                                                                              \
    do {                                                                                                             \
        _Pragma("unroll") for (int i = 0; i < GL; ++i) {                                                             \
            __builtin_amdgcn_global_load_lds((const unsigned*)(Ab + (size_t)sR[i] * K + (kt) * BK + sC[i]),          \
                                             (unsigned*)(shm + (buf) * STAGE_B + wid * 1024 + i * 8192), 16, 0, 0);   \
            __builtin_amdgcn_global_load_lds((const unsigned*)(Bb + (size_t)sR[i] * K + (kt) * BK + sC[i]),          \
                                             (unsigned*)(shm + (buf) * STAGE_B + TILE_B + wid * 1024 + i * 8192), 16, 0, 0); \
        }                                                                                                            \
    } while (0)
    __syncthreads();
    GSTAGE(0, 0);
    WAIT_V0();
    __syncthreads();
    for (int t = 0; t < nt; ++t) {
        const int cur = t & 1;
        if (t + 1 < nt) GSTAGE(cur ^ 1, t + 1);
        const char* sa = shm + cur * STAGE_B;
        const char* sb = sa + TILE_B;
#pragma unroll
        for (int ks = 0; ks < 2; ++ks) {
            bf16x8 At[8], Bf[4];
#pragma unroll
            for (int m = 0; m < 8; ++m) At[m] = *(const bf16x8*)(sa + lds_byte(wr * 128 + m * 16 + fr, ks * 32 + fq * 8));
#pragma unroll
            for (int n = 0; n < 4; ++n) Bf[n] = *(const bf16x8*)(sb + lds_byte(wc * 64 + n * 16 + fr, ks * 32 + fq * 8));
#pragma unroll
            for (int m = 0; m < 8; ++m)
#pragma unroll
                for (int n = 0; n < 4; ++n) acc[m][n] = __builtin_amdgcn_mfma_f32_16x16x32_bf16(Bf[n], At[m], acc[m][n], 0, 0, 0);
            __builtin_amdgcn_sched_barrier(0);
        }
        WAIT_V0();
        __syncthreads();
    }
#undef GSTAGE
#pragma unroll
    for (int m = 0; m < 8; ++m) {
        const int row = brow + wr * 128 + m * 16 + fr;
#pragma unroll
        for (int np = 0; np < 2; ++np) {
            const int col = bcol + wc * 64 + np * 32 + fq * 4;
            epi(row, col, acc[m][2 * np], acc[m][2 * np + 1]);
        }
    }
}

__device__ __forceinline__ bool gemm_next(int i, int nN, int nTiles, int& pm, int& pn) {
    const int G = gridDim.x, b = blockIdx.x;
    int v = b;
    if ((G & 7) == 0) v = (b & 7) * (G >> 3) + (b >> 3);
    const int L = i * G + v;
    if (L >= nTiles) return false;
    pm = L / nN; pn = L % nN;
    return true;
}

template <class NMap, class Scale>
__device__ __forceinline__ void prep_wT(const float* __restrict__ src, bf16_t* __restrict__ dst, int K, int N, int gtid, int gstride,
                                        NMap nmap, Scale scale) {
    const int items = N * (K / 8);
    for (int it = gtid; it < items; it += gstride) {
        const int n = it % N, k0 = (it / N) * 8;
        const int ns = nmap(n);
        float v[8];
#pragma unroll
        for (int i = 0; i < 8; ++i) v[i] = src[(size_t)(k0 + i) * N + ns] * scale(k0 + i);
        uint4 o; o.x = pk2(v[0], v[1]); o.y = pk2(v[2], v[3]); o.z = pk2(v[4], v[5]); o.w = pk2(v[6], v[7]);
        *(uint4*)(dst + (size_t)n * K + k0) = o;
    }
}

__device__ __forceinline__ void phase_prep(const P& p, const int wv) {
    const int gtid = blockIdx.x * NTHREADS + opaque_tid(wv), gstride = gridDim.x * NTHREADS;
    const int lane = gtid & 63, gw = gtid >> 6, nw = gstride >> 6;
    char* ws = p.ws;
    {
        const float* g = p.mix_g;
        prep_wT(p.w_in, (bf16_t*)(ws + OFF_WIN), 1024, 1792, gtid, gstride,
                [](int n) { if (n >= 640) return n; int pp = n & 63; return (n & ~63) + (pp >> 5) * 16 + ((pp >> 4) & 1) * 32 + (pp & 15); },
                [g](int k) { return g[k]; });
    }
    {
        const float *ga = p.attn_g, *gl = p.lru_g;
        prep_wT(p.w_out, (bf16_t*)(ws + OFF_WOUT), 1024, 1024, gtid, gstride, [](int n) { return n; },
                [ga, gl](int k) { return k < 512 ? ga[k] : gl[k - 512]; });
    }
    {
        const float* g = p.ffn_g;
        prep_wT(p.peer_wq, (bf16_t*)(ws + OFF_WQ), 1024, 2048, gtid, gstride, [](int n) { return n; }, [g](int k) { return g[k]; });
    }
    {
        const float* g = p.ple_g;
        prep_wT(p.ple_wg, (bf16_t*)(ws + OFF_WG), 1024, 1024, gtid, gstride, [](int n) { return n; }, [g](int k) { return g[k]; });
    }
    prep_wT(p.ple_wp, (bf16_t*)(ws + OFF_WP), 256, 1024, gtid, gstride, [](int n) { return n; }, [](int) { return 1.f; });
    {
        bf16_t* kb = (bf16_t*)(ws + OFF_KEYS);
        for (int i = gtid; i < 16 * 128 * 128 / 2; i += gstride) {
            float2 v = ((const float2*)p.peer_keys)[i];
            ((unsigned*)kb)[i] = pk2(v.x, v.y);
        }
    }
    {
        bf16_t* lw = (bf16_t*)(ws + OFF_LW);
        for (int i = gtid; i < 2 * 2 * 8 * 64 * 64; i += gstride) {
            const int e = i & 7, ln = (i >> 3) & 63, ks = (i >> 9) & 3, cb = (i >> 11) & 1, h = (i >> 12) & 7, mat = (i >> 15) & 1, dir = (i >> 16) & 1;
            const int tl = ln & 31, hf = ln >> 5;
            const int j = cb * 32 + tl;
            const int ii = 16 * ks + 8 * (e >> 2) + 4 * hf + (e & 3);
            const float* srcw = mat ? p.lru_wx : p.lru_wa;
            const float v = srcw[(((size_t)dir * 8 + h) * 64 + ii) * 64 + j];
            lw[i] = (bf16_t)(pk2(v, 0.f) & 0xffff);
        }
        float* ls = (float*)(ws + OFF_LS);
        for (int i = gtid; i < 1024; i += gstride) {
            const float lam = p.lru_lam[i];
            ls[i] = lam >= 0.f ? -log1pf(expf(-lam)) : lam - log1pf(expf(lam));
        }
    }
    {
        const float* g = p.ffn_g;
        const float4* us = (const float4*)p.peer_u;
        const float4* vs = (const float4*)p.peer_v;
        uint4* ud = (uint4*)(ws + OFF_UT);
        uint4* vd = (uint4*)(ws + OFF_VT);
        for (int i = gtid; i < 16384 * 64; i += gstride) {
            unsigned uo[4], vo[4];
#pragma unroll
            for (int q = 0; q < 4; ++q) {
                const float4 u = us[(size_t)i * 4 + q], v = vs[(size_t)i * 4 + q];
                const float4 gg = ((const float4*)g)[(i * 4 + q) & 255];
                int a = __builtin_amdgcn_cvt_pk_fp8_f32(u.x * gg.x * 64.f, u.y * gg.y * 64.f, 0, false);
                a = __builtin_amdgcn_cvt_pk_fp8_f32(u.z * gg.z * 64.f, u.w * gg.w * 64.f, a, true);
                int b = __builtin_amdgcn_cvt_pk_fp8_f32(v.x * 8.f, v.y * 8.f, 0, false);
                b = __builtin_amdgcn_cvt_pk_fp8_f32(v.z * 8.f, v.w * 8.f, b, true);
                uo[q] = (unsigned)a; vo[q] = (unsigned)b;
            }
            const int e_ = i >> 6, c16 = i & 63;
            const size_t di = ((size_t)(c16 >> 3) * 16384 + e_) * 8 + (c16 & 7);
            ud[di] = make_uint4(uo[0], uo[1], uo[2], uo[3]);
            vd[di] = make_uint4(vo[0], vo[1], vo[2], vo[3]);
        }
    }
    {
        float* sq = (float*)(ws + OFF_SSQ3);
        for (int i = gtid; i < NT; i += gstride) sq[i] = 0.f;
    }
    {
        uint2* pd = (uint2*)(ws + OFF_PB);
        for (int i = gtid; i < NT * 64; i += gstride) {
            const float4 v = i < NTP * 64 ? ((const float4*)p.p_p)[i] : ((const float4*)p.p_s)[i - NTP * 64];
            uint2 a; a.x = pk2(v.x, v.y); a.y = pk2(v.z, v.w);
            pd[i] = a;
        }
    }
    {
        bf16_t* xb = (bf16_t*)(ws + OFF_XB);
        float* rs1 = (float*)(ws + OFF_RS1);
        for (int tok = gw; tok < NT; tok += nw) {
            const float4* xr = (const float4*)(tok < NTP ? p.x_p + (size_t)tok * 1024 : p.x_s + (size_t)(tok - NTP) * 1024);
            float s = 0.f;
            uint2* od = (uint2*)(xb + (size_t)tok * 1024);
#pragma unroll
            for (int j = 0; j < 4; ++j) {
                const float4 v = xr[lane + 64 * j];
                s += v.x * v.x + v.y * v.y + v.z * v.z + v.w * v.w;
                uint2 a; a.x = pk2(v.x, v.y); a.y = pk2(v.z, v.w);
                od[lane + 64 * j] = a;
            }
            s = wave_sum(s);
            if (lane == 0) rs1[tok] = frsq(s * (1.f / 1024.f) + EPS);
        }
    }
}

__device__ __forceinline__ void phase_inproj(const P& p, char* shm, const int wv) {
    char* ws = p.ws;
    const bf16_t* XB = (const bf16_t*)(ws + OFF_XB);
    const bf16_t* W = (const bf16_t*)(ws + OFF_WIN);
    const float* RS1 = (const float*)(ws + OFF_RS1);
    bf16_t* Q = (bf16_t*)(ws + OFF_Q);
    bf16_t* KB = (bf16_t*)(ws + OFF_KB);
    bf16_t* VB = (bf16_t*)(ws + OFF_VB);
    bf16_t* XR = (bf16_t*)(ws + OFF_XR);
    bf16_t* GR = (bf16_t*)(ws + OFF_GR);
    auto epi = [=](int row, int col, f32x4 v0, f32x4 v1) {
        const float rs = RS1[row];
        v0 *= rs; v1 *= rs;
        if (col < 640) {
            const int pos = tok_pos(row);
            const int d0 = ((col & 63) >> 5) * 16 + (col & 15);
            f32x4 o0, o1;
#pragma unroll
            for (int j = 0; j < 4; ++j) {
                const float invf = exp2f(-(float)(d0 + j) * 0.41524101186092029f);
                const float ang = (float)pos * invf;
                const float nrev = rintf(ang * 0.15915494309189535f);
                float rr = fmaf(-nrev, 6.28125f, ang);
                rr = fmaf(-nrev, 0.0019353071795864769f, rr);
                const float cs = __cosf(rr), sn = __sinf(rr);
                o0[j] = v0[j] * cs - v1[j] * sn;
                o1[j] = v1[j] * cs + v0[j] * sn;
            }
            if (col < 512) {
                o0 *= 0.125f; o1 *= 0.125f;
                bf16_t* dst = Q + (size_t)row * 512 + (col & ~63) + d0;
                st4bf(dst, o0); st4bf(dst + 32, o1);
            } else {
                bf16_t* dst = KB + (size_t)row * 128 + ((col - 512) & ~63) + d0;
                st4bf(dst, o0); st4bf(dst + 32, o1);
            }
        } else if (col < 768) {
            bf16_t* dst = VB + (size_t)row * 128 + (col - 640);
            st4bf(dst, v0); st4bf(dst + 16, v1);
        } else if (col < 1280) {
            bf16_t* dst = XR + (size_t)row * 512 + (col - 768);
            st4bf(dst, v0); st4bf(dst + 16, v1);
        } else {
            bf16_t* dst = GR + (size_t)row * 512 + (col - 1280);
            f32x4 g0, g1;
#pragma unroll
            for (int j = 0; j < 4; ++j) { g0[j] = gelu_tanh(v0[j]); g1[j] = gelu_tanh(v1[j]); }
            st4bf(dst, g0); st4bf(dst + 16, g1);
        }
    };
    int pm, pn;
    for (int i = 0; gemm_next(i, 7, 384 * 7, pm, pn); ++i) gemm_tile(XB, W, 1024, pm * 256, pn * 256, shm, wv, epi);
}

__device__ __forceinline__ void attn_unit(const P& p, char* shm, int unit, const int wv) {
    char* ws = p.ws;
    const int blk = unit >> 1, kvh = unit & 1;
    int c, nc; tile_seq(blk, c, nc);
    const int g0 = blk * 128;
    bf16_t* Ks = (bf16_t*)shm;
    bf16_t* Vt = (bf16_t*)(shm + 55296);
    const bf16_t* KB = (const bf16_t*)(ws + OFF_KB);
    const bf16_t* VB = (const bf16_t*)(ws + OFF_VB);
    const bf16_t* Q = (const bf16_t*)(ws + OFF_Q);
    bf16_t* AT = (bf16_t*)(ws + OFF_AT);
    const int tid = opaque_tid(wv), w = tid >> 6, lane = tid & 63, half = lane >> 5, tl = lane & 31;
    __syncthreads();
    for (int item = tid; item < 384 * 8; item += NTHREADS) {
        const int key = item % 384, part = item / 384;
        const int ch = key >> 7;
        if ((ch == 0 && c == 0) || (ch == 2 && c == nc - 1)) continue;
        const size_t tok = (size_t)(g0 - 128 + key);
        const uint4 kv = *(const uint4*)(KB + tok * 128 + kvh * 64 + part * 8);
        *(uint4*)(Ks + key * 72 + part * 8) = kv;
        const uint4 vv = *(const uint4*)(VB + tok * 128 + kvh * 64 + part * 8);
        bf16_t* vd = Vt + (part * 8) * 388 + key;
        vd[0 * 388] = (bf16_t)(vv.x & 0xffff); vd[1 * 388] = (bf16_t)(vv.x >> 16);
        vd[2 * 388] = (bf16_t)(vv.y & 0xffff); vd[3 * 388] = (bf16_t)(vv.y >> 16);
        vd[4 * 388] = (bf16_t)(vv.z & 0xffff); vd[5 * 388] = (bf16_t)(vv.z >> 16);
        vd[6 * 388] = (bf16_t)(vv.w & 0xffff); vd[7 * 388] = (bf16_t)(vv.w >> 16);
    }
    __syncthreads();
    for (int it = 0; it < 2; ++it) {
        const int task = w + 8 * it;
        const int qhl = task & 3, rg = task >> 2;
        const int hq = kvh * 4 + qhl;
        const int qrow = rg * 32 + tl;
        const bf16_t* qp = Q + (size_t)(g0 + qrow) * 512 + hq * 64 + half * 8;
        bf16x8 qf[4];
#pragma unroll
        for (int ks = 0; ks < 4; ++ks) qf[ks] = *(const bf16x8*)(qp + ks * 16);
        float m = p.sink[hq];
        float l = half == 0 ? 1.f : 0.f;
        f32x16 O0, O1;
#pragma unroll
        for (int i = 0; i < 16; ++i) { O0[i] = 0.f; O1[i] = 0.f; }
        for (int ch = 0; ch < 3; ++ch) {
            if ((ch == 0 && c == 0) || (ch == 2 && c == nc - 1)) continue;
            f32x16 S[4];
#pragma unroll
            for (int kb = 0; kb < 4; ++kb) {
#pragma unroll
                for (int i = 0; i < 16; ++i) S[kb][i] = 0.f;
#pragma unroll
                for (int ks = 0; ks < 4; ++ks) {
                    const bf16x8 kf = *(const bf16x8*)(Ks + (ch * 128 + kb * 32 + tl) * 72 + ks * 16 + half * 8);
                    S[kb] = __builtin_amdgcn_mfma_f32_32x32x16_bf16(kf, qf[ks], S[kb], 0, 0, 0);
                }
            }
            float mx = -INFINITY;
#pragma unroll
            for (int kb = 0; kb < 4; ++kb)
#pragma unroll
                for (int i = 0; i < 16; ++i) {
                    const int kk = kb * 32 + 8 * (i >> 2) + 4 * half + (i & 3);
                    const bool valid = (ch == 1) || (ch == 0 ? kk >= qrow : kk <= qrow);
                    const float s = valid ? S[kb][i] : -INFINITY;
                    S[kb][i] = s;
                    mx = fmaxf(mx, s);
                }
            mx = fmaxf(mx, xor32(mx, lane));
            const float mn = fmaxf(m, mx);
            const float alpha = fexp(m - mn);
            m = mn;
            float ps = 0.f;
#pragma unroll
            for (int kb = 0; kb < 4; ++kb)
#pragma unroll
                for (int i = 0; i < 16; ++i) {
                    const float pv = fexp(S[kb][i] - mn);
                    S[kb][i] = pv;
                    ps += pv;
                }
            l = l * alpha + ps;
#pragma unroll
            for (int i = 0; i < 16; ++i) { O0[i] *= alpha; O1[i] *= alpha; }
#pragma unroll
            for (int kb = 0; kb < 4; ++kb)
#pragma unroll
                for (int s2 = 0; s2 < 2; ++s2) {
                    uint4 pw;
                    pw.x = pk2(S[kb][8 * s2 + 0], S[kb][8 * s2 + 1]); pw.y = pk2(S[kb][8 * s2 + 2], S[kb][8 * s2 + 3]);
                    pw.z = pk2(S[kb][8 * s2 + 4], S[kb][8 * s2 + 5]); pw.w = pk2(S[kb][8 * s2 + 6], S[kb][8 * s2 + 7]);
                    const bf16x8 pf = __builtin_bit_cast(bf16x8, pw);
                    const bf16_t* vp = Vt + tl * 388 + ch * 128 + kb * 32 + 16 * s2 + 4 * half;
                    uint4 vw;
                    uint2 a0 = *(const uint2*)vp, a1 = *(const uint2*)(vp + 8);
                    vw.x = a0.x; vw.y = a0.y; vw.z = a1.x; vw.w = a1.y;
                    O0 = __builtin_amdgcn_mfma_f32_32x32x16_bf16(__builtin_bit_cast(bf16x8, vw), pf, O0, 0, 0, 0);
                    const bf16_t* vp1 = vp + 32 * 388;
                    a0 = *(const uint2*)vp1; a1 = *(const uint2*)(vp1 + 8);
                    vw.x = a0.x; vw.y = a0.y; vw.z = a1.x; vw.w = a1.y;
                    O1 = __builtin_amdgcn_mfma_f32_32x32x16_bf16(__builtin_bit_cast(bf16x8, vw), pf, O1, 0, 0, 0);
                }
        }
        const float lt = l + xor32(l, lane);
        const float inv = frcp(lt);
        bf16_t* op = AT + (size_t)(g0 + qrow) * 512 + hq * 64 + 4 * half;
#pragma unroll
        for (int i4 = 0; i4 < 4; ++i4) {
            f32x4 a, b;
#pragma unroll
            for (int q = 0; q < 4; ++q) { a[q] = O0[4 * i4 + q] * inv; b[q] = O1[4 * i4 + q] * inv; }
            st4bf(op + 8 * i4, a);
            st4bf(op + 32 + 8 * i4, b);
        }
    }
}

#define WAVE_LDS_FENCE() asm volatile("s_waitcnt lgkmcnt(0)" ::: "memory")
template <bool FINAL>
__device__ __forceinline__ void lru_unit(const P& p, char* shm, int blk, const int wv) {
    char* ws = p.ws;
    int c, nc; tile_seq(blk, c, nc);
    const int g0 = blk * 128;
    const int seq_lo = g0 - c * 128, seq_hi = seq_lo + nc * 128;
    const int tid = opaque_tid(wv), w = wv, lane = tid & 63, half = lane >> 5, tl = lane & 31;
    float* abuf = (float*)shm + w * (2 * 32 * 68);
    float* ubuf = abuf + 32 * 68;
    bf16_t* xt = (bf16_t*)abuf;
    float* ssq = (float*)(shm + 139264);
    const bf16_t* XR = (const bf16_t*)(ws + OFF_XR);
    const bf16_t* GR = (const bf16_t*)(ws + OFF_GR);
    const bf16_t* LW = (const bf16_t*)(ws + OFF_LW);
    const float* LS = (const float*)(ws + OFF_LS);
    float* AGG = (float*)(ws + OFF_AGG);
    bf16_t* HF = (bf16_t*)(ws + OFF_HF);
    bf16_t* MRG = (bf16_t*)(ws + OFF_MRG);
    const int chn = w * 64 + lane;
    __syncthreads();
    if (FINAL) {
        if (tid < 32) ssq[tid] = 0.f;
        __syncthreads();
    }
    for (int dir = 0; dir < 2; ++dir) {
        float h = 0.f, Ap = 1.f;
        if (FINAL) {
            if (dir == 0) {
                for (int cc = 0; cc < c; ++cc) {
                    const int tile = blk - c + cc;
                    const float A_ = AGG[(size_t)(tile * 2 + 0) * 1024 + chn], H_ = AGG[(size_t)(tile * 2 + 0) * 1024 + 512 + chn];
                    h = A_ * h + H_;
                }
            } else {
                for (int cc = nc - 1; cc > c; --cc) {
                    const int tile = blk - c + cc;
                    const float A_ = AGG[(size_t)(tile * 2 + 1) * 1024 + chn], H_ = AGG[(size_t)(tile * 2 + 1) * 1024 + 512 + chn];
                    h = A_ * h + H_;
                }
            }
        }
        for (int ibi = 0; ibi < 4; ++ibi) {
            const int ib = dir ? 3 - ibi : ibi;
            const int t0 = g0 + ib * 32;
            WAVE_LDS_FENCE();
#pragma unroll
            for (int i = 0; i < 5; ++i) {
                const int rowi = (lane >> 3) + 8 * i;
                const int tt = t0 - 2 + rowi;
                uint4 v = make_uint4(0u, 0u, 0u, 0u);
                if (tt >= seq_lo && tt < seq_hi) v = *(const uint4*)(XR + (size_t)tt * 512 + w * 64 + (lane & 7) * 8);
                uint2* d = (uint2*)(xt + rowi * 68 + (lane & 7) * 8);
                d[0] = make_uint2(v.x, v.y); d[1] = make_uint2(v.z, v.w);
            }
            WAVE_LDS_FENCE();
            float xcv[4][8];
#pragma unroll
            for (int ks = 0; ks < 4; ++ks)
#pragma unroll
                for (int grp = 0; grp < 2; ++grp) {
                    const int cl = 16 * ks + 8 * grp + 4 * half;
                    const int cb4 = w * 64 + cl;
                    f32x4 a = *(const f32x4*)(p.conv_b + cb4);
#pragma unroll
                    for (int j = 0; j < 4; ++j) {
                        const f32x4 xv = ld4bf(xt + (tl + j) * 68 + cl);
                        const f32x4 wv4 = *(const f32x4*)(p.conv_w + j * 512 + cb4);
                        a += wv4 * xv;
                    }
#pragma unroll
                    for (int q = 0; q < 4; ++q) xcv[ks][grp * 4 + q] = a[q];
                }
            bf16x8 xb[4];
#pragma unroll
            for (int ks = 0; ks < 4; ++ks) {
                uint4 pw;
                pw.x = pk2(xcv[ks][0], xcv[ks][1]); pw.y = pk2(xcv[ks][2], xcv[ks][3]);
                pw.z = pk2(xcv[ks][4], xcv[ks][5]); pw.w = pk2(xcv[ks][6], xcv[ks][7]);
                xb[ks] = __builtin_bit_cast(bf16x8, pw);
            }
            WAVE_LDS_FENCE();
#pragma unroll
            for (int cb = 0; cb < 2; ++cb) {
                f32x16 aa, ax;
#pragma unroll
                for (int i = 0; i < 16; ++i) { aa[i] = 0.f; ax[i] = 0.f; }
#pragma unroll
                for (int ks = 0; ks < 4; ++ks) {
                    const bf16x8 wa = *(const bf16x8*)(LW + ((size_t)((((dir * 2 + 0) * 8 + w) * 2 + cb) * 4 + ks) * 64 + lane) * 8);
                    const bf16x8 wx = *(const bf16x8*)(LW + ((size_t)((((dir * 2 + 1) * 8 + w) * 2 + cb) * 4 + ks) * 64 + lane) * 8);
                    aa = __builtin_amdgcn_mfma_f32_32x32x16_bf16(wa, xb[ks], aa, 0, 0, 0);
                    ax = __builtin_amdgcn_mfma_f32_32x32x16_bf16(wx, xb[ks], ax, 0, 0, 0);
                }
#pragma unroll
                for (int r4 = 0; r4 < 4; ++r4) {
                    const int j0 = cb * 32 + 8 * r4 + 4 * half;
                    const int ch4 = w * 64 + j0;
                    const f32x4 ba4 = *(const f32x4*)(p.lru_ba + dir * 512 + ch4);
                    const f32x4 bx4 = *(const f32x4*)(p.lru_bx + dir * 512 + ch4);
                    const f32x4 ls4 = *(const f32x4*)(LS + dir * 512 + ch4);
                    f32x4 av, uv;
#pragma unroll
                    for (int q = 0; q < 4; ++q) {
                        const int r = 4 * r4 + q;
                        const float xcval = xcv[2 * cb + (r4 >> 1)][4 * (r4 & 1) + q];
                        const float rgate = sigmoidf_(aa[r] + ba4[q]);
                        const float igate = sigmoidf_(ax[r] + bx4[q]);
                        const float la = 8.f * rgate * ls4[q];
                        av[q] = fexp(la);
                        uv[q] = fsqrt(fmaxf(0.f, 1.f - av[q] * av[q])) * igate * xcval;
                    }
                    *(f32x4*)(abuf + tl * 68 + j0) = av;
                    *(f32x4*)(ubuf + tl * 68 + j0) = uv;
                }
            }
            WAVE_LDS_FENCE();
            float val[32];
#pragma unroll
            for (int tt = 0; tt < 32; ++tt) {
                const int tloc = dir ? 31 - tt : tt;
                const float a = abuf[tloc * 68 + lane], u = ubuf[tloc * 68 + lane];
                h = a * h + u;
                Ap *= a;
                if (FINAL) {
                    const size_t off = (size_t)(t0 + tloc) * 512 + chn;
                    if (dir == 0) {
                        HF[off] = (bf16_t)(pk2(h, 0.f) & 0xffff);
                    } else {
                        const float hf = bf1(HF[off]);
                        const float gg = bf1(GR[off]);
                        const float v = gg * (hf + h);
                        val[tt] = v;
                        abuf[tloc * 68 + lane] = v;
                    }
                }
            }
            if (FINAL && dir == 1) {
                WAVE_LDS_FENCE();
                {
                    float s = 0.f;
#pragma unroll
                    for (int q = 0; q < 8; ++q) {
                        const f32x4 v4 = *(const f32x4*)(abuf + tl * 68 + half * 32 + q * 4);
                        s += v4[0] * v4[0] + v4[1] * v4[1] + v4[2] * v4[2] + v4[3] * v4[3];
                    }
                    atomicAdd(&ssq[tl], s);
                }
                __syncthreads();
#pragma unroll
                for (int tt = 0; tt < 32; ++tt) {
                    const int tloc = 31 - tt;
                    const float rs = frsq(ssq[tloc] * (1.f / 512.f) + EPS);
                    MRG[(size_t)(t0 + tloc) * 1024 + 512 + chn] = (bf16_t)(pk2(val[tt] * rs, 0.f) & 0xffff);
                }
                __syncthreads();
                if (tid < 32) ssq[tid] = 0.f;
                __syncthreads();
            }
        }
        if (!FINAL) {
            AGG[(size_t)(blk * 2 + dir) * 1024 + chn] = Ap;
            AGG[(size_t)(blk * 2 + dir) * 1024 + 512 + chn] = h;
        }
    }
}

__device__ __forceinline__ void score_unit(const P& p, char* shm, int unit, const int wv) {
    char* ws = p.ws;
    const int sp = unit & 15, tg = unit >> 4;
    const int tid = opaque_tid(wv), w = tid >> 6, lane = tid & 63, fr = lane & 15, fq = lane >> 4;
    bf16_t* KL = (bf16_t*)shm;
    const bf16_t* KEYS = (const bf16_t*)(ws + OFF_KEYS) + (size_t)sp * 16384;
    const bf16_t* QP = (const bf16_t*)(ws + OFF_QP);
    float* SUBS = (float*)(ws + OFF_SUBS);
    __syncthreads();
    for (int i = tid; i < 2048; i += NTHREADS) {
        const int r = i >> 4, cpart = i & 15;
        *(uint4*)(KL + r * 136 + cpart * 8) = *(const uint4*)(KEYS + r * 128 + cpart * 8);
    }
    __syncthreads();
    for (int tt = 0; tt < 8; ++tt) {
        const int gb = (tg * 8 + tt) * 128 + w * 16;
        bf16x8 af[4];
#pragma unroll
        for (int ks = 0; ks < 4; ++ks) af[ks] = *(const bf16x8*)(QP + (size_t)(gb + fr) * 2048 + sp * 128 + ks * 32 + fq * 8);
        float v[4][8];
#pragma unroll
        for (int nb = 0; nb < 8; ++nb) {
            f32x4 acc = {0.f, 0.f, 0.f, 0.f};
#pragma unroll
            for (int ks = 0; ks < 4; ++ks) {
                const bf16x8 bf = *(const bf16x8*)(KL + (nb * 16 + fr) * 136 + ks * 32 + fq * 8);
                acc = __builtin_amdgcn_mfma_f32_16x16x32_bf16(af[ks], bf, acc, 0, 0, 0);
            }
#pragma unroll
            for (int i = 0; i < 4; ++i) v[i][nb] = __uint_as_float((__float_as_uint(acc[i]) & ~127u) | (unsigned)(nb * 16 + fr));
        }
        float keep[4] = {0.f, 0.f, 0.f, 0.f};
        for (int r = 0; r < 16; ++r) {
#pragma unroll
            for (int i = 0; i < 4; ++i) {
                float lm = v[i][0];
#pragma unroll
                for (int nb = 1; nb < 8; ++nb) lm = fmaxf(lm, v[i][nb]);
                const float rm = row_max16(lm);
                keep[i] = (fr == r) ? rm : keep[i];
#pragma unroll
                for (int nb = 0; nb < 8; ++nb) v[i][nb] = (v[i][nb] == rm) ? -INFINITY : v[i][nb];
            }
        }
#pragma unroll
        for (int i = 0; i < 4; ++i) SUBS[(size_t)(gb + 4 * fq + i) * 256 + sp * 16 + fr] = keep[i];
    }
}

__device__ __forceinline__ void phase_stage2(const P& p, const int wv) {
    char* ws = p.ws;
    const float* SUBS = (const float*)(ws + OFF_SUBS);
    int* PIDX = (int*)(ws + OFF_PIDX);
    float* PS = (float*)(ws + OFF_PS);
    const int gtid = blockIdx.x * NTHREADS + opaque_tid(wv), gstride = gridDim.x * NTHREADS;
    for (int idx = gtid; idx < NT * 8; idx += gstride) {
        const int tok = idx >> 3, hh = idx & 7;
        const float* s0p = SUBS + (size_t)tok * 256 + hh * 32;
        const float* s1p = s0p + 16;
        float s0[16], s1[16];
#pragma unroll
        for (int i = 0; i < 4; ++i) {
            const f32x4 a = *(const f32x4*)(s0p + 4 * i), b = *(const f32x4*)(s1p + 4 * i);
#pragma unroll
            for (int q = 0; q < 4; ++q) { s0[4 * i + q] = a[q]; s1[4 * i + q] = b[q]; }
        }
        float L[16];
#pragma unroll
        for (int i = 0; i < 16; ++i) L[i] = -INFINITY;
#pragma unroll
        for (int a = 0; a < 16; ++a)
#pragma unroll
            for (int b = 0; b < 16; ++b) {
                if ((a + 1) * (b + 1) <= 16) {
                    float nv = __uint_as_float((__float_as_uint(s0[a] + s1[b]) & ~255u) | (unsigned)(a * 16 + b));
#pragma unroll
                    for (int i = 0; i < 16; ++i) {
                        const float hi = fmaxf(L[i], nv);
                        nv = fminf(L[i], nv);
                        L[i] = hi;
                    }
                }
            }
        int ids[16];
#pragma unroll
        for (int k = 0; k < 16; ++k) {
            const unsigned code = __float_as_uint(L[k]) & 255u;
            const unsigned i0 = __float_as_uint(s0p[code >> 4]) & 127u;
            const unsigned i1 = __float_as_uint(s1p[code & 15]) & 127u;
            ids[k] = (int)(i0 * 128 + i1);
        }
        int* pi = PIDX + (size_t)tok * 128;
        f32x4* pf = (f32x4*)(PS + (size_t)tok * 128 + hh * 16);
#pragma unroll
        for (int k = 0; k < 16; ++k) pi[k * 8 + hh] = ids[k];
#pragma unroll
        for (int i = 0; i < 4; ++i) pf[i] = f32x4{L[4 * i], L[4 * i + 1], L[4 * i + 2], L[4 * i + 3]};
    }
}

__device__ __forceinline__ void unpack8(const uint4 w, float* f) {
    f[0] = bflo(w.x); f[1] = bfhi(w.x); f[2] = bflo(w.y); f[3] = bfhi(w.y);
    f[4] = bflo(w.z); f[5] = bfhi(w.z); f[6] = bflo(w.w); f[7] = bfhi(w.w);
}
__device__ __forceinline__ unsigned xcc_id() { return (unsigned)__builtin_amdgcn_s_getreg((3 << 11) | 20) & 0xFu; }
__device__ __forceinline__ float dpp_ror8(float v) {
    return __int_as_float(__builtin_amdgcn_update_dpp(0, __float_as_int(v), 0x128, 0xf, 0xf, true));
}
__device__ __forceinline__ float swz_x4(float v) { return __int_as_float(__builtin_amdgcn_ds_swizzle(__float_as_int(v), 0x101F)); }
__device__ __forceinline__ float swz_x16(float v) { return __int_as_float(__builtin_amdgcn_ds_swizzle(__float_as_int(v), 0x401F)); }

__device__ __forceinline__ void gather_item_a(const P& p, const int s, const int chunk, const int w, const int lane) {
    char* ws = p.ws;
    const bf16_t* H1B = (const bf16_t*)(ws + OFF_H1B);
    const int* PIDX = (const int*)(ws + OFF_PIDX);
    bf16_t* PART = (bf16_t*)(ws + OFF_PART);
    const int i8 = lane & 7, gq = lane >> 3;
    const unsigned char* UT = (const unsigned char*)(ws + OFF_UT) + (size_t)s * (16384 * 128) + i8 * 16;
    const bool b0 = (lane & 1) != 0, b1 = (lane & 2) != 0, b2 = (lane & 4) != 0;
    const int tok0 = chunk * 64 + w * 8;
    int4 idA[4], idB[4];
    uint4 UU[2][8], XQ[2][2];
#define LD_IDS(di, tk) do { const int4* ip_ = (const int4*)(PIDX + (size_t)(tk) * 128 + gq * 16); \
        _Pragma("unroll") for (int q_ = 0; q_ < 4; ++q_) di[q_] = ip_[q_]; } while (0)
#define LD_X(buf, tk) do { const uint4* hp_ = (const uint4*)(H1B + (size_t)(tk) * 1024 + s * 128 + i8 * 16); XQ[buf][0] = hp_[0]; XQ[buf][1] = hp_[1]; } while (0)
#define LD_U(buf, ia, ib) do { const int e_[8] = {ia.x, ia.y, ia.z, ia.w, ib.x, ib.y, ib.z, ib.w}; \
        _Pragma("unroll") for (int g_ = 0; g_ < 8; ++g_) UU[buf][g_] = *(const uint4*)(UT + ((size_t)e_[g_] << 7)); } while (0)
    LD_IDS(idA, tok0);
    LD_X(0, tok0);
    LD_U(0, idA[0], idA[1]);
    LD_IDS(idB, tok0 + 1);
#pragma unroll
    for (int j = 0; j < 8; ++j) {
        const int tok = tok0 + j;
        LD_U(1, idA[2], idA[3]);
        if (j < 7) LD_X((j + 1) & 1, tok + 1);
        __builtin_amdgcn_sched_barrier(0);
        float xs[16];
        unpack8(XQ[j & 1][0], xs); unpack8(XQ[j & 1][1], xs + 8);
        float d[16];
#pragma unroll
        for (int hf = 0; hf < 2; ++hf) {
            if (hf == 1) {
                if (j < 7) LD_U(0, idB[0], idB[1]);
                __builtin_amdgcn_sched_barrier(0);
            }
#pragma unroll
            for (int g = 0; g < 8; ++g) {
                const uint4 u4 = UU[hf][g];
                const unsigned wd[4] = {u4.x, u4.y, u4.z, u4.w};
                f32x2 d2 = {0.f, 0.f}, d3 = {0.f, 0.f};
#pragma unroll
                for (int q = 0; q < 4; ++q) {
                    const f32x2 lo = __builtin_amdgcn_cvt_pk_f32_fp8((int)wd[q], false);
                    const f32x2 hi = __builtin_amdgcn_cvt_pk_f32_fp8((int)wd[q], true);
                    const f32x2 xlo = {xs[q * 4 + 0], xs[q * 4 + 1]};
                    const f32x2 xhi = {xs[q * 4 + 2], xs[q * 4 + 3]};
                    d2 = lo * xlo + d2;
                    d3 = hi * xhi + d3;
                }
                d[hf * 8 + g] = (d2.x + d2.y) + (d3.x + d3.y);
            }
        }
        float t8[8], t4[4], t2[2];
#pragma unroll
        for (int q = 0; q < 8; ++q) {
            const float keep = b0 ? d[8 + q] : d[q], send = b0 ? d[q] : d[8 + q];
            t8[q] = keep + dppf(send, 0);
        }
#pragma unroll
        for (int q = 0; q < 4; ++q) {
            const float keep = b1 ? t8[4 + q] : t8[q], send = b1 ? t8[q] : t8[4 + q];
            t4[q] = keep + dppf(send, 1);
        }
#pragma unroll
        for (int q = 0; q < 2; ++q) {
            const float keep = b2 ? t4[2 + q] : t4[q], send = b2 ? t4[q] : t4[2 + q];
            t2[q] = keep + swz_x4(send);
        }
        const int itb = (b0 ? 8 : 0) + (b1 ? 4 : 0) + (b2 ? 2 : 0);
        *(unsigned*)(PART + ((size_t)tok * 8 + s) * 128 + gq * 16 + itb) = pk2(t2[0], t2[1]);
        if (j < 7) {
#pragma unroll
            for (int q = 0; q < 4; ++q) idA[q] = idB[q];
        }
        if (j < 6) LD_IDS(idB, tok + 2);
    }
#undef LD_IDS
#undef LD_X
#undef LD_U
}

__device__ __forceinline__ void gather_item_b(const P& p, const int s, const int chunk, const int w, const int lane) {
    char* ws = p.ws;
    const bf16_t* H1B = (const bf16_t*)(ws + OFF_H1B);
    const int* PIDX = (const int*)(ws + OFF_PIDX);
    const float* WGT = (const float*)(ws + OFF_WGT);
    bf16_t* H2B = (bf16_t*)(ws + OFF_H2B);
    float* SSQ3 = (float*)(ws + OFF_SSQ3);
    const int i8 = lane & 7, gq = lane >> 3;
    const unsigned char* VT = (const unsigned char*)(ws + OFF_VT) + (size_t)s * (16384 * 128) + i8 * 16;
    const bool b5 = (lane & 32) != 0, b4 = (lane & 16) != 0, b3 = (lane & 8) != 0;
    const int dloc = s * 128 + i8 * 16 + (b5 ? 8 : 0) + (b4 ? 4 : 0) + (b3 ? 2 : 0);
    const int tok0 = chunk * 64 + w * 8;
    int4 idA[4], idB[4];
    f32x4 wgA[4], wgB[4];
    uint4 VV[2][8];
#define LD_IW(di, dw, tk) do { const int4* ip_ = (const int4*)(PIDX + (size_t)(tk) * 128 + gq * 16); const f32x4* wp_ = (const f32x4*)(WGT + (size_t)(tk) * 128 + gq * 16); \
        _Pragma("unroll") for (int q_ = 0; q_ < 4; ++q_) { di[q_] = ip_[q_]; dw[q_] = wp_[q_]; } } while (0)
#define LD_V(buf, ia, ib) do { const int e_[8] = {ia.x, ia.y, ia.z, ia.w, ib.x, ib.y, ib.z, ib.w}; \
        _Pragma("unroll") for (int g_ = 0; g_ < 8; ++g_) VV[buf][g_] = *(const uint4*)(VT + ((size_t)e_[g_] << 7)); } while (0)
    LD_IW(idA, wgA, tok0);
    LD_V(0, idA[0], idA[1]);
    LD_IW(idB, wgB, tok0 + 1);
#pragma unroll
    for (int j = 0; j < 8; ++j) {
        const int tok = tok0 + j;
        LD_V(1, idA[2], idA[3]);
        const unsigned hw = *(const unsigned*)(H1B + (size_t)tok * 1024 + dloc);
        __builtin_amdgcn_sched_barrier(0);
        f32x2 acc[8];
#pragma unroll
        for (int q = 0; q < 8; ++q) acc[q] = f32x2{0.f, 0.f};
#pragma unroll
        for (int hf = 0; hf < 2; ++hf) {
            if (hf == 1) {
                if (j < 7) LD_V(0, idB[0], idB[1]);
                __builtin_amdgcn_sched_barrier(0);
            }
#pragma unroll
            for (int g = 0; g < 8; ++g) {
                const uint4 v4 = VV[hf][g];
                const unsigned wd[4] = {v4.x, v4.y, v4.z, v4.w};
                const float wsc = wgA[hf * 2 + (g >> 2)][g & 3];
                const f32x2 w2 = {wsc, wsc};
#pragma unroll
                for (int q = 0; q < 4; ++q) {
                    const f32x2 lo = __builtin_amdgcn_cvt_pk_f32_fp8((int)wd[q], false);
                    const f32x2 hi = __builtin_amdgcn_cvt_pk_f32_fp8((int)wd[q], true);
                    acc[2 * q] = lo * w2 + acc[2 * q];
                    acc[2 * q + 1] = hi * w2 + acc[2 * q + 1];
                }
            }
        }
        float a16[16];
#pragma unroll
        for (int q = 0; q < 8; ++q) { a16[2 * q] = acc[q].x; a16[2 * q + 1] = acc[q].y; }
        float t8[8], t4[4], t2[2];
#pragma unroll
        for (int q = 0; q < 8; ++q) {
            const float keep = b5 ? a16[8 + q] : a16[q], send = b5 ? a16[q] : a16[8 + q];
            t8[q] = keep + xor32(send, lane);
        }
#pragma unroll
        for (int q = 0; q < 4; ++q) {
            const float keep = b4 ? t8[4 + q] : t8[q], send = b4 ? t8[q] : t8[4 + q];
            t4[q] = keep + swz_x16(send);
        }
#pragma unroll
        for (int q = 0; q < 2; ++q) {
            const float keep = b3 ? t4[2 + q] : t4[q], send = b3 ? t4[q] : t4[2 + q];
            t2[q] = keep + dpp_ror8(send);
        }
        const float o0 = bflo(hw) + t2[0], o1 = bfhi(hw) + t2[1];
        *(unsigned*)(H2B + (size_t)tok * 1024 + dloc) = pk2(o0, o1);
        const float sq = wave_sum(o0 * o0 + o1 * o1);
        if (lane == 0) atomicAdd(SSQ3 + tok, sq);
        if (j < 7) {
#pragma unroll
            for (int q = 0; q < 4; ++q) { idA[q] = idB[q]; wgA[q] = wgB[q]; }
        }
        if (j < 6) LD_IW(idB, wgB, tok + 2);
    }
#undef LD_IW
#undef LD_V
}

template <int PASS>
__device__ __forceinline__ void phase_gather_sliced(const P& p, char* shm, const int wv) {
    const int tid = opaque_tid(wv), w = wv, lane = tid & 63;
    unsigned* q = (unsigned*)(p.ws + OFF_CTL) + 16 + PASS * 8;
    volatile int* sh = (volatile int*)(shm + 139392);
    const int home = (int)(xcc_id() & 7u);
    constexpr int NCH = NT / 64;
    for (int k = 0; k < 8; ++k) {
        const int s = (home + k) & 7;
        __syncthreads();
        if (tid == 0) sh[0] = (int)__hip_atomic_fetch_add(q + s, 1u, __ATOMIC_RELAXED, __HIP_MEMORY_SCOPE_AGENT);
        __syncthreads();
        int cur = sh[0];
        while (cur < NCH) {
            __syncthreads();
            if (tid == 0) sh[0] = (int)__hip_atomic_fetch_add(q + s, 1u, __ATOMIC_RELAXED, __HIP_MEMORY_SCOPE_AGENT);
            if (PASS == 0) gather_item_a(p, s, cur, w, lane); else gather_item_b(p, s, cur, w, lane);
            __syncthreads();
            cur = sh[0];
        }
    }
}

__device__ __forceinline__ void phase_gather_mid(const P& p, const int wv) {
    char* ws = p.ws;
    const int tid = opaque_tid(wv), w = wv, lane = tid & 63;
    const int gw = blockIdx.x * 8 + w, nw = gridDim.x * 8;
    const bf16_t* H1B = (const bf16_t*)(ws + OFF_H1B);
    const bf16_t* PART = (const bf16_t*)(ws + OFF_PART);
    const float* PS = (const float*)(ws + OFF_PS);
    float* WGT = (float*)(ws + OFF_WGT);
    for (int tok = gw; tok < NT; tok += nw) {
        const uint4* hp = (const uint4*)(H1B + (size_t)tok * 1024);
        float xf[16];
        unpack8(hp[lane], xf); unpack8(hp[64 + lane], xf + 8);
        float s = 0.f;
#pragma unroll
        for (int i = 0; i < 16; ++i) s += xf[i] * xf[i];
        s = wave_sum(s);
        const float rs2 = frsq(s * (1.f / 1024.f) + EPS);
        float wout[2];
        int pos[2];
#pragma unroll
        for (int hsel = 0; hsel < 2; ++hsel) {
            const int e = lane + 64 * hsel;
            const int ppos = (e & 15) * 8 + (e >> 4);
            float d = 0.f;
#pragma unroll
            for (int sl = 0; sl < 8; ++sl) d += bf1(PART[((size_t)tok * 8 + sl) * 128 + ppos]);
            const float sc = PS[(size_t)tok * 128 + e] * rs2;
            const float m = row_max16(sc);
            const float pe = fexp(sc - m);
            const float g = pe * frcp(row_sum16(pe));
            wout[hsel] = g * gelu_tanh(d * rs2 * (1.f / 64.f)) * 0.125f;
            pos[hsel] = ppos;
        }
        WGT[(size_t)tok * 128 + pos[0]] = wout[0];
        WGT[(size_t)tok * 128 + pos[1]] = wout[1];
    }
}

__global__ void __launch_bounds__(NTHREADS, 2) mega(P p) {
    extern __shared__ __attribute__((aligned(1024))) char shm[];
    cg::grid_group grid = cg::this_grid();
    char* ws = p.ws;
    const int wv = __builtin_amdgcn_readfirstlane((int)(threadIdx.x >> 6));
    const int w = wv;
    const int gw = blockIdx.x * 8 + w, nw = gridDim.x * 8;
    unsigned* bar_cnt = (unsigned*)(ws + OFF_CTL);

    phase_prep(p, wv);
    grid.sync();
    for (int rp = 0; rp < REP_GEMM; ++rp) phase_inproj(p, shm, wv);
    grid_bar(bar_cnt, (unsigned)(1 * gridDim.x), wv);
    for (int rp = 0; rp < REP_MIX; ++rp)
    for (int u = blockIdx.x; u < 1536 + 768; u += gridDim.x) {
        if (u < 1536) attn_unit(p, shm, u, wv); else lru_unit<false>(p, shm, u - 1536, wv);
    }
    grid_bar(bar_cnt, (unsigned)(2 * gridDim.x), wv);
    for (int rp = 0; rp < REP_MIX; ++rp)
    for (int u = blockIdx.x; u < 768; u += gridDim.x) lru_unit<true>(p, shm, u, wv);
    {
        const bf16_t* AT = (const bf16_t*)(ws + OFF_AT);
        bf16_t* MRG = (bf16_t*)(ws + OFF_MRG);
        const int lane = opaque_tid(wv) & 63;
        for (int tok = gw; tok < NT; tok += nw) {
            const uint4 a = ((const uint4*)(AT + (size_t)tok * 512))[lane];
            float f[8];
            unpack8(a, f);
            float s = 0.f;
#pragma unroll
            for (int i = 0; i < 8; ++i) s += f[i] * f[i];
            s = wave_sum(s);
            const float rs = frsq(s * (1.f / 512.f) + EPS);
            uint4 o;
            o.x = pk2(f[0] * rs, f[1] * rs); o.y = pk2(f[2] * rs, f[3] * rs); o.z = pk2(f[4] * rs, f[5] * rs); o.w = pk2(f[6] * rs, f[7] * rs);
            ((uint4*)(MRG + (size_t)tok * 1024))[lane] = o;
        }
    }
    grid_bar(bar_cnt, (unsigned)(3 * gridDim.x), wv);
    {
        const bf16_t* MRG = (const bf16_t*)(ws + OFF_MRG);
        const bf16_t* W = (const bf16_t*)(ws + OFF_WOUT);
        bf16_t* H1B = (bf16_t*)(ws + OFF_H1B);
        const float *xp = p.x_p, *xs = p.x_s;
        auto epi = [=](int row, int col, f32x4 v0, f32x4 v1) {
            const float* xr = (row < NTP ? xp + (size_t)row * 1024 : xs + (size_t)(row - NTP) * 1024) + col;
            const f32x4 x0 = *(const f32x4*)xr, x1 = *(const f32x4*)(xr + 16);
            bf16_t* dst = H1B + (size_t)row * 1024 + col;
            st4bf(dst, v0 + x0); st4bf(dst + 16, v1 + x1);
        };
        int pm, pn;
        for (int rp = 0; rp < REP_GEMM; ++rp)
        for (int i = 0; gemm_next(i, 4, 384 * 4, pm, pn); ++i) gemm_tile(MRG, W, 1024, pm * 256, pn * 256, shm, wv, epi);
    }
    grid_bar(bar_cnt, (unsigned)(4 * gridDim.x), wv);
    {
        const bf16_t* H1B = (const bf16_t*)(ws + OFF_H1B);
        const bf16_t* W = (const bf16_t*)(ws + OFF_WQ);
        bf16_t* QP = (bf16_t*)(ws + OFF_QP);
        auto epi = [=](int row, int col, f32x4 v0, f32x4 v1) {
            bf16_t* dst = QP + (size_t)row * 2048 + col;
            st4bf(dst, v0); st4bf(dst + 16, v1);
        };
        int pm, pn;
        for (int rp = 0; rp < REP_GEMM; ++rp)
        for (int i = 0; gemm_next(i, 8, 384 * 8, pm, pn); ++i) gemm_tile(H1B, W, 1024, pm * 256, pn * 256, shm, wv, epi);
    }
    grid_bar(bar_cnt, (unsigned)(5 * gridDim.x), wv);
    for (int rp = 0; rp < REP_PEER; ++rp)
    for (int u = blockIdx.x; u < 1536; u += gridDim.x) score_unit(p, shm, u, wv);
    grid_bar(bar_cnt, (unsigned)(6 * gridDim.x), wv);
    phase_stage2(p, wv);
    grid_bar(bar_cnt, (unsigned)(7 * gridDim.x), wv);
    phase_gather_sliced<0>(p, shm, wv);
    grid_bar(bar_cnt, (unsigned)(8 * gridDim.x), wv);
    phase_gather_mid(p, wv);
    grid_bar(bar_cnt, (unsigned)(9 * gridDim.x), wv);
    phase_gather_sliced<1>(p, shm, wv);
    grid_bar(bar_cnt, (unsigned)(10 * gridDim.x), wv);
    {
        const bf16_t* H2B = (const bf16_t*)(ws + OFF_H2B);
        const bf16_t* WG = (const bf16_t*)(ws + OFF_WG);
        const bf16_t* PB = (const bf16_t*)(ws + OFF_PB);
        const bf16_t* WP = (const bf16_t*)(ws + OFF_WP);
        const float* SSQ3 = (const float*)(ws + OFF_SSQ3);
        bf16_t* G = (bf16_t*)(ws + OFF_G);
        bf16_t* H3 = (bf16_t*)(ws + OFF_H3);
        auto epi_g = [=](int row, int col, f32x4 v0, f32x4 v1) {
            const float rs = frsq(SSQ3[row] * (1.f / 1024.f) + EPS);
            f32x4 a, b;
#pragma unroll
            for (int j = 0; j < 4; ++j) { a[j] = sigmoidf_(v0[j] * rs); b[j] = sigmoidf_(v1[j] * rs); }
            bf16_t* dst = G + (size_t)row * 1024 + col;
            st4bf(dst, a); st4bf(dst + 16, b);
        };
        auto epi_p = [=](int row, int col, f32x4 v0, f32x4 v1) {
            const size_t off = (size_t)row * 1024 + col;
            const f32x4 g0 = ld4bf(G + off), g1 = ld4bf(G + off + 16);
            const f32x4 h0 = ld4bf(H2B + off), h1 = ld4bf(H2B + off + 16);
            st4bf(H3 + off, h0 + g0 * v0); st4bf(H3 + off + 16, h1 + g1 * v1);
        };
        int pm, pn;
        for (int rp = 0; rp < REP_GEMM; ++rp)
        for (int i = 0; gemm_next(i, 4, 384 * 4, pm, pn); ++i) gemm_tile(H2B, WG, 1024, pm * 256, pn * 256, shm, wv, epi_g);
        for (int rp = 0; rp < REP_GEMM; ++rp)
        for (int i = 0; gemm_next(i, 4, 384 * 4, pm, pn); ++i) gemm_tile(PB, WP, 256, pm * 256, pn * 256, shm, wv, epi_p);
    }
    grid_bar(bar_cnt, (unsigned)(11 * gridDim.x), wv);
    {
        const bf16_t* H3 = (const bf16_t*)(ws + OFF_H3);
        const int lane = opaque_tid(wv) & 63;
        for (int tok = gw; tok < NT; tok += nw) {
            const uint2* hp = (const uint2*)(H3 + (size_t)tok * 1024);
            float f[16];
            float s = 0.f;
#pragma unroll
            for (int j = 0; j < 4; ++j) {
                const uint2 a = hp[lane + 64 * j];
                f[4 * j] = bflo(a.x); f[4 * j + 1] = bfhi(a.x); f[4 * j + 2] = bflo(a.y); f[4 * j + 3] = bfhi(a.y);
            }
#pragma unroll
            for (int i = 0; i < 16; ++i) s += f[i] * f[i];
            s = wave_sum(s);
            const float rs = frsq(s * (1.f / 1024.f) + EPS);
            float4* op = (float4*)(p.out + (size_t)tok * 1024);
#pragma unroll
            for (int j = 0; j < 4; ++j) {
                const float4 g = ((const float4*)p.fin_g)[lane + 64 * j];
                float4 o;
                o.x = f[4 * j] * rs * g.x; o.y = f[4 * j + 1] * rs * g.y; o.z = f[4 * j + 2] * rs * g.z; o.w = f[4 * j + 3] * rs * g.w;
                op[lane + 64 * j] = o;
            }
        }
    }
}

extern "C" void kernel_launch(void* const* d_in, const int* in_sizes, int n_in, void* d_out, int out_size, void* d_ws, size_t ws_size,
                              hipStream_t stream) {
    static int grid = 0;
    if (grid == 0) {
        if (n_in != 26 || ws_size < WS_END) {
            fprintf(stderr, "kernel_launch: unexpected n_in %d or ws_size %zu (< %zu)\n", n_in, ws_size, (size_t)WS_END);
            grid = -1;
            return;
        }
        int dev = 0, cus = 0, per_cu = 0;
        hipGetDevice(&dev);
        hipDeviceGetAttribute(&cus, hipDeviceAttributeMultiprocessorCount, dev);
        hipFuncSetAttribute((const void*)mega, hipFuncAttributeMaxDynamicSharedMemorySize, LDS_BYTES);
        hipOccupancyMaxActiveBlocksPerMultiprocessor(&per_cu, (const void*)mega, NTHREADS, LDS_BYTES);
        if (per_cu < 1) { fprintf(stderr, "kernel_launch: occupancy query says %d blocks/CU\n", per_cu); per_cu = 1; }
        grid = cus * 1;
        (void)hipGetLastError();
    }
    if (grid < 0) return;
    if (hipMemsetAsync((char*)d_ws + OFF_CTL, 0, 256, stream) != hipSuccess) fprintf(stderr, "kernel_launch: memset failed\n");
    P p{};
    const float** pp = (const float**)&p;
    for (int i = 0; i < 26; ++i) pp[i] = (const float*)d_in[i];
    p.out = (float*)d_out;
    p.ws = (char*)d_ws;
    void* args[] = {&p};
    hipError_t e = hipLaunchCooperativeKernel((const void*)mega, dim3(grid), dim3(NTHREADS), args, LDS_BYTES, stream);
    if (e != hipSuccess) fprintf(stderr, "cooperative launch failed: %s (grid %d)\n", hipGetErrorString(e), grid);
}
```

```cpp
#include <hip/hip_runtime.h>
#include <hip/hip_cooperative_groups.h>
#include <cstdio>
#include <cstdint>
namespace cg = cooperative_groups;

typedef unsigned short bf16_t;
typedef __bf16 bf16x8 __attribute__((ext_vector_type(8)));
typedef __bf16 bf16x2v __attribute__((ext_vector_type(2)));
typedef float f32x4 __attribute__((ext_vector_type(4)));
typedef float f32x16 __attribute__((ext_vector_type(16)));
typedef float f32x2 __attribute__((ext_vector_type(2)));

constexpr int NT = 98304;
constexpr int NTP = 65536;
constexpr float EPS = 1e-6f;
constexpr int LDS_BYTES = 147456;
constexpr int NTHREADS = 512;
#define REP_GEMM 1
#define REP_MIX 1
#define REP_PEER 1

constexpr size_t MiB = 1ull << 20;
constexpr size_t OFF_R0 = 0;
constexpr size_t OFF_R1 = 192 * MiB;
constexpr size_t OFF_R2 = 576 * MiB;
constexpr size_t OFF_R3 = 768 * MiB;
constexpr size_t OFF_WIN = OFF_R3;
constexpr size_t OFF_WOUT = OFF_WIN + 1792ull * 1024 * 2;
constexpr size_t OFF_WQ = OFF_WOUT + 1024ull * 1024 * 2;
constexpr size_t OFF_WG = OFF_WQ + 2048ull * 1024 * 2;
constexpr size_t OFF_WP = OFF_WG + 1024ull * 1024 * 2;
constexpr size_t OFF_KEYS = OFF_WP + 1024ull * 256 * 2;
constexpr size_t OFF_UT = OFF_KEYS + 16ull * 128 * 128 * 2;
constexpr size_t OFF_VT = OFF_UT + 16384ull * 1024 * 2;
constexpr size_t OFF_LW = OFF_VT + 16384ull * 1024 * 2;
constexpr size_t OFF_LS = OFF_LW + 2ull * 2 * 8 * 64 * 64 * 2;
constexpr size_t OFF_PB = OFF_LS + 4096;
constexpr size_t OFF_RS1 = OFF_PB + (size_t)NT * 256 * 2;
constexpr size_t OFF_RS3 = OFF_RS1 + (size_t)NT * 4;
constexpr size_t OFF_AGG = OFF_RS3 + (size_t)NT * 4;
constexpr size_t OFF_SSQ3 = OFF_AGG + 768ull * 2 * 1024 * 4;
constexpr size_t OFF_CTL = OFF_SSQ3 + (size_t)NT * 4;
constexpr size_t WS_END = OFF_CTL + 256;
constexpr size_t OFF_Q = OFF_R1;
constexpr size_t OFF_KB = OFF_R1 + 96 * MiB;
constexpr size_t OFF_VB = OFF_R1 + 120 * MiB;
constexpr size_t OFF_XR = OFF_R1 + 144 * MiB;
constexpr size_t OFF_GR = OFF_R1 + 240 * MiB;
constexpr size_t OFF_QP = OFF_R1;
constexpr size_t OFF_H2B = OFF_R1;
constexpr size_t OFF_G = OFF_R1 + 192 * MiB;
constexpr size_t OFF_PART = OFF_R1 + 192 * MiB;
constexpr size_t OFF_AT = OFF_R2;
constexpr size_t OFF_HF = OFF_R2 + 96 * MiB;
constexpr size_t OFF_H1B = OFF_R2;
constexpr size_t OFF_XB = OFF_R0;
constexpr size_t OFF_MRG = OFF_R0;
constexpr size_t OFF_SUBS = OFF_R0;
constexpr size_t OFF_WGT = OFF_R0;
constexpr size_t OFF_PIDX = OFF_R0 + 96 * MiB;
constexpr size_t OFF_PS = OFF_R0 + 144 * MiB;
constexpr size_t OFF_H3 = OFF_R0;

struct P {
    const float *x_p, *x_s, *p_p, *p_s, *mix_g, *w_in, *sink, *conv_w, *conv_b, *lru_wa, *lru_ba, *lru_wx, *lru_bx, *lru_lam,
        *attn_g, *lru_g, *w_out, *ffn_g, *peer_wq, *peer_keys, *peer_u, *peer_v, *ple_g, *ple_wg, *ple_wp, *fin_g;
    float* out;
    char* ws;
};

__device__ __forceinline__ int opaque_tid(int wv) { unsigned z = 0; asm volatile("" : "+v"(z)); int l = __builtin_amdgcn_mbcnt_hi(~0u, __builtin_amdgcn_mbcnt_lo(~0u, z)); return wv * 64 + l; }
__device__ __forceinline__ unsigned pk2(float lo, float hi) {
    unsigned r;
    asm("v_cvt_pk_bf16_f32 %0, %1, %2" : "=v"(r) : "v"(lo), "v"(hi));
    return r;
}
__device__ __forceinline__ float bflo(unsigned w) { return __uint_as_float(w << 16); }
__device__ __forceinline__ float bfhi(unsigned w) { return __uint_as_float(w & 0xffff0000u); }
__device__ __forceinline__ float bf1(bf16_t h) { return __uint_as_float((unsigned)h << 16); }
__device__ __forceinline__ void st4bf(bf16_t* dst, f32x4 v) {
    uint2 o; o.x = pk2(v[0], v[1]); o.y = pk2(v[2], v[3]);
    *(uint2*)dst = o;
}
__device__ __forceinline__ f32x4 ld4bf(const bf16_t* src) {
    uint2 o = *(const uint2*)src;
    f32x4 v; v[0] = bflo(o.x); v[1] = bfhi(o.x); v[2] = bflo(o.y); v[3] = bfhi(o.y);
    return v;
}
__device__ __forceinline__ float dppf(float v, const int ctrl_sel) {
    int t = 0;
    if (ctrl_sel == 0) t = __builtin_amdgcn_update_dpp(0, __float_as_int(v), 0xB1, 0xf, 0xf, true);
    else if (ctrl_sel == 1) t = __builtin_amdgcn_update_dpp(0, __float_as_int(v), 0x4E, 0xf, 0xf, true);
    else if (ctrl_sel == 2) t = __builtin_amdgcn_update_dpp(0, __float_as_int(v), 0x141, 0xf, 0xf, true);
    else t = __builtin_amdgcn_update_dpp(0, __float_as_int(v), 0x140, 0xf, 0xf, true);
    return __int_as_float(t);
}
__device__ __forceinline__ float row_max16(float v) {
    v = fmaxf(v, dppf(v, 0)); v = fmaxf(v, dppf(v, 1)); v = fmaxf(v, dppf(v, 2)); v = fmaxf(v, dppf(v, 3));
    return v;
}
__device__ __forceinline__ float row_sum16(float v) {
    v += dppf(v, 0); v += dppf(v, 1); v += dppf(v, 2); v += dppf(v, 3);
    return v;
}
__device__ __forceinline__ float wave_sum(float v) {
    v = row_sum16(v);
    v += __int_as_float(__builtin_amdgcn_ds_swizzle(__float_as_int(v), 0x401F));
    return __int_as_float(__builtin_amdgcn_readlane(__float_as_int(v), 0)) + __int_as_float(__builtin_amdgcn_readlane(__float_as_int(v), 32));
}
__device__ __forceinline__ float xor32(float v, int lane) {
    return __int_as_float(__builtin_amdgcn_ds_bpermute((lane ^ 32) << 2, __float_as_int(v)));
}
__device__ __forceinline__ void grid_bar(unsigned* cnt, const unsigned target, const int wv) {
    __syncthreads();
    if (wv == 0) {
        const int l = opaque_tid(0);
        if (l == 0) {
            __builtin_amdgcn_fence(__ATOMIC_RELEASE, "agent");
            asm volatile("s_waitcnt vmcnt(0)" ::: "memory");
            __hip_atomic_fetch_add(cnt, 1u, __ATOMIC_RELAXED, __HIP_MEMORY_SCOPE_AGENT);
            while (__hip_atomic_load(cnt, __ATOMIC_RELAXED, __HIP_MEMORY_SCOPE_AGENT) < target) __builtin_amdgcn_s_sleep(2);
            __builtin_amdgcn_fence(__ATOMIC_ACQUIRE, "agent");
            asm volatile("s_waitcnt vmcnt(0)" ::: "memory");
        }
    }
    __syncthreads();
}
__device__ __forceinline__ float fexp(float x) { return __builtin_amdgcn_exp2f(x * 1.4426950408889634f); }
__device__ __forceinline__ float frcp(float x) { return __builtin_amdgcn_rcpf(x); }
__device__ __forceinline__ float fsqrt(float x) { return __builtin_amdgcn_sqrtf(x); }
__device__ __forceinline__ float frsq(float x) { return __builtin_amdgcn_rsqf(x); }
__device__ __forceinline__ float sigmoidf_(float x) { return frcp(1.f + fexp(-x)); }
__device__ __forceinline__ float gelu_tanh(float x) {
    const float y2 = 1.5957691216057308f * (x + 0.044715f * x * x * x);
    return x * frcp(1.f + fexp(-y2));
}
__device__ __forceinline__ int tok_pos(int g) { return g < NTP ? (g & 2047) : (g & 16383); }
__device__ __forceinline__ void tile_seq(int blk, int& c, int& nc) {
    if (blk < 512) { c = blk & 15; nc = 16; } else { c = (blk - 512) & 127; nc = 128; }
}
__device__ __forceinline__ float dot2bf(unsigned a, unsigned b, float acc) {
    return __builtin_amdgcn_fdot2_f32_bf16(__builtin_bit_cast(bf16x2v, a), __builtin_bit_cast(bf16x2v, b), acc, false);
}

__device__ __forceinline__ int lds_byte(int r, int c) {
    int st = (r >> 4) * 2 + (c >> 5), ob = (r & 15) * 64 + (c & 31) * 2;
    return st * 1024 + (ob ^ (((ob >> 9) & 1) << 5));
}
__device__ __forceinline__ void stage_rc(int b, int& R, int& C) {
    int st = b >> 10, sb = b & 1023, swz = sb ^ (((sb >> 9) & 1) << 5);
    R = (st / 2) * 16 + swz / 64;
    C = (st % 2) * 32 + (swz % 64) / 2;
}
#define WAIT_V0() asm volatile("s_waitcnt vmcnt(0)" ::: "memory")

template <class Epi>
__device__ __forceinline__ void gemm_tile(const bf16_t* __restrict__ A, const bf16_t* __restrict__ Bt, const int K,
                                          const int brow, const int bcol, char* shm, const int wv, Epi epi) {
    constexpr int BK = 64, TILE_B = 256 * BK * 2, GL = 4, STAGE_B = 2 * TILE_B;
    const int tid = opaque_tid(wv), wid = tid >> 6, lane = tid & 63, wr = wid >> 2, wc = wid & 3, fr = lane & 15, fq = lane >> 4;
    const bf16_t* Ab = A + (size_t)brow * K;
    const bf16_t* Bb = Bt + (size_t)bcol * K;
    int sR[GL], sC[GL];
#pragma unroll
    for (int i = 0; i < GL; ++i) stage_rc(wid * 1024 + i * 8192 + lane * 16, sR[i], sC[i]);
    f32x4 acc[8][4];
#pragma unroll
    for (int m = 0; m < 8; ++m)
#pragma unroll
        for (int n = 0; n < 4; ++n) acc[m][n] = f32x4{0.f, 0.f, 0.f, 0.f};
    const int nt = K / BK;
#define GSTAGE(buf, kt)                                                                                              \
    do {                                                                                                             \
        _Pragma("unroll") for (int i = 0; i < GL; ++i) {                                                             \
            __builtin_amdgcn_global_load_lds((const unsigned*)(Ab + (size_t)sR[i] * K + (kt) * BK + sC[i]),          \
                                             (unsigned*)(shm + (buf) * STAGE_B + wid * 1024 + i * 8192), 16, 0, 0);   \
            __builtin_amdgcn_global_load_lds((const unsigned*)(Bb + (size_t)sR[i] * K + (kt) * BK + sC[i]),          \
                                             (unsigned*)(shm + (buf) * STAGE_B + TILE_B + wid * 1024 + i * 8192), 16, 0, 0); \
        }                                                                                                            \
    } while (0)
    __syncthreads();
    GSTAGE(0, 0);
    WAIT_V0();
    __syncthreads();
    for (int t = 0; t < nt; ++t) {
        const int cur = t & 1;
        if (t + 1 < nt) GSTAGE(cur ^ 1, t + 1);
        const char* sa = shm + cur * STAGE_B;
        const char* sb = sa + TILE_B;
#pragma unroll
        for (int ks = 0; ks < 2; ++ks) {
            bf16x8 At[8], Bf[4];
#pragma unroll
            for (int m = 0; m < 8; ++m) At[m] = *(const bf16x8*)(sa + lds_byte(wr * 128 + m * 16 + fr, ks * 32 + fq * 8));
#pragma unroll
            for (int n = 0; n < 4; ++n) Bf[n] = *(const bf16x8*)(sb + lds_byte(wc * 64 + n * 16 + fr, ks * 32 + fq * 8));
#pragma unroll
            for (int m = 0; m < 8; ++m)
#pragma unroll
                for (int n = 0; n < 4; ++n) acc[m][n] = __builtin_amdgcn_mfma_f32_16x16x32_bf16(Bf[n], At[m], acc[m][n], 0, 0, 0);
            __builtin_amdgcn_sched_barrier(0);
        }
        WAIT_V0();
        __syncthreads();
    }
#undef GSTAGE
#pragma unroll
    for (int m = 0; m < 8; ++m) {
        const int row = brow + wr * 128 + m * 16 + fr;
#pragma unroll
        for (int np = 0; np < 2; ++np) {
            const int col = bcol + wc * 64 + np * 32 + fq * 4;
            epi(row, col, acc[m][2 * np], acc[m][2 * np + 1]);
        }
    }
}

__device__ __forceinline__ bool gemm_next(int i, int nN, int nTiles, int& pm, int& pn) {
    const int G = gridDim.x, b = blockIdx.x;
    int v = b;
    if ((G & 7) == 0) v = (b & 7) * (G >> 3) + (b >> 3);
    const int L = i * G + v;
    if (L >= nTiles) return false;
    pm = L / nN; pn = L % nN;
    return true;
}

template <class NMap, class Scale>
__device__ __forceinline__ void prep_wT(const float* __restrict__ src, bf16_t* __restrict__ dst, int K, int N, int gtid, int gstride,
                                        NMap nmap, Scale scale) {
    const int items = N * (K / 8);
    for (int it = gtid; it < items; it += gstride) {
        const int n = it % N, k0 = (it / N) * 8;
        const int ns = nmap(n);
        float v[8];
#pragma unroll
        for (int i = 0; i < 8; ++i) v[i] = src[(size_t)(k0 + i) * N + ns] * scale(k0 + i);
        uint4 o; o.x = pk2(v[0], v[1]); o.y = pk2(v[2], v[3]); o.z = pk2(v[4], v[5]); o.w = pk2(v[6], v[7]);
        *(uint4*)(dst + (size_t)n * K + k0) = o;
    }
}

__device__ __forceinline__ void phase_prep(const P& p, const int wv) {
    const int gtid = blockIdx.x * NTHREADS + opaque_tid(wv), gstride = gridDim.x * NTHREADS;
    const int lane = gtid & 63, gw = gtid >> 6, nw = gstride >> 6;
    char* ws = p.ws;
    {
        const float* g = p.mix_g;
        prep_wT(p.w_in, (bf16_t*)(ws + OFF_WIN), 1024, 1792, gtid, gstride,
                [](int n) { if (n >= 640) return n; int pp = n & 63; return (n & ~63) + (pp >> 5) * 16 + ((pp >> 4) & 1) * 32 + (pp & 15); },
                [g](int k) { return g[k]; });
    }
    {
        const float *ga = p.attn_g, *gl = p.lru_g;
        prep_wT(p.w_out, (bf16_t*)(ws + OFF_WOUT), 1024, 1024, gtid, gstride, [](int n) { return n; },
                [ga, gl](int k) { return k < 512 ? ga[k] : gl[k - 512]; });
    }
    {
        const float* g = p.ffn_g;
        prep_wT(p.peer_wq, (bf16_t*)(ws + OFF_WQ), 1024, 2048, gtid, gstride, [](int n) { return n; }, [g](int k) { return g[k]; });
    }
    {
        const float* g = p.ple_g;
        prep_wT(p.ple_wg, (bf16_t*)(ws + OFF_WG), 1024, 1024, gtid, gstride, [](int n) { return n; }, [g](int k) { return g[k]; });
    }
    prep_wT(p.ple_wp, (bf16_t*)(ws + OFF_WP), 256, 1024, gtid, gstride, [](int n) { return n; }, [](int) { return 1.f; });
    {
        bf16_t* kb = (bf16_t*)(ws + OFF_KEYS);
        for (int i = gtid; i < 16 * 128 * 128 / 2; i += gstride) {
            float2 v = ((const float2*)p.peer_keys)[i];
            ((unsigned*)kb)[i] = pk2(v.x, v.y);
        }
    }
    {
        bf16_t* lw = (bf16_t*)(ws + OFF_LW);
        for (int i = gtid; i < 2 * 2 * 8 * 64 * 64; i += gstride) {
            const int e = i & 7, ln = (i >> 3) & 63, ks = (i >> 9) & 3, cb = (i >> 11) & 1, h = (i >> 12) & 7, mat = (i >> 15) & 1, dir = (i >> 16) & 1;
            const int tl = ln & 31, hf = ln >> 5;
            const int j = cb * 32 + tl;
            const int ii = 16 * ks + 8 * (e >> 2) + 4 * hf + (e & 3);
            const float* srcw = mat ? p.lru_wx : p.lru_wa;
            const float v = srcw[(((size_t)dir * 8 + h) * 64 + ii) * 64 + j];
            lw[i] = (bf16_t)(pk2(v, 0.f) & 0xffff);
        }
        float* ls = (float*)(ws + OFF_LS);
        for (int i = gtid; i < 1024; i += gstride) {
            const float lam = p.lru_lam[i];
            ls[i] = lam >= 0.f ? -log1pf(expf(-lam)) : lam - log1pf(expf(lam));
        }
    }
    {
        const float* g = p.ffn_g;
        const float4* us = (const float4*)p.peer_u;
        const float4* vs = (const float4*)p.peer_v;
        uint4* ud = (uint4*)(ws + OFF_UT);
        uint4* vd = (uint4*)(ws + OFF_VT);
        for (int i = gtid; i < 16384 * 64; i += gstride) {
            unsigned uo[4], vo[4];
#pragma unroll
            for (int q = 0; q < 4; ++q) {
                const float4 u = us[(size_t)i * 4 + q], v = vs[(size_t)i * 4 + q];
                const float4 gg = ((const float4*)g)[(i * 4 + q) & 255];
                int a = __builtin_amdgcn_cvt_pk_fp8_f32(u.x * gg.x * 64.f, u.y * gg.y * 64.f, 0, false);
                a = __builtin_amdgcn_cvt_pk_fp8_f32(u.z * gg.z * 64.f, u.w * gg.w * 64.f, a, true);
                int b = __builtin_amdgcn_cvt_pk_fp8_f32(v.x * 8.f, v.y * 8.f, 0, false);
                b = __builtin_amdgcn_cvt_pk_fp8_f32(v.z * 8.f, v.w * 8.f, b, true);
                uo[q] = (unsigned)a; vo[q] = (unsigned)b;
            }
            const int e_ = i >> 6, c16 = i & 63;
            const size_t di = ((size_t)(c16 >> 3) * 16384 + e_) * 8 + (c16 & 7);
            ud[di] = make_uint4(uo[0], uo[1], uo[2], uo[3]);
            vd[di] = make_uint4(vo[0], vo[1], vo[2], vo[3]);
        }
    }
    {
        float* sq = (float*)(ws + OFF_SSQ3);
        for (int i = gtid; i < NT; i += gstride) sq[i] = 0.f;
    }
    {
        uint2* pd = (uint2*)(ws + OFF_PB);
        for (int i = gtid; i < NT * 64; i += gstride) {
            const float4 v = i < NTP * 64 ? ((const float4*)p.p_p)[i] : ((const float4*)p.p_s)[i - NTP * 64];
            uint2 a; a.x = pk2(v.x, v.y); a.y = pk2(v.z, v.w);
            pd[i] = a;
        }
    }
    {
        bf16_t* xb = (bf16_t*)(ws + OFF_XB);
        float* rs1 = (float*)(ws + OFF_RS1);
        for (int tok = gw; tok < NT; tok += nw) {
            const float4* xr = (const float4*)(tok < NTP ? p.x_p + (size_t)tok * 1024 : p.x_s + (size_t)(tok - NTP) * 1024);
            float s = 0.f;
            uint2* od = (uint2*)(xb + (size_t)tok * 1024);
#pragma unroll
            for (int j = 0; j < 4; ++j) {
                const float4 v = xr[lane + 64 * j];
                s += v.x * v.x + v.y * v.y + v.z * v.z + v.w * v.w;
                uint2 a; a.x = pk2(v.x, v.y); a.y = pk2(v.z, v.w);
                od[lane + 64 * j] = a;
            }
            s = wave_sum(s);
            if (lane == 0) rs1[tok] = frsq(s * (1.f / 1024.f) + EPS);
        }
    }
}

__device__ __forceinline__ void phase_inproj(const P& p, char* shm, const int wv) {
    char* ws = p.ws;
    const bf16_t* XB = (const bf16_t*)(ws + OFF_XB);
    const bf16_t* W = (const bf16_t*)(ws + OFF_WIN);
    const float* RS1 = (const float*)(ws + OFF_RS1);
    bf16_t* Q = (bf16_t*)(ws + OFF_Q);
    bf16_t* KB = (bf16_t*)(ws + OFF_KB);
    bf16_t* VB = (bf16_t*)(ws + OFF_VB);
    bf16_t* XR = (bf16_t*)(ws + OFF_XR);
    bf16_t* GR = (bf16_t*)(ws + OFF_GR);
    auto epi = [=](int row, int col, f32x4 v0, f32x4 v1) {
        const float rs = RS1[row];
        v0 *= rs; v1 *= rs;
        if (col < 640) {
            const int pos = tok_pos(row);
            const int d0 = ((col & 63) >> 5) * 16 + (col & 15);
            f32x4 o0, o1;
#pragma unroll
            for (int j = 0; j < 4; ++j) {
                const float invf = exp2f(-(float)(d0 + j) * 0.41524101186092029f);
                const float ang = (float)pos * invf;
                const float nrev = rintf(ang * 0.15915494309189535f);
                float rr = fmaf(-nrev, 6.28125f, ang);
                rr = fmaf(-nrev, 0.0019353071795864769f, rr);
                const float cs = __cosf(rr), sn = __sinf(rr);
                o0[j] = v0[j] * cs - v1[j] * sn;
                o1[j] = v1[j] * cs + v0[j] * sn;
            }
            if (col < 512) {
                o0 *= 0.125f; o1 *= 0.125f;
                bf16_t* dst = Q + (size_t)row * 512 + (col & ~63) + d0;
                st4bf(dst, o0); st4bf(dst + 32, o1);
            } else {
                bf16_t* dst = KB + (size_t)row * 128 + ((col - 512) & ~63) + d0;
                st4bf(dst, o0); st4bf(dst + 32, o1);
            }
        } else if (col < 768) {
            bf16_t* dst = VB + (size_t)row * 128 + (col - 640);
            st4bf(dst, v0); st4bf(dst + 16, v1);
        } else if (col < 1280) {
            bf16_t* dst = XR + (size_t)row * 512 + (col - 768);
            st4bf(dst, v0); st4bf(dst + 16, v1);
        } else {
            bf16_t* dst = GR + (size_t)row * 512 + (col - 1280);
            f32x4 g0, g1;
#pragma unroll
            for (int j = 0; j < 4; ++j) { g0[j] = gelu_tanh(v0[j]); g1[j] = gelu_tanh(v1[j]); }
            st4bf(dst, g0); st4bf(dst + 16, g1);
        }
    };
    int pm, pn;
    for (int i = 0; gemm_next(i, 7, 384 * 7, pm, pn); ++i) gemm_tile(XB, W, 1024, pm * 256, pn * 256, shm, wv, epi);
}

__device__ __forceinline__ void attn_unit(const P& p, char* shm, int unit, const int wv) {
    char* ws = p.ws;
    const int blk = unit >> 1, kvh = unit & 1;
    int c, nc; tile_seq(blk, c, nc);
    const int g0 = blk * 128;
    bf16_t* Ks = (bf16_t*)shm;
    bf16_t* Vt = (bf16_t*)(shm + 55296);
    const bf16_t* KB = (const bf16_t*)(ws + OFF_KB);
    const bf16_t* VB = (const bf16_t*)(ws + OFF_VB);
    const bf16_t* Q = (const bf16_t*)(ws + OFF_Q);
    bf16_t* AT = (bf16_t*)(ws + OFF_AT);
    const int tid = opaque_tid(wv), w = tid >> 6, lane = tid & 63, half = lane >> 5, tl = lane & 31;
    __syncthreads();
    for (int item = tid; item < 384 * 8; item += NTHREADS) {
        const int key = item % 384, part = item / 384;
        const int ch = key >> 7;
        if ((ch == 0 && c == 0) || (ch == 2 && c == nc - 1)) continue;
        const size_t tok = (size_t)(g0 - 128 + key);
        const uint4 kv = *(const uint4*)(KB + tok * 128 + kvh * 64 + part * 8);
        *(uint4*)(Ks + key * 72 + part * 8) = kv;
        const uint4 vv = *(const uint4*)(VB + tok * 128 + kvh * 64 + part * 8);
        bf16_t* vd = Vt + (part * 8) * 388 + key;
        vd[0 * 388] = (bf16_t)(vv.x & 0xffff); vd[1 * 388] = (bf16_t)(vv.x >> 16);
        vd[2 * 388] = (bf16_t)(vv.y & 0xffff); vd[3 * 388] = (bf16_t)(vv.y >> 16);
        vd[4 * 388] = (bf16_t)(vv.z & 0xffff); vd[5 * 388] = (bf16_t)(vv.z >> 16);
        vd[6 * 388] = (bf16_t)(vv.w & 0xffff); vd[7 * 388] = (bf16_t)(vv.w >> 16);
    }
    __syncthreads();
    for (int it = 0; it < 2; ++it) {
        const int task = w + 8 * it;
        const int qhl = task & 3, rg = task >> 2;
        const int hq = kvh * 4 + qhl;
        const int qrow = rg * 32 + tl;
        const bf16_t* qp = Q + (size_t)(g0 + qrow) * 512 + hq * 64 + half * 8;
        bf16x8 qf[4];
#pragma unroll
        for (int ks = 0; ks < 4; ++ks) qf[ks] = *(const bf16x8*)(qp + ks * 16);
        float m = p.sink[hq];
        float l = half == 0 ? 1.f : 0.f;
        f32x16 O0, O1;
#pragma unroll
        for (int i = 0; i < 16; ++i) { O0[i] = 0.f; O1[i] = 0.f; }
        for (int ch = 0; ch < 3; ++ch) {
            if ((ch == 0 && c == 0) || (ch == 2 && c == nc - 1)) continue;
            f32x16 S[4];
#pragma unroll
            for (int kb = 0; kb < 4; ++kb) {
#pragma unroll
                for (int i = 0; i < 16; ++i) S[kb][i] = 0.f;
#pragma unroll
                for (int ks = 0; ks < 4; ++ks) {
                    const bf16x8 kf = *(const bf16x8*)(Ks + (ch * 128 + kb * 32 + tl) * 72 + ks * 16 + half * 8);
                    S[kb] = __builtin_amdgcn_mfma_f32_32x32x16_bf16(kf, qf[ks], S[kb], 0, 0, 0);
                }
            }
            float mx = -INFINITY;
#pragma unroll
            for (int kb = 0; kb < 4; ++kb)
#pragma unroll
                for (int i = 0; i < 16; ++i) {
                    const int kk = kb * 32 + 8 * (i >> 2) + 4 * half + (i & 3);
                    const bool valid = (ch == 1) || (ch == 0 ? kk >= qrow : kk <= qrow);
                    const float s = valid ? S[kb][i] : -INFINITY;
                    S[kb][i] = s;
                    mx = fmaxf(mx, s);
                }
            mx = fmaxf(mx, xor32(mx, lane));
            const float mn = fmaxf(m, mx);
            const float alpha = fexp(m - mn);
            m = mn;
            float ps = 0.f;
#pragma unroll
            for (int kb = 0; kb < 4; ++kb)
#pragma unroll
                for (int i = 0; i < 16; ++i) {
                    const float pv = fexp(S[kb][i] - mn);
                    S[kb][i] = pv;
                    ps += pv;
                }
            l = l * alpha + ps;
#pragma unroll
            for (int i = 0; i < 16; ++i) { O0[i] *= alpha; O1[i] *= alpha; }
#pragma unroll
            for (int kb = 0; kb < 4; ++kb)
#pragma unroll
                for (int s2 = 0; s2 < 2; ++s2) {
                    uint4 pw;
                    pw.x = pk2(S[kb][8 * s2 + 0], S[kb][8 * s2 + 1]); pw.y = pk2(S[kb][8 * s2 + 2], S[kb][8 * s2 + 3]);
                    pw.z = pk2(S[kb][8 * s2 + 4], S[kb][8 * s2 + 5]); pw.w = pk2(S[kb][8 * s2 + 6], S[kb][8 * s2 + 7]);
                    const bf16x8 pf = __builtin_bit_cast(bf16x8, pw);
                    const bf16_t* vp = Vt + tl * 388 + ch * 128 + kb * 32 + 16 * s2 + 4 * half;
                    uint4 vw;
                    uint2 a0 = *(const uint2*)vp, a1 = *(const uint2*)(vp + 8);
                    vw.x = a0.x; vw.y = a0.y; vw.z = a1.x; vw.w = a1.y;
                    O0 = __builtin_amdgcn_mfma_f32_32x32x16_bf16(__builtin_bit_cast(bf16x8, vw), pf, O0, 0, 0, 0);
                    const bf16_t* vp1 = vp + 32 * 388;
                    a0 = *(const uint2*)vp1; a1 = *(const uint2*)(vp1 + 8);
                    vw.x = a0.x; vw.y = a0.y; vw.z = a1.x; vw.w = a1.y;
                    O1 = __builtin_amdgcn_mfma_f32_32x32x16_bf16(__builtin_bit_cast(bf16x8, vw), pf, O1, 0, 0, 0);
                }
        }
        const float lt = l + xor32(l, lane);
        const float inv = frcp(lt);
        bf16_t* op = AT + (size_t)(g0 + qrow) * 512 + hq * 64 + 4 * half;
#pragma unroll
        for (int i4 = 0; i4 < 4; ++i4) {
            f32x4 a, b;
#pragma unroll
            for (int q = 0; q < 4; ++q) { a[q] = O0[4 * i4 + q] * inv; b[q] = O1[4 * i4 + q] * inv; }
            st4bf(op + 8 * i4, a);
            st4bf(op + 32 + 8 * i4, b);
        }
    }
}

#define WAVE_LDS_FENCE() asm volatile("s_waitcnt lgkmcnt(0)" ::: "memory")
template <bool FINAL>
__device__ __forceinline__ void lru_unit(const P& p, char* shm, int blk, const int wv) {
    char* ws = p.ws;
    int c, nc; tile_seq(blk, c, nc);
    const int g0 = blk * 128;
    const int seq_lo = g0 - c * 128, seq_hi = seq_lo + nc * 128;
    const int tid = opaque_tid(wv), w = wv, lane = tid & 63, half = lane >> 5, tl = lane & 31;
    float* abuf = (float*)shm + w * (2 * 32 * 68);
    float* ubuf = abuf + 32 * 68;
    bf16_t* xt = (bf16_t*)abuf;
    float* ssq = (float*)(shm + 139264);
    const bf16_t* XR = (const bf16_t*)(ws + OFF_XR);
    const bf16_t* GR = (const bf16_t*)(ws + OFF_GR);
    const bf16_t* LW = (const bf16_t*)(ws + OFF_LW);
    const float* LS = (const float*)(ws + OFF_LS);
    float* AGG = (float*)(ws + OFF_AGG);
    bf16_t* HF = (bf16_t*)(ws + OFF_HF);
    bf16_t* MRG = (bf16_t*)(ws + OFF_MRG);
    const int chn = w * 64 + lane;
    __syncthreads();
    if (FINAL) {
        if (tid < 32) ssq[tid] = 0.f;
        __syncthreads();
    }
    for (int dir = 0; dir < 2; ++dir) {
        float h = 0.f, Ap = 1.f;
        if (FINAL) {
            if (dir == 0) {
#pragma unroll 8
                for (int cc = 0; cc < c; ++cc) {
                    const int tile = blk - c + cc;
                    const float A_ = AGG[(size_t)(tile * 2 + 0) * 1024 + chn], H_ = AGG[(size_t)(tile * 2 + 0) * 1024 + 512 + chn];
                    h = A_ * h + H_;
                }
            } else {
#pragma unroll 8
                for (int cc = nc - 1; cc > c; --cc) {
                    const int tile = blk - c + cc;
                    const float A_ = AGG[(size_t)(tile * 2 + 1) * 1024 + chn], H_ = AGG[(size_t)(tile * 2 + 1) * 1024 + 512 + chn];
                    h = A_ * h + H_;
                }
            }
        }
        uint4 xpre[5];
#define LRU_LOAD_X(tbase) do { _Pragma("unroll") for (int i = 0; i < 5; ++i) { \
                const int tt_ = (tbase) - 2 + (lane >> 3) + 8 * i; \
                xpre[i] = make_uint4(0u, 0u, 0u, 0u); \
                if (tt_ >= seq_lo && tt_ < seq_hi) xpre[i] = *(const uint4*)(XR + (size_t)tt_ * 512 + w * 64 + (lane & 7) * 8); } } while (0)
        if (!FINAL) LRU_LOAD_X(g0 + (dir ? 3 : 0) * 32);
        for (int ibi = 0; ibi < 4; ++ibi) {
            const int ib = dir ? 3 - ibi : ibi;
            const int t0 = g0 + ib * 32;
            if (FINAL) LRU_LOAD_X(t0);
            WAVE_LDS_FENCE();
#pragma unroll
            for (int i = 0; i < 5; ++i) {
                const int rowi = (lane >> 3) + 8 * i;
                uint2* d = (uint2*)(xt + rowi * 68 + (lane & 7) * 8);
                d[0] = make_uint2(xpre[i].x, xpre[i].y); d[1] = make_uint2(xpre[i].z, xpre[i].w);
            }
            if (!FINAL && ibi < 3) LRU_LOAD_X(g0 + (dir ? 2 - ibi : ibi + 1) * 32);
            WAVE_LDS_FENCE();
            float xcv[4][8];
#pragma unroll
            for (int ks = 0; ks < 4; ++ks)
#pragma unroll
                for (int grp = 0; grp < 2; ++grp) {
                    const int cl = 16 * ks + 8 * grp + 4 * half;
                    const int cb4 = w * 64 + cl;
                    f32x4 a = *(const f32x4*)(p.conv_b + cb4);
#pragma unroll
                    for (int j = 0; j < 4; ++j) {
                        const f32x4 xv = ld4bf(xt + (tl + j) * 68 + cl);
                        const f32x4 wv4 = *(const f32x4*)(p.conv_w + j * 512 + cb4);
                        a += wv4 * xv;
                    }
#pragma unroll
                    for (int q = 0; q < 4; ++q) xcv[ks][grp * 4 + q] = a[q];
                }
            bf16x8 xb[4];
#pragma unroll
            for (int ks = 0; ks < 4; ++ks) {
                uint4 pw;
                pw.x = pk2(xcv[ks][0], xcv[ks][1]); pw.y = pk2(xcv[ks][2], xcv[ks][3]);
                pw.z = pk2(xcv[ks][4], xcv[ks][5]); pw.w = pk2(xcv[ks][6], xcv[ks][7]);
                xb[ks] = __builtin_bit_cast(bf16x8, pw);
            }
            WAVE_LDS_FENCE();
#pragma unroll
            for (int cb = 0; cb < 2; ++cb) {
                f32x16 aa, ax;
#pragma unroll
                for (int i = 0; i < 16; ++i) { aa[i] = 0.f; ax[i] = 0.f; }
#pragma unroll
                for (int ks = 0; ks < 4; ++ks) {
                    const bf16x8 wa = *(const bf16x8*)(LW + ((size_t)((((dir * 2 + 0) * 8 + w) * 2 + cb) * 4 + ks) * 64 + lane) * 8);
                    const bf16x8 wx = *(const bf16x8*)(LW + ((size_t)((((dir * 2 + 1) * 8 + w) * 2 + cb) * 4 + ks) * 64 + lane) * 8);
                    aa = __builtin_amdgcn_mfma_f32_32x32x16_bf16(wa, xb[ks], aa, 0, 0, 0);
                    ax = __builtin_amdgcn_mfma_f32_32x32x16_bf16(wx, xb[ks], ax, 0, 0, 0);
                }
#pragma unroll
                for (int r4 = 0; r4 < 4; ++r4) {
                    const int j0 = cb * 32 + 8 * r4 + 4 * half;
                    const int ch4 = w * 64 + j0;
                    const f32x4 ba4 = *(const f32x4*)(p.lru_ba + dir * 512 + ch4);
                    const f32x4 bx4 = *(const f32x4*)(p.lru_bx + dir * 512 + ch4);
                    const f32x4 ls4 = *(const f32x4*)(LS + dir * 512 + ch4);
                    f32x4 av, uv;
#pragma unroll
                    for (int q = 0; q < 4; ++q) {
                        const int r = 4 * r4 + q;
                        const float xcval = xcv[2 * cb + (r4 >> 1)][4 * (r4 & 1) + q];
                        const float rgate = sigmoidf_(aa[r] + ba4[q]);
                        const float igate = sigmoidf_(ax[r] + bx4[q]);
                        const float la = 8.f * rgate * ls4[q];
                        av[q] = fexp(la);
                        uv[q] = fsqrt(fmaxf(0.f, 1.f - av[q] * av[q])) * igate * xcval;
                    }
                    *(f32x4*)(abuf + tl * 68 + j0) = av;
                    *(f32x4*)(ubuf + tl * 68 + j0) = uv;
                }
            }
            WAVE_LDS_FENCE();
            float val[32];
#pragma unroll
            for (int tt = 0; tt < 32; ++tt) {
                const int tloc = dir ? 31 - tt : tt;
                const float a = abuf[tloc * 68 + lane], u = ubuf[tloc * 68 + lane];
                h = a * h + u;
                Ap *= a;
                if (FINAL) {
                    const size_t off = (size_t)(t0 + tloc) * 512 + chn;
                    if (dir == 0) {
                        HF[off] = (bf16_t)(pk2(h, 0.f) & 0xffff);
                    } else {
                        const float hf = bf1(HF[off]);
                        const float gg = bf1(GR[off]);
                        const float v = gg * (hf + h);
                        val[tt] = v;
                        abuf[tloc * 68 + lane] = v;
                    }
                }
            }
            if (FINAL && dir == 1) {
                WAVE_LDS_FENCE();
                {
                    float s = 0.f;
#pragma unroll
                    for (int q = 0; q < 8; ++q) {
                        const f32x4 v4 = *(const f32x4*)(abuf + tl * 68 + half * 32 + q * 4);
                        s += v4[0] * v4[0] + v4[1] * v4[1] + v4[2] * v4[2] + v4[3] * v4[3];
                    }
                    atomicAdd(&ssq[tl], s);
                }
                __syncthreads();
#pragma unroll
                for (int tt = 0; tt < 32; ++tt) {
                    const int tloc = 31 - tt;
                    const float rs = frsq(ssq[tloc] * (1.f / 512.f) + EPS);
                    MRG[(size_t)(t0 + tloc) * 1024 + 512 + chn] = (bf16_t)(pk2(val[tt] * rs, 0.f) & 0xffff);
                }
                __syncthreads();
                if (tid < 32) ssq[tid] = 0.f;
                __syncthreads();
            }
        }
        if (!FINAL) {
            AGG[(size_t)(blk * 2 + dir) * 1024 + chn] = Ap;
            AGG[(size_t)(blk * 2 + dir) * 1024 + 512 + chn] = h;
        }
    }
}

__device__ __forceinline__ void score_unit(const P& p, char* shm, int unit, const int wv) {
    char* ws = p.ws;
    const int sp = unit & 15, tg = unit >> 4;
    const int tid = opaque_tid(wv), w = tid >> 6, lane = tid & 63, fr = lane & 15, fq = lane >> 4;
    bf16_t* KL = (bf16_t*)shm;
    const bf16_t* KEYS = (const bf16_t*)(ws + OFF_KEYS) + (size_t)sp * 16384;
    const bf16_t* QP = (const bf16_t*)(ws + OFF_QP);
    float* SUBS = (float*)(ws + OFF_SUBS);
    __syncthreads();
    for (int i = tid; i < 2048; i += NTHREADS) {
        const int r = i >> 4, cpart = i & 15;
        *(uint4*)(KL + r * 136 + cpart * 8) = *(const uint4*)(KEYS + r * 128 + cpart * 8);
    }
    __syncthreads();
    for (int tt = 0; tt < 8; ++tt) {
        const int gb = (tg * 8 + tt) * 128 + w * 16;
        bf16x8 af[4];
#pragma unroll
        for (int ks = 0; ks < 4; ++ks) af[ks] = *(const bf16x8*)(QP + (size_t)(gb + fr) * 2048 + sp * 128 + ks * 32 + fq * 8);
        float v[4][8];
#pragma unroll
        for (int nb = 0; nb < 8; ++nb) {
            f32x4 acc = {0.f, 0.f, 0.f, 0.f};
#pragma unroll
            for (int ks = 0; ks < 4; ++ks) {
                const bf16x8 bf = *(const bf16x8*)(KL + (nb * 16 + fr) * 136 + ks * 32 + fq * 8);
                acc = __builtin_amdgcn_mfma_f32_16x16x32_bf16(af[ks], bf, acc, 0, 0, 0);
            }
#pragma unroll
            for (int i = 0; i < 4; ++i) v[i][nb] = __uint_as_float((__float_as_uint(acc[i]) & ~127u) | (unsigned)(nb * 16 + fr));
        }
#define CE_(a, b) do { const float hi_ = fmaxf(v[i][a], v[i][b]); const float lo_ = fminf(v[i][a], v[i][b]); v[i][a] = hi_; v[i][b] = lo_; } while (0)
#pragma unroll
        for (int i = 0; i < 4; ++i) {
            CE_(0, 1); CE_(2, 3); CE_(4, 5); CE_(6, 7);
            CE_(0, 2); CE_(1, 3); CE_(4, 6); CE_(5, 7);
            CE_(1, 2); CE_(5, 6);
            CE_(0, 4); CE_(1, 5); CE_(2, 6); CE_(3, 7);
            CE_(2, 4); CE_(3, 5);
            CE_(1, 2); CE_(3, 4); CE_(5, 6);
        }
#undef CE_
        float keep[4] = {0.f, 0.f, 0.f, 0.f};
        for (int r = 0; r < 16; ++r) {
#pragma unroll
            for (int i = 0; i < 4; ++i) {
                const float rm = row_max16(v[i][0]);
                keep[i] = (fr == r) ? rm : keep[i];
                const bool win = v[i][0] == rm;
#pragma unroll
                for (int nb = 0; nb < 7; ++nb) v[i][nb] = win ? v[i][nb + 1] : v[i][nb];
                v[i][7] = win ? -INFINITY : v[i][7];
            }
        }
#pragma unroll
        for (int i = 0; i < 4; ++i) SUBS[(size_t)(gb + 4 * fq + i) * 256 + sp * 16 + fr] = keep[i];
    }
}

__device__ __forceinline__ void phase_stage2(const P& p, const int wv) {
    char* ws = p.ws;
    const float* SUBS = (const float*)(ws + OFF_SUBS);
    int* PIDX = (int*)(ws + OFF_PIDX);
    float* PS = (float*)(ws + OFF_PS);
    const int gtid = blockIdx.x * NTHREADS + opaque_tid(wv), gstride = gridDim.x * NTHREADS;
    for (int idx = gtid; idx < NT * 8; idx += gstride) {
        const int tok = idx >> 3, hh = idx & 7;
        const float* s0p = SUBS + (size_t)tok * 256 + hh * 32;
        const float* s1p = s0p + 16;
        float s0[16], s1[16];
#pragma unroll
        for (int i = 0; i < 4; ++i) {
            const f32x4 a = *(const f32x4*)(s0p + 4 * i), b = *(const f32x4*)(s1p + 4 * i);
#pragma unroll
            for (int q = 0; q < 4; ++q) { s0[4 * i + q] = a[q]; s1[4 * i + q] = b[q]; }
        }
        float L[16];
#pragma unroll
        for (int i = 0; i < 16; ++i) L[i] = -INFINITY;
#pragma unroll
        for (int a = 0; a < 16; ++a)
#pragma unroll
            for (int b = 0; b < 16; ++b) {
                if ((a + 1) * (b + 1) <= 16) {
                    float nv = __uint_as_float((__float_as_uint(s0[a] + s1[b]) & ~255u) | (unsigned)(a * 16 + b));
#pragma unroll
                    for (int i = 0; i < 16; ++i) {
                        const float hi = fmaxf(L[i], nv);
                        nv = fminf(L[i], nv);
                        L[i] = hi;
                    }
                }
            }
        int ids[16];
#pragma unroll
        for (int k = 0; k < 16; ++k) {
            const unsigned code = __float_as_uint(L[k]) & 255u;
            const unsigned i0 = __float_as_uint(s0p[code >> 4]) & 127u;
            const unsigned i1 = __float_as_uint(s1p[code & 15]) & 127u;
            ids[k] = (int)(i0 * 128 + i1);
        }
        int* pi = PIDX + (size_t)tok * 128;
        f32x4* pf = (f32x4*)(PS + (size_t)tok * 128 + hh * 16);
#pragma unroll
        for (int k = 0; k < 16; ++k) pi[k * 8 + hh] = ids[k];
#pragma unroll
        for (int i = 0; i < 4; ++i) pf[i] = f32x4{L[4 * i], L[4 * i + 1], L[4 * i + 2], L[4 * i + 3]};
    }
}

__device__ __forceinline__ void unpack8(const uint4 w, float* f) {
    f[0] = bflo(w.x); f[1] = bfhi(w.x); f[2] = bflo(w.y); f[3] = bfhi(w.y);
    f[4] = bflo(w.z); f[5] = bfhi(w.z); f[6] = bflo(w.w); f[7] = bfhi(w.w);
}
__device__ __forceinline__ unsigned xcc_id() { return (unsigned)__builtin_amdgcn_s_getreg((3 << 11) | 20) & 0xFu; }
__device__ __forceinline__ float dpp_ror8(float v) {
    return __int_as_float(__builtin_amdgcn_update_dpp(0, __float_as_int(v), 0x128, 0xf, 0xf, true));
}
__device__ __forceinline__ float swz_x4(float v) { return __int_as_float(__builtin_amdgcn_ds_swizzle(__float_as_int(v), 0x101F)); }
__device__ __forceinline__ float swz_x16(float v) { return __int_as_float(__builtin_amdgcn_ds_swizzle(__float_as_int(v), 0x401F)); }

__device__ __forceinline__ void gather_item_a(const P& p, const int s, const int chunk, const int w, const int lane) {
    char* ws = p.ws;
    const bf16_t* H1B = (const bf16_t*)(ws + OFF_H1B);
    const int* PIDX = (const int*)(ws + OFF_PIDX);
    bf16_t* PART = (bf16_t*)(ws + OFF_PART);
    const int i8 = lane & 7, gq = lane >> 3;
    const unsigned char* UT = (const unsigned char*)(ws + OFF_UT) + (size_t)s * (16384 * 128) + i8 * 16;
    const bool b0 = (lane & 1) != 0, b1 = (lane & 2) != 0, b2 = (lane & 4) != 0;
    const int tok0 = chunk * 64 + w * 8;
    int4 idA[4], idB[4];
    uint4 UU[2][8], XQ[2][2];
#define LD_IDS(di, tk) do { const int4* ip_ = (const int4*)(PIDX + (size_t)(tk) * 128 + gq * 16); \
        _Pragma("unroll") for (int q_ = 0; q_ < 4; ++q_) di[q_] = ip_[q_]; } while (0)
#define LD_X(buf, tk) do { const uint4* hp_ = (const uint4*)(H1B + (size_t)(tk) * 1024 + s * 128 + i8 * 16); XQ[buf][0] = hp_[0]; XQ[buf][1] = hp_[1]; } while (0)
#define LD_U(buf, ia, ib) do { const int e_[8] = {ia.x, ia.y, ia.z, ia.w, ib.x, ib.y, ib.z, ib.w}; \
        _Pragma("unroll") for (int g_ = 0; g_ < 8; ++g_) UU[buf][g_] = *(const uint4*)(UT + ((size_t)e_[g_] << 7)); } while (0)
    LD_IDS(idA, tok0);
    LD_X(0, tok0);
    LD_U(0, idA[0], idA[1]);
    LD_IDS(idB, tok0 + 1);
#pragma unroll
    for (int j = 0; j < 8; ++j) {
        const int tok = tok0 + j;
        LD_U(1, idA[2], idA[3]);
        if (j < 7) LD_X((j + 1) & 1, tok + 1);
        __builtin_amdgcn_sched_barrier(0);
        float xs[16];
        unpack8(XQ[j & 1][0], xs); unpack8(XQ[j & 1][1], xs + 8);
        float d[16];
#pragma unroll
        for (int hf = 0; hf < 2; ++hf) {
            if (hf == 1) {
                if (j < 7) LD_U(0, idB[0], idB[1]);
                __builtin_amdgcn_sched_barrier(0);
            }
#pragma unroll
            for (int g = 0; g < 8; ++g) {
                const uint4 u4 = UU[hf][g];
                const unsigned wd[4] = {u4.x, u4.y, u4.z, u4.w};
                f32x2 d2 = {0.f, 0.f}, d3 = {0.f, 0.f};
#pragma unroll
                for (int q = 0; q < 4; ++q) {
                    const f32x2 lo = __builtin_amdgcn_cvt_pk_f32_fp8((int)wd[q], false);
                    const f32x2 hi = __builtin_amdgcn_cvt_pk_f32_fp8((int)wd[q], true);
                    const f32x2 xlo = {xs[q * 4 + 0], xs[q * 4 + 1]};
                    const f32x2 xhi = {xs[q * 4 + 2], xs[q * 4 + 3]};
                    d2 = lo * xlo + d2;
                    d3 = hi * xhi + d3;
                }
                d[hf * 8 + g] = (d2.x + d2.y) + (d3.x + d3.y);
            }
        }
        float t8[8], t4[4], t2[2];
#pragma unroll
        for (int q = 0; q < 8; ++q) {
            const float keep = b0 ? d[8 + q] : d[q], send = b0 ? d[q] : d[8 + q];
            t8[q] = keep + dppf(send, 0);
        }
#pragma unroll
        for (int q = 0; q < 4; ++q) {
            const float keep = b1 ? t8[4 + q] : t8[q], send = b1 ? t8[q] : t8[4 + q];
            t4[q] = keep + dppf(send, 1);
        }
#pragma unroll
        for (int q = 0; q < 2; ++q) {
            const float keep = b2 ? t4[2 + q] : t4[q], send = b2 ? t4[q] : t4[2 + q];
            t2[q] = keep + swz_x4(send);
        }
        const int itb = (b0 ? 8 : 0) + (b1 ? 4 : 0) + (b2 ? 2 : 0);
        *(unsigned*)(PART + ((size_t)tok * 8 + s) * 128 + gq * 16 + itb) = pk2(t2[0], t2[1]);
        if (j < 7) {
#pragma unroll
            for (int q = 0; q < 4; ++q) idA[q] = idB[q];
        }
        if (j < 6) LD_IDS(idB, tok + 2);
    }
#undef LD_IDS
#undef LD_X
#undef LD_U
}

__device__ __forceinline__ void gather_item_b(const P& p, const int s, const int chunk, const int w, const int lane) {
    char* ws = p.ws;
    const bf16_t* H1B = (const bf16_t*)(ws + OFF_H1B);
    const int* PIDX = (const int*)(ws + OFF_PIDX);
    const float* WGT = (const float*)(ws + OFF_WGT);
    bf16_t* H2B = (bf16_t*)(ws + OFF_H2B);
    float* SSQ3 = (float*)(ws + OFF_SSQ3);
    const int i8 = lane & 7, gq = lane >> 3;
    const unsigned char* VT = (const unsigned char*)(ws + OFF_VT) + (size_t)s * (16384 * 128) + i8 * 16;
    const bool b5 = (lane & 32) != 0, b4 = (lane & 16) != 0, b3 = (lane & 8) != 0;
    const int dloc = s * 128 + i8 * 16 + (b5 ? 8 : 0) + (b4 ? 4 : 0) + (b3 ? 2 : 0);
    const int tok0 = chunk * 64 + w * 8;
    int4 idA[4], idB[4];
    f32x4 wgA[4], wgB[4];
    uint4 VV[2][8];
#define LD_IW(di, dw, tk) do { const int4* ip_ = (const int4*)(PIDX + (size_t)(tk) * 128 + gq * 16); const f32x4* wp_ = (const f32x4*)(WGT + (size_t)(tk) * 128 + gq * 16); \
        _Pragma("unroll") for (int q_ = 0; q_ < 4; ++q_) { di[q_] = ip_[q_]; dw[q_] = wp_[q_]; } } while (0)
#define LD_V(buf, ia, ib) do { const int e_[8] = {ia.x, ia.y, ia.z, ia.w, ib.x, ib.y, ib.z, ib.w}; \
        _Pragma("unroll") for (int g_ = 0; g_ < 8; ++g_) VV[buf][g_] = *(const uint4*)(VT + ((size_t)e_[g_] << 7)); } while (0)
    LD_IW(idA, wgA, tok0);
    LD_V(0, idA[0], idA[1]);
    LD_IW(idB, wgB, tok0 + 1);
#pragma unroll
    for (int j = 0; j < 8; ++j) {
        const int tok = tok0 + j;
        LD_V(1, idA[2], idA[3]);
        const unsigned hw = *(const unsigned*)(H1B + (size_t)tok * 1024 + dloc);
        __builtin_amdgcn_sched_barrier(0);
        f32x2 acc[8];
#pragma unroll
        for (int q = 0; q < 8; ++q) acc[q] = f32x2{0.f, 0.f};
#pragma unroll
        for (int hf = 0; hf < 2; ++hf) {
            if (hf == 1) {
                if (j < 7) LD_V(0, idB[0], idB[1]);
                __builtin_amdgcn_sched_barrier(0);
            }
#pragma unroll
            for (int g = 0; g < 8; ++g) {
                const uint4 v4 = VV[hf][g];
                const unsigned wd[4] = {v4.x, v4.y, v4.z, v4.w};
                const float wsc = wgA[hf * 2 + (g >> 2)][g & 3];
                const f32x2 w2 = {wsc, wsc};
#pragma unroll
                for (int q = 0; q < 4; ++q) {
                    const f32x2 lo = __builtin_amdgcn_cvt_pk_f32_fp8((int)wd[q], false);
                    const f32x2 hi = __builtin_amdgcn_cvt_pk_f32_fp8((int)wd[q], true);
                    acc[2 * q] = lo * w2 + acc[2 * q];
                    acc[2 * q + 1] = hi * w2 + acc[2 * q + 1];
                }
            }
        }
        float a16[16];
#pragma unroll
        for (int q = 0; q < 8; ++q) { a16[2 * q] = acc[q].x; a16[2 * q + 1] = acc[q].y; }
        float t8[8], t4[4], t2[2];
#pragma unroll
        for (int q = 0; q < 8; ++q) {
            const float keep = b5 ? a16[8 + q] : a16[q], send = b5 ? a16[q] : a16[8 + q];
            t8[q] = keep + xor32(send, lane);
        }
#pragma unroll
        for (int q = 0; q < 4; ++q) {
            const float keep = b4 ? t8[4 + q] : t8[q], send = b4 ? t8[q] : t8[4 + q];
            t4[q] = keep + swz_x16(send);
        }
#pragma unroll
        for (int q = 0; q < 2; ++q) {
            const float keep = b3 ? t4[2 + q] : t4[q], send = b3 ? t4[q] : t4[2 + q];
            t2[q] = keep + dpp_ror8(send);
        }
        const float o0 = bflo(hw) + t2[0], o1 = bfhi(hw) + t2[1];
        *(unsigned*)(H2B + (size_t)tok * 1024 + dloc) = pk2(o0, o1);
        const float sq = wave_sum(o0 * o0 + o1 * o1);
        if (lane == 0) atomicAdd(SSQ3 + tok, sq);
        if (j < 7) {
#pragma unroll
            for (int q = 0; q < 4; ++q) { idA[q] = idB[q]; wgA[q] = wgB[q]; }
        }
        if (j < 6) LD_IW(idB, wgB, tok + 2);
    }
#undef LD_IW
#undef LD_V
}

template <int PASS>
__device__ __forceinline__ void phase_gather_sliced(const P& p, char* shm, const int wv) {
    const int tid = opaque_tid(wv), w = wv, lane = tid & 63;
    unsigned* q = (unsigned*)(p.ws + OFF_CTL) + 16 + PASS * 8;
    volatile int* sh = (volatile int*)(shm + 139392);
    const int home = (int)(xcc_id() & 7u);
    constexpr int NCH = NT / 64;
    for (int k = 0; k < 8; ++k) {
        const int s = (home + k) & 7;
        __syncthreads();
        if (tid == 0) sh[0] = (int)__hip_atomic_fetch_add(q + s, 1u, __ATOMIC_RELAXED, __HIP_MEMORY_SCOPE_AGENT);
        __syncthreads();
        int cur = sh[0];
        while (cur < NCH) {
            __syncthreads();
            if (tid == 0) sh[0] = (int)__hip_atomic_fetch_add(q + s, 1u, __ATOMIC_RELAXED, __HIP_MEMORY_SCOPE_AGENT);
            if (PASS == 0) gather_item_a(p, s, cur, w, lane); else gather_item_b(p, s, cur, w, lane);
            __syncthreads();
            cur = sh[0];
        }
    }
}

__device__ __forceinline__ void phase_gather_mid(const P& p, const int wv) {
    char* ws = p.ws;
    const int tid = opaque_tid(wv), w = wv, lane = tid & 63;
    const int gw = blockIdx.x * 8 + w, nw = gridDim.x * 8;
    const bf16_t* H1B = (const bf16_t*)(ws + OFF_H1B);
    const bf16_t* PART = (const bf16_t*)(ws + OFF_PART);
    const float* PS = (const float*)(ws + OFF_PS);
    float* WGT = (float*)(ws + OFF_WGT);
    for (int tok = gw; tok < NT; tok += nw) {
        const uint4* hp = (const uint4*)(H1B + (size_t)tok * 1024);
        float xf[16];
        unpack8(hp[lane], xf); unpack8(hp[64 + lane], xf + 8);
        float s = 0.f;
#pragma unroll
        for (int i = 0; i < 16; ++i) s += xf[i] * xf[i];
        s = wave_sum(s);
        const float rs2 = frsq(s * (1.f / 1024.f) + EPS);
        float wout[2];
        int pos[2];
#pragma unroll
        for (int hsel = 0; hsel < 2; ++hsel) {
            const int e = lane + 64 * hsel;
            const int ppos = (e & 15) * 8 + (e >> 4);
            float d = 0.f;
#pragma unroll
            for (int sl = 0; sl < 8; ++sl) d += bf1(PART[((size_t)tok * 8 + sl) * 128 + ppos]);
            const float sc = PS[(size_t)tok * 128 + e] * rs2;
            const float m = row_max16(sc);
            const float pe = fexp(sc - m);
            const float g = pe * frcp(row_sum16(pe));
            wout[hsel] = g * gelu_tanh(d * rs2 * (1.f / 64.f)) * 0.125f;
            pos[hsel] = ppos;
        }
        WGT[(size_t)tok * 128 + pos[0]] = wout[0];
        WGT[(size_t)tok * 128 + pos[1]] = wout[1];
    }
}

__global__ void __launch_bounds__(NTHREADS, 2) mega(P p) {
    extern __shared__ __attribute__((aligned(1024))) char shm[];
    cg::grid_group grid = cg::this_grid();
    char* ws = p.ws;
    const int wv = __builtin_amdgcn_readfirstlane((int)(threadIdx.x >> 6));
    const int w = wv;
    const int gw = blockIdx.x * 8 + w, nw = gridDim.x * 8;
    unsigned* bar_cnt = (unsigned*)(ws + OFF_CTL);

    phase_prep(p, wv);
    grid.sync();
    for (int rp = 0; rp < REP_GEMM; ++rp) phase_inproj(p, shm, wv);
    grid_bar(bar_cnt, (unsigned)(1 * gridDim.x), wv);
    for (int rp = 0; rp < REP_MIX; ++rp)
    for (int u = blockIdx.x; u < 1536 + 768; u += gridDim.x) {
        if (u < 1536) attn_unit(p, shm, u, wv); else lru_unit<false>(p, shm, u - 1536, wv);
    }
    grid_bar(bar_cnt, (unsigned)(2 * gridDim.x), wv);
    for (int rp = 0; rp < REP_MIX; ++rp)
    for (int u = blockIdx.x; u < 768; u += gridDim.x) lru_unit<true>(p, shm, u, wv);
    {
        const bf16_t* AT = (const bf16_t*)(ws + OFF_AT);
        bf16_t* MRG = (bf16_t*)(ws + OFF_MRG);
        const int lane = opaque_tid(wv) & 63;
        for (int tok = gw; tok < NT; tok += nw) {
            const uint4 a = ((const uint4*)(AT + (size_t)tok * 512))[lane];
            float f[8];
            unpack8(a, f);
            float s = 0.f;
#pragma unroll
            for (int i = 0; i < 8; ++i) s += f[i] * f[i];
            s = wave_sum(s);
            const float rs = frsq(s * (1.f / 512.f) + EPS);
            uint4 o;
            o.x = pk2(f[0] * rs, f[1] * rs); o.y = pk2(f[2] * rs, f[3] * rs); o.z = pk2(f[4] * rs, f[5] * rs); o.w = pk2(f[6] * rs, f[7] * rs);
            ((uint4*)(MRG + (size_t)tok * 1024))[lane] = o;
        }
    }
    grid_bar(bar_cnt, (unsigned)(3 * gridDim.x), wv);
    {
        const bf16_t* MRG = (const bf16_t*)(ws + OFF_MRG);
        const bf16_t* W = (const bf16_t*)(ws + OFF_WOUT);
        bf16_t* H1B = (bf16_t*)(ws + OFF_H1B);
        const float *xp = p.x_p, *xs = p.x_s;
        auto epi = [=](int row, int col, f32x4 v0, f32x4 v1) {
            const float* xr = (row < NTP ? xp + (size_t)row * 1024 : xs + (size_t)(row - NTP) * 1024) + col;
            const f32x4 x0 = *(const f32x4*)xr, x1 = *(const f32x4*)(xr + 16);
            bf16_t* dst = H1B + (size_t)row * 1024 + col;
            st4bf(dst, v0 + x0); st4bf(dst + 16, v1 + x1);
        };
        int pm, pn;
        for (int rp = 0; rp < REP_GEMM; ++rp)
        for (int i = 0; gemm_next(i, 4, 384 * 4, pm, pn); ++i) gemm_tile(MRG, W, 1024, pm * 256, pn * 256, shm, wv, epi);
    }
    grid_bar(bar_cnt, (unsigned)(4 * gridDim.x), wv);
    {
        const bf16_t* H1B = (const bf16_t*)(ws + OFF_H1B);
        const bf16_t* W = (const bf16_t*)(ws + OFF_WQ);
        bf16_t* QP = (bf16_t*)(ws + OFF_QP);
        auto epi = [=](int row, int col, f32x4 v0, f32x4 v1) {
            bf16_t* dst = QP + (size_t)row * 2048 + col;
            st4bf(dst, v0); st4bf(dst + 16, v1);
        };
        int pm, pn;
        for (int rp = 0; rp < REP_GEMM; ++rp)
        for (int i = 0; gemm_next(i, 8, 384 * 8, pm, pn); ++i) gemm_tile(H1B, W, 1024, pm * 256, pn * 256, shm, wv, epi);
    }
    grid_bar(bar_cnt, (unsigned)(5 * gridDim.x), wv);
    for (int rp = 0; rp < REP_PEER; ++rp)
    for (int u = blockIdx.x; u < 1536; u += gridDim.x) score_unit(p, shm, u, wv);
    grid_bar(bar_cnt, (unsigned)(6 * gridDim.x), wv);
    phase_stage2(p, wv);
    grid_bar(bar_cnt, (unsigned)(7 * gridDim.x), wv);
    phase_gather_sliced<0>(p, shm, wv);
    grid_bar(bar_cnt, (unsigned)(8 * gridDim.x), wv);
    phase_gather_mid(p, wv);
    grid_bar(bar_cnt, (unsigned)(9 * gridDim.x), wv);
    phase_gather_sliced<1>(p, shm, wv);
    grid_bar(bar_cnt, (unsigned)(10 * gridDim.x), wv);
    {
        const bf16_t* H2B = (const bf16_t*)(ws + OFF_H2B);
        const bf16_t* WG = (const bf16_t*)(ws + OFF_WG);
        const bf16_t* PB = (const bf16_t*)(ws + OFF_PB);
        const bf16_t* WP = (const bf16_t*)(ws + OFF_WP);
        const float* SSQ3 = (const float*)(ws + OFF_SSQ3);
        bf16_t* G = (bf16_t*)(ws + OFF_G);
        bf16_t* H3 = (bf16_t*)(ws + OFF_H3);
        auto epi_g = [=](int row, int col, f32x4 v0, f32x4 v1) {
            const float rs = frsq(SSQ3[row] * (1.f / 1024.f) + EPS);
            f32x4 a, b;
#pragma unroll
            for (int j = 0; j < 4; ++j) { a[j] = sigmoidf_(v0[j] * rs); b[j] = sigmoidf_(v1[j] * rs); }
            bf16_t* dst = G + (size_t)row * 1024 + col;
            st4bf(dst, a); st4bf(dst + 16, b);
        };
        auto epi_p = [=](int row, int col, f32x4 v0, f32x4 v1) {
            const size_t off = (size_t)row * 1024 + col;
            const f32x4 g0 = ld4bf(G + off), g1 = ld4bf(G + off + 16);
            const f32x4 h0 = ld4bf(H2B + off), h1 = ld4bf(H2B + off + 16);
            st4bf(H3 + off, h0 + g0 * v0); st4bf(H3 + off + 16, h1 + g1 * v1);
        };
        int pm, pn;
        for (int rp = 0; rp < REP_GEMM; ++rp)
        for (int i = 0; gemm_next(i, 4, 384 * 4, pm, pn); ++i) gemm_tile(H2B, WG, 1024, pm * 256, pn * 256, shm, wv, epi_g);
        for (int rp = 0; rp < REP_GEMM; ++rp)
        for (int i = 0; gemm_next(i, 4, 384 * 4, pm, pn); ++i) gemm_tile(PB, WP, 256, pm * 256, pn * 256, shm, wv, epi_p);
    }
    grid_bar(bar_cnt, (unsigned)(11 * gridDim.x), wv);
    {
        const bf16_t* H3 = (const bf16_t*)(ws + OFF_H3);
        const int lane = opaque_tid(wv) & 63;
        for (int tok = gw; tok < NT; tok += nw) {
            const uint2* hp = (const uint2*)(H3 + (size_t)tok * 1024);
            float f[16];
            float s = 0.f;
#pragma unroll
            for (int j = 0; j < 4; ++j) {
                const uint2 a = hp[lane + 64 * j];
                f[4 * j] = bflo(a.x); f[4 * j + 1] = bfhi(a.x); f[4 * j + 2] = bflo(a.y); f[4 * j + 3] = bfhi(a.y);
            }
#pragma unroll
            for (int i = 0; i < 16; ++i) s += f[i] * f[i];
            s = wave_sum(s);
            const float rs = frsq(s * (1.f / 1024.f) + EPS);
            float4* op = (float4*)(p.out + (size_t)tok * 1024);
#pragma unroll
            for (int j = 0; j < 4; ++j) {
                const float4 g = ((const float4*)p.fin_g)[lane + 64 * j];
                float4 o;
                o.x = f[4 * j] * rs * g.x; o.y = f[4 * j + 1] * rs * g.y; o.z = f[4 * j + 2] * rs * g.z; o.w = f[4 * j + 3] * rs * g.w;
                op[lane + 64 * j] = o;
            }
        }
    }
}

extern "C" void kernel_launch(void* const* d_in, const int* in_sizes, int n_in, void* d_out, int out_size, void* d_ws, size_t ws_size,
                              hipStream_t stream) {
    static int grid = 0;
    if (grid == 0) {
        if (n_in != 26 || ws_size < WS_END) {
            fprintf(stderr, "kernel_launch: unexpected n_in %d or ws_size %zu (< %zu)\n", n_in, ws_size, (size_t)WS_END);
            grid = -1;
            return;
        }
        int dev = 0, cus = 0, per_cu = 0;
        hipGetDevice(&dev);
        hipDeviceGetAttribute(&cus, hipDeviceAttributeMultiprocessorCount, dev);
        hipFuncSetAttribute((const void*)mega, hipFuncAttributeMaxDynamicSharedMemorySize, LDS_BYTES);
        hipOccupancyMaxActiveBlocksPerMultiprocessor(&per_cu, (const void*)mega, NTHREADS, LDS_BYTES);
        if (per_cu < 1) { fprintf(stderr, "kernel_launch: occupancy query says %d blocks/CU\n", per_cu); per_cu = 1; }
        grid = cus * 1;
        (void)hipGetLastError();
    }
    if (grid < 0) return;
    if (hipMemsetAsync((char*)d_ws + OFF_CTL, 0, 256, stream) != hipSuccess) fprintf(stderr, "kernel_launch: memset failed\n");
    P p{};
    const float** pp = (const float**)&p;
    for (int i = 0; i < 26; ++i) pp[i] = (const float*)d_in[i];
    p.out = (float*)d_out;
    p.ws = (char*)d_ws;
    void* args[] = {&p};
    hipError_t e = hipLaunchCooperativeKernel((const void*)mega, dim3(grid), dim3(NTHREADS), args, LDS_BYTES, stream);
    if (e != hipSuccess) fprintf(stderr, "cooperative launch failed: %s (grid %d)\n", hipGetErrorString(e), grid);
}
```

```cpp
#include <hip/hip_runtime.h>
#include <hip/hip_cooperative_groups.h>
#include <cstdio>
#include <cstdint>
namespace cg = cooperative_groups;

typedef unsigned short bf16_t;
typedef __bf16 bf16x8 __attribute__((ext_vector_type(8)));
typedef __bf16 bf16x2v __attribute__((ext_vector_type(2)));
typedef float f32x4 __attribute__((ext_vector_type(4)));
typedef float f32x16 __attribute__((ext_vector_type(16)));
typedef float f32x2 __attribute__((ext_vector_type(2)));

constexpr int NT = 98304;
constexpr int NTP = 65536;
constexpr float EPS = 1e-6f;
constexpr int LDS_BYTES = 147456;
constexpr int NTHREADS = 512;
#define REP_GEMM 1
#define REP_MIX 1
#define REP_PEER 1

constexpr size_t MiB = 1ull << 20;
constexpr size_t OFF_R0 = 0;
constexpr size_t OFF_R1 = 192 * MiB;
constexpr size_t OFF_R2 = 576 * MiB;
constexpr size_t OFF_R3 = 768 * MiB;
constexpr size_t OFF_WIN = OFF_R3;
constexpr size_t OFF_WOUT = OFF_WIN + 1792ull * 1024 * 2;
constexpr size_t OFF_WQ = OFF_WOUT + 1024ull * 1024 * 2;
constexpr size_t OFF_WG = OFF_WQ + 2048ull * 1024 * 2;
constexpr size_t OFF_WP = OFF_WG + 1024ull * 1024 * 2;
constexpr size_t OFF_KEYS = OFF_WP + 1024ull * 256 * 2;
constexpr size_t OFF_UT = OFF_KEYS + 16ull * 128 * 128 * 2;
constexpr size_t OFF_VT = OFF_UT + 16384ull * 1024 * 2;
constexpr size_t OFF_LW = OFF_VT + 16384ull * 1024 * 2;
constexpr size_t OFF_LS = OFF_LW + 2ull * 2 * 8 * 64 * 64 * 2;
constexpr size_t OFF_PB = OFF_LS + 4096;
constexpr size_t OFF_RS1 = OFF_PB + (size_t)NT * 256 * 2;
constexpr size_t OFF_RS3 = OFF_RS1 + (size_t)NT * 4;
constexpr size_t OFF_AGG = OFF_RS3 + (size_t)NT * 4;
constexpr size_t OFF_SSQ3 = OFF_AGG + 768ull * 2 * 1024 * 4;
constexpr size_t OFF_CTL = OFF_SSQ3 + (size_t)NT * 8 * 4;
constexpr size_t OFF_AGGB = OFF_CTL + 256;
constexpr size_t WS_END = OFF_AGGB + 768ull * 4 * 2 * 512 * 4;
constexpr size_t OFF_XR = OFF_R1;
constexpr size_t OFF_GR = OFF_R1 + 96 * MiB;
constexpr size_t OFF_Q = OFF_R1 + 192 * MiB;
constexpr size_t OFF_KB = OFF_R1 + 288 * MiB;
constexpr size_t OFF_VB = OFF_R1 + 312 * MiB;
constexpr size_t OFF_QP = OFF_R1;
constexpr size_t OFF_H2B = OFF_R1;
constexpr size_t OFF_G = OFF_R1 + 192 * MiB;
constexpr size_t OFF_PART = OFF_R1 + 192 * MiB;
constexpr size_t OFF_AT = OFF_R2;
constexpr size_t OFF_HF = OFF_R2 + 96 * MiB;
constexpr size_t OFF_H1B = OFF_R2;
constexpr size_t OFF_XB = OFF_R0;
constexpr size_t OFF_MRG = OFF_R1 + 192 * MiB;
constexpr size_t OFF_SUBS = OFF_R0;
constexpr size_t OFF_WGT = OFF_R0;
constexpr size_t OFF_PIDX = OFF_R0 + 96 * MiB;
constexpr size_t OFF_PS = OFF_R0 + 144 * MiB;
constexpr size_t OFF_H3 = OFF_R0;

struct P {
    const float *x_p, *x_s, *p_p, *p_s, *mix_g, *w_in, *sink, *conv_w, *conv_b, *lru_wa, *lru_ba, *lru_wx, *lru_bx, *lru_lam,
        *attn_g, *lru_g, *w_out, *ffn_g, *peer_wq, *peer_keys, *peer_u, *peer_v, *ple_g, *ple_wg, *ple_wp, *fin_g;
    float* out;
    char* ws;
};

__device__ __forceinline__ int opaque_tid(int wv) { unsigned z = 0; asm volatile("" : "+v"(z)); int l = __builtin_amdgcn_mbcnt_hi(~0u, __builtin_amdgcn_mbcnt_lo(~0u, z)); return wv * 64 + l; }
__device__ __forceinline__ unsigned pk2(float lo, float hi) {
    unsigned r;
    asm("v_cvt_pk_bf16_f32 %0, %1, %2" : "=v"(r) : "v"(lo), "v"(hi));
    return r;
}
__device__ __forceinline__ float bflo(unsigned w) { return __uint_as_float(w << 16); }
__device__ __forceinline__ float bfhi(unsigned w) { return __uint_as_float(w & 0xffff0000u); }
__device__ __forceinline__ float bf1(bf16_t h) { return __uint_as_float((unsigned)h << 16); }
__device__ __forceinline__ void st4bf(bf16_t* dst, f32x4 v) {
    uint2 o; o.x = pk2(v[0], v[1]); o.y = pk2(v[2], v[3]);
    *(uint2*)dst = o;
}
__device__ __forceinline__ void st8bf(bf16_t* dst, f32x4 a, f32x4 b) {
    uint4 o; o.x = pk2(a[0], a[1]); o.y = pk2(a[2], a[3]); o.z = pk2(b[0], b[1]); o.w = pk2(b[2], b[3]);
    *(uint4*)dst = o;
}
__device__ __forceinline__ void ld8bf(const bf16_t* src, f32x4& a, f32x4& b) {
    const uint4 o = *(const uint4*)src;
    a[0] = bflo(o.x); a[1] = bfhi(o.x); a[2] = bflo(o.y); a[3] = bfhi(o.y);
    b[0] = bflo(o.z); b[1] = bfhi(o.z); b[2] = bflo(o.w); b[3] = bfhi(o.w);
}
__device__ __forceinline__ f32x4 ld4bf(const bf16_t* src) {
    uint2 o = *(const uint2*)src;
    f32x4 v; v[0] = bflo(o.x); v[1] = bfhi(o.x); v[2] = bflo(o.y); v[3] = bfhi(o.y);
    return v;
}
__device__ __forceinline__ float dppf(float v, const int ctrl_sel) {
    int t = 0;
    if (ctrl_sel == 0) t = __builtin_amdgcn_update_dpp(0, __float_as_int(v), 0xB1, 0xf, 0xf, true);
    else if (ctrl_sel == 1) t = __builtin_amdgcn_update_dpp(0, __float_as_int(v), 0x4E, 0xf, 0xf, true);
    else if (ctrl_sel == 2) t = __builtin_amdgcn_update_dpp(0, __float_as_int(v), 0x141, 0xf, 0xf, true);
    else t = __builtin_amdgcn_update_dpp(0, __float_as_int(v), 0x140, 0xf, 0xf, true);
    return __int_as_float(t);
}
__device__ __forceinline__ float row_max16(float v) {
    v = fmaxf(v, dppf(v, 0)); v = fmaxf(v, dppf(v, 1)); v = fmaxf(v, dppf(v, 2)); v = fmaxf(v, dppf(v, 3));
    return v;
}
__device__ __forceinline__ float row_sum16(float v) {
    v += dppf(v, 0); v += dppf(v, 1); v += dppf(v, 2); v += dppf(v, 3);
    return v;
}
__device__ __forceinline__ float wave_sum(float v) {
    v = row_sum16(v);
    v += __int_as_float(__builtin_amdgcn_ds_swizzle(__float_as_int(v), 0x401F));
    return __int_as_float(__builtin_amdgcn_readlane(__float_as_int(v), 0)) + __int_as_float(__builtin_amdgcn_readlane(__float_as_int(v), 32));
}
__device__ __forceinline__ float xor32(float v, int lane) {
    return __int_as_float(__builtin_amdgcn_ds_bpermute((lane ^ 32) << 2, __float_as_int(v)));
}
__device__ __forceinline__ void grid_bar(unsigned* cnt, const unsigned target, const int wv) {
    asm volatile("s_waitcnt vmcnt(0)" ::: "memory");
    __syncthreads();
    if (wv == 0) {
        const int l = opaque_tid(0);
        if (l == 0) {
            __builtin_amdgcn_fence(__ATOMIC_RELEASE, "agent");
            asm volatile("s_waitcnt vmcnt(0)" ::: "memory");
            __hip_atomic_fetch_add(cnt, 1u, __ATOMIC_RELAXED, __HIP_MEMORY_SCOPE_AGENT);
            while (__hip_atomic_load(cnt, __ATOMIC_RELAXED, __HIP_MEMORY_SCOPE_AGENT) < target) __builtin_amdgcn_s_sleep(2);
            __builtin_amdgcn_fence(__ATOMIC_ACQUIRE, "agent");
            asm volatile("s_waitcnt vmcnt(0)" ::: "memory");
        }
    }
    __syncthreads();
}
__device__ __forceinline__ float fexp(float x) { return __builtin_amdgcn_exp2f(x * 1.4426950408889634f); }
__device__ __forceinline__ float frcp(float x) { return __builtin_amdgcn_rcpf(x); }
__device__ __forceinline__ float fsqrt(float x) { return __builtin_amdgcn_sqrtf(x); }
__device__ __forceinline__ float frsq(float x) { return __builtin_amdgcn_rsqf(x); }
__device__ __forceinline__ float sigmoidf_(float x) { return frcp(1.f + fexp(-x)); }
__device__ __forceinline__ float gelu_tanh(float x) {
    const float y2 = 1.5957691216057308f * (x + 0.044715f * x * x * x);
    return x * frcp(1.f + fexp(-y2));
}
__device__ __forceinline__ int tok_pos(int g) { return g < NTP ? (g & 2047) : (g & 16383); }
__device__ __forceinline__ void tile_seq(int blk, int& c, int& nc) {
    if (blk < 512) { c = blk & 15; nc = 16; } else { c = (blk - 512) & 127; nc = 128; }
}
__device__ __forceinline__ float dot2bf(unsigned a, unsigned b, float acc) {
    return __builtin_amdgcn_fdot2_f32_bf16(__builtin_bit_cast(bf16x2v, a), __builtin_bit_cast(bf16x2v, b), acc, false);
}

namespace pg8 {
#define PG8_LAS __attribute__((address_space(3)))
typedef short bf16x8 __attribute__((ext_vector_type(8)));
typedef float f32x4 __attribute__((ext_vector_type(4)));
constexpr int BM = 256, BK = 64, HALF = 128, HTB = HALF * BK * 2, STAGE_BYTES = 8 * HTB, NXCD = 8, WGM = 8;
__device__ __forceinline__ int lds_byte(int r, int c) { const int st = (r >> 4) * 2 + (c >> 5), rr = r & 15, cc = c & 31, ob = rr * 64 + cc * 2; return st * 1024 + (ob ^ (((ob >> 9) & 1) << 5)); }
__device__ __forceinline__ void stage_rc(int b, int& R, int& C) { const int st = b / 1024, sb = b % 1024, swz = sb ^ (((sb >> 9) & 1) << 5); R = (st >> 1) * 16 + swz / 64; C = (st & 1) * 32 + (swz % 64) / 2; }
__device__ __forceinline__ int perm32(int rho) { const int n = rho >> 4, i = rho & 15; return 8 * (i >> 2) + 4 * n + (i & 3); }
struct Unit { int pm, pn; };
struct Gemm { const bf16_t* A; const bf16_t* Bt; int M, N, K; };
struct StaticOrder {
    int nM, nN, nwg, G, c;
    __device__ void init(int M, int N, int G_, int c_) { nM = M / BM; nN = N / BM; nwg = nM * nN; G = G_; c = c_; }
    __device__ bool next(int i, Unit& u) const {
        const long L = (long)i * G + c; if (L >= nwg) return false;
        int wgid = (int)L; { const int q = nwg / NXCD, r = nwg % NXCD, xcd = wgid % NXCD, off = wgid / NXCD; wgid = (xcd < r ? xcd * (q + 1) : r * (q + 1) + (xcd - r) * q) + off; }
        const int nig = WGM * nN, gid = wgid / nig, fm = gid * WGM, gsz = (nM - fm) < WGM ? (nM - fm) : WGM;
        u.pm = fm + ((wgid % nig) % gsz); u.pn = (wgid % nig) / gsz; return true;
    }
    __device__ __forceinline__ void a_ready(const Unit&) const {}
    __device__ __forceinline__ void done(const Unit&) const {}
};
template <class Epi, class Sched, bool STAMP = false>
__device__ __forceinline__ void gemm_phase(PG8_LAS unsigned char* lds, const Gemm g, const Sched& S, const Epi& E, unsigned long long* stamps, const int wv) {
    const int tid = opaque_tid(wv), wid = wv, lane = tid & 63, wr = wid >> 2, wc = wid & 3, fr = lane & 15, fq = lane >> 4;
    const int K = g.K, nt = K / BK;
    int ts_lo = 0, ts_hi = 0, nts = 0; const unsigned long long rt_entry = STAMP ? (unsigned long long)wall_clock64() : 0ull;
#define PG8_STAMP() do { if (STAMP && wid == 0 && nts < 64) { const unsigned long long _c = (unsigned long long)clock64(); \
        ts_lo = (lane == nts) ? (int)(unsigned)_c : ts_lo; ts_hi = (lane == nts) ? (int)(unsigned)(_c >> 32) : ts_hi; ++nts; } } while (0)
    PG8_STAMP();
    unsigned voffA[2], voffB[2];
#pragma unroll
    for (int i = 0; i < 2; ++i) { int R, C; stage_rc(tid * 16 + i * 8192, R, C); const int Rb = Epi::PERM ? ((R & ~31) + perm32(R & 31)) : R;
        voffA[i] = (unsigned)(R * K + C) * 2u; voffB[i] = (unsigned)(Rb * K + C) * 2u; }
    const size_t kstep = (size_t)(BK * 2);
    const size_t hstep = (size_t)HALF * K * 2;
    const size_t tstep = 2 * hstep;
    const unsigned ldsw = (unsigned)wid * 1024u;
    const int aoff = lds_byte(wr * 64 + fr, fq * 8), boff = lds_byte(wc * 32 + fr, fq * 8);
#define PG8_SA(b, h) (((b) * 2 + (h)) * HTB)
#define PG8_SB(b, h) ((4 + (b) * 2 + (h)) * HTB)
#define PG8_STAGE(bufoff, gbase, voff) do { _Pragma("unroll") for (int _i = 0; _i < 2; ++_i) \
        __builtin_amdgcn_global_load_lds((const unsigned*)((const char*)(gbase) + (voff)[_i]), (PG8_LAS unsigned*)(lds + (bufoff) + ldsw + _i * 8192), 16, 0, 0); } while (0)
#define PG8_LDA(dst, b, h) do { _Pragma("unroll") for (int m = 0; m < 4; ++m) _Pragma("unroll") for (int k = 0; k < 2; ++k) dst[m][k] = *(const PG8_LAS bf16x8*)(lds + PG8_SA(b, h) + aoff + m * 2048 + k * 1024); } while (0)
#define PG8_LDB(dst, b, h) do { _Pragma("unroll") for (int n = 0; n < 2; ++n) _Pragma("unroll") for (int k = 0; k < 2; ++k) dst[n][k] = *(const PG8_LAS bf16x8*)(lds + PG8_SB(b, h) + boff + n * 2048 + k * 1024); } while (0)
#define PG8_MMA(ai, bj, At, Bt) do { __builtin_amdgcn_s_setprio(1); _Pragma("unroll") for (int m = 0; m < 4; ++m) _Pragma("unroll") for (int n = 0; n < 2; ++n) _Pragma("unroll") for (int k = 0; k < 2; ++k) \
        acc[ai][bj][m][n] = __builtin_amdgcn_mfma_f32_16x16x32_bf16(Bt[n][k], At[m][k], acc[ai][bj][m][n], 0, 0, 0); __builtin_amdgcn_s_setprio(0); } while (0)
#define PG8_WAIT_V(n) asm volatile("s_waitcnt vmcnt(" #n ")" ::: "memory")
#define PG8_WAIT_L(n) asm volatile("s_waitcnt lgkmcnt(" #n ")" ::: "memory")
#define PG8_BAR __builtin_amdgcn_s_barrier()
#define PG8_SCHED __builtin_amdgcn_sched_barrier(0)
    Unit cur, nxt; int ui = 0;
    if (!S.next(0, cur)) return;
    f32x4 acc[2][2][4][2];
#pragma unroll
    for (int a = 0; a < 2; ++a)
#pragma unroll
        for (int b = 0; b < 2; ++b)
#pragma unroll
            for (int m = 0; m < 4; ++m)
#pragma unroll
                for (int n = 0; n < 2; ++n) acc[a][b][m][n] = (f32x4){0.f, 0.f, 0.f, 0.f};
    bf16x8 At[4][2], B0[2][2], B1[2][2];
    const char* cA = (const char*)g.A + (size_t)cur.pm * tstep; const char* cB = (const char*)g.Bt + (size_t)cur.pn * tstep;
    S.a_ready(cur);
    PG8_STAGE(PG8_SB(0, 0), cB, voffB); PG8_STAGE(PG8_SA(0, 0), cA, voffA); PG8_STAGE(PG8_SB(0, 1), cB + hstep, voffB); PG8_STAGE(PG8_SA(0, 1), cA + hstep, voffA);
    if (wr == 1) PG8_BAR;
    PG8_WAIT_V(4); PG8_BAR;
    PG8_STAGE(PG8_SB(1, 0), cB + kstep, voffB); PG8_STAGE(PG8_SA(1, 0), cA + kstep, voffA); PG8_STAGE(PG8_SB(1, 1), cB + hstep + kstep, voffB);
    PG8_WAIT_V(6); PG8_BAR;
    PG8_STAMP();
    for (;;) {
        const bool has_next = S.next(ui + 1, nxt);
        const char* nA = has_next ? (const char*)g.A + (size_t)nxt.pm * tstep : cA; const char* nB = has_next ? (const char*)g.Bt + (size_t)nxt.pn * tstep : cB;
        for (int t = 0; t < nt; t += 2) {
            const bool last = (t == nt - 2);
            const char* a1 = cA + (size_t)(t + 1) * kstep;
            const char* a2 = last ? nA : cA + (size_t)(t + 2) * kstep; const char* b2 = last ? nB : cB + (size_t)(t + 2) * kstep;
            const char* a3 = a2 + kstep; const char* b3 = b2 + kstep;
            if (last && has_next) S.a_ready(nxt);
            PG8_LDB(B0, 0, 0); PG8_SCHED; PG8_LDA(At, 0, 0); PG8_STAGE(PG8_SA(1, 1), a1 + hstep, voffA);
            PG8_WAIT_L(8); PG8_BAR; PG8_WAIT_L(0); PG8_MMA(0, 0, At, B0); PG8_BAR; PG8_SCHED;
            PG8_LDB(B1, 0, 1); PG8_STAGE(PG8_SB(0, 0), b2, voffB);
            PG8_BAR; PG8_WAIT_L(0); PG8_MMA(0, 1, At, B1); PG8_BAR;
            PG8_LDA(At, 0, 1); PG8_STAGE(PG8_SA(0, 0), a2, voffA);
            PG8_BAR; PG8_WAIT_L(0); PG8_MMA(1, 0, At, B0); PG8_BAR; PG8_SCHED;
            PG8_STAGE(PG8_SB(0, 1), b2 + hstep, voffB);
            PG8_WAIT_V(6); PG8_BAR; PG8_MMA(1, 1, At, B1); PG8_BAR;
            PG8_LDB(B0, 1, 0); PG8_SCHED; PG8_LDA(At, 1, 0); PG8_STAGE(PG8_SA(0, 1), a2 + hstep, voffA);
            PG8_WAIT_L(8); PG8_BAR; PG8_WAIT_L(0); PG8_MMA(0, 0, At, B0); PG8_BAR; PG8_SCHED;
            PG8_LDB(B1, 1, 1); PG8_STAGE(PG8_SB(1, 0), b3, voffB);
            PG8_BAR; PG8_WAIT_L(0); PG8_MMA(0, 1, At, B1); PG8_BAR;
            PG8_LDA(At, 1, 1); PG8_STAGE(PG8_SA(1, 0), a3, voffA);
            PG8_BAR; PG8_WAIT_L(0); PG8_MMA(1, 0, At, B0); PG8_BAR; PG8_SCHED;
            PG8_STAGE(PG8_SB(1, 1), b3 + hstep, voffB);
            PG8_WAIT_V(6); PG8_BAR; PG8_MMA(1, 1, At, B1); PG8_BAR;
        }
        PG8_STAMP();
        if constexpr (!Epi::AFTER_DRAIN) { E(acc, cur, wr, wc, fr, fq); S.done(cur); }
        PG8_STAMP();
        if (!has_next) break;
#pragma unroll
        for (int a = 0; a < 2; ++a)
#pragma unroll
            for (int b = 0; b < 2; ++b)
#pragma unroll
                for (int m = 0; m < 4; ++m)
#pragma unroll
                    for (int n = 0; n < 2; ++n) acc[a][b][m][n] = (f32x4){0.f, 0.f, 0.f, 0.f};
        cur = nxt; cA = nA; cB = nB; ++ui;
    }
    PG8_WAIT_V(0);
    if (wr == 0) PG8_BAR;
    PG8_BAR;
    if constexpr (Epi::AFTER_DRAIN) { E.fused(acc, cur, wr, wc, fr, fq, lds, wid, lane); S.done(cur); }
    PG8_STAMP();
    if (STAMP && wid == 0) { stamps[lane] = lane < nts ? (((unsigned long long)(unsigned)ts_hi << 32) | (unsigned)ts_lo) : 0ull;
        if (lane == 62) stamps[62] = rt_entry; if (lane == 63) stamps[63] = (unsigned long long)wall_clock64(); }
#undef PG8_STAMP
#undef PG8_SA
#undef PG8_SB
#undef PG8_STAGE
#undef PG8_LDA
#undef PG8_LDB
#undef PG8_MMA
#undef PG8_WAIT_V
#undef PG8_WAIT_L
#undef PG8_BAR
#undef PG8_SCHED
}
__device__ __forceinline__ void pin_pre(const float& v) { asm volatile("" ::"v"(v)); }
__device__ __forceinline__ void pin_pre(const int&) {}
__device__ __forceinline__ void pin_pre(const uint4& v) { asm volatile("" ::"v"(v.x), "v"(v.y), "v"(v.z), "v"(v.w)); }
struct Pre2u4 { uint4 a, b; };
struct Pre2x4 { f32x4 a, b; };
__device__ __forceinline__ void pin_pre(const Pre2x4& v) { asm volatile("" ::"v"(v.a), "v"(v.b)); }
__device__ __forceinline__ void pin_pre(const Pre2u4& v) { pin_pre(v.a); pin_pre(v.b); }
template <class L, class A, int NB> struct EpiFn {
    static constexpr bool PERM = true, AFTER_DRAIN = false;
    L ld; A ap;
    __device__ __forceinline__ void operator()(const f32x4 (&acc)[2][2][4][2], const Unit& u, int wr, int wc, int fr, int fq) const {
        const int row0 = u.pm * BM + wr * 64 + fr, col0 = u.pn * BM + wc * 32 + 8 * fq;
        constexpr int PER = 16 / NB;
#pragma unroll
        for (int b = 0; b < NB; ++b) {
            decltype(ld(0, 0)) pre[PER];
#pragma unroll
            for (int k = 0; k < PER; ++k) {
                const int idx = b * PER + k, ai = idx >> 3, m = (idx >> 1) & 3, bj = idx & 1;
                pre[k] = ld(row0 + ai * HALF + m * 16, col0 + bj * HALF);
            }
#pragma unroll
            for (int k = 0; k < PER; ++k) pin_pre(pre[k]);
#pragma unroll
            for (int k = 0; k < PER; ++k) {
                const int idx = b * PER + k, ai = idx >> 3, m = (idx >> 1) & 3, bj = idx & 1;
                ap(row0 + ai * HALF + m * 16, col0 + bj * HALF, acc[ai][bj][m][0], acc[ai][bj][m][1], pre[k]);
            }
        }
    }
};
}

template <int NB, class L, class A>
__device__ __forceinline__ void gemm_run(const bf16_t* Am, const bf16_t* Bt, int N, int K, char* shm, const int wv, L ld, A ap) {
    pg8::Gemm g{Am, Bt, NT, N, K};
    pg8::StaticOrder S; S.init(NT, N, (int)gridDim.x, (int)blockIdx.x);
    pg8::EpiFn<L, A, NB> E{ld, ap};
    __syncthreads();
    pg8::gemm_phase<pg8::EpiFn<L, A, NB>, pg8::StaticOrder, false>((PG8_LAS unsigned char*)shm, g, S, E, nullptr, wv);
    __syncthreads();
}

template <class NMap, class Scale>
__device__ __forceinline__ void prep_wT(const float* __restrict__ src, bf16_t* __restrict__ dst, int K, int N, int gtid, int gstride,
                                        NMap nmap, Scale scale) {
    const int items = N * (K / 8);
    for (int it = gtid; it < items; it += gstride) {
        const int n = it % N, k0 = (it / N) * 8;
        const int ns = nmap(n);
        float v[8];
#pragma unroll
        for (int i = 0; i < 8; ++i) v[i] = src[(size_t)(k0 + i) * N + ns] * scale(k0 + i);
        uint4 o; o.x = pk2(v[0], v[1]); o.y = pk2(v[2], v[3]); o.z = pk2(v[4], v[5]); o.w = pk2(v[6], v[7]);
        *(uint4*)(dst + (size_t)n * K + k0) = o;
    }
}

__device__ __forceinline__ void phase_prep(const P& p, const int wv) {
    const int gtid = blockIdx.x * NTHREADS + opaque_tid(wv), gstride = gridDim.x * NTHREADS;
    const int lane = gtid & 63, gw = gtid >> 6, nw = gstride >> 6;
    char* ws = p.ws;
    {
        const float* g = p.mix_g;
        prep_wT(p.w_in, (bf16_t*)(ws + OFF_WIN), 1024, 1792, gtid, gstride,
                [](int n) { if (n >= 640) return n; int pp = n & 63; return (n & ~63) + (pp >> 3) * 4 + (pp & 3) + ((pp >> 2) & 1) * 32; },
                [g](int k) { return g[k]; });
    }
    {
        const float *ga = p.attn_g, *gl = p.lru_g;
        prep_wT(p.w_out, (bf16_t*)(ws + OFF_WOUT), 1024, 1024, gtid, gstride, [](int n) { return n; },
                [ga, gl](int k) { return k < 512 ? ga[k] : gl[k - 512]; });
    }
    {
        const float* g = p.ffn_g;
        prep_wT(p.peer_wq, (bf16_t*)(ws + OFF_WQ), 1024, 2048, gtid, gstride, [](int n) { return n; }, [g](int k) { return g[k]; });
    }
    {
        const float* g = p.ple_g;
        prep_wT(p.ple_wg, (bf16_t*)(ws + OFF_WG), 1024, 1024, gtid, gstride, [](int n) { return n; }, [g](int k) { return g[k]; });
    }
    prep_wT(p.ple_wp, (bf16_t*)(ws + OFF_WP), 256, 1024, gtid, gstride, [](int n) { return n; }, [](int) { return 1.f; });
    {
        bf16_t* kb = (bf16_t*)(ws + OFF_KEYS);
        for (int i = gtid; i < 16 * 128 * 128 / 2; i += gstride) {
            float2 v = ((const float2*)p.peer_keys)[i];
            ((unsigned*)kb)[i] = pk2(v.x, v.y);
        }
    }
    {
        bf16_t* lw = (bf16_t*)(ws + OFF_LW);
        for (int i = gtid; i < 2 * 2 * 8 * 64 * 64; i += gstride) {
            const int e = i & 7, ln = (i >> 3) & 63, ks = (i >> 9) & 3, cb = (i >> 11) & 1, h = (i >> 12) & 7, mat = (i >> 15) & 1, dir = (i >> 16) & 1;
            const int tl = ln & 31, hf = ln >> 5;
            const int j = cb * 32 + tl;
            const int ii = 16 * ks + 8 * (e >> 2) + 4 * hf + (e & 3);
            const float* srcw = mat ? p.lru_wx : p.lru_wa;
            const float v = srcw[(((size_t)dir * 8 + h) * 64 + ii) * 64 + j];
            lw[i] = (bf16_t)(pk2(v, 0.f) & 0xffff);
        }
        float* ls = (float*)(ws + OFF_LS);
        for (int i = gtid; i < 1024; i += gstride) {
            const float lam = p.lru_lam[i];
            ls[i] = lam >= 0.f ? -log1pf(expf(-lam)) : lam - log1pf(expf(lam));
        }
    }
    {
        const float* g = p.ffn_g;
        const float4* us = (const float4*)p.peer_u;
        const float4* vs = (const float4*)p.peer_v;
        uint4* ud = (uint4*)(ws + OFF_UT);
        uint4* vd = (uint4*)(ws + OFF_VT);
        for (int i = gtid; i < 16384 * 64; i += gstride) {
            unsigned uo[4], vo[4];
#pragma unroll
            for (int q = 0; q < 4; ++q) {
                const float4 u = us[(size_t)i * 4 + q], v = vs[(size_t)i * 4 + q];
                const float4 gg = ((const float4*)g)[(i * 4 + q) & 255];
                int a = __builtin_amdgcn_cvt_pk_fp8_f32(u.x * gg.x * 64.f, u.y * gg.y * 64.f, 0, false);
                a = __builtin_amdgcn_cvt_pk_fp8_f32(u.z * gg.z * 64.f, u.w * gg.w * 64.f, a, true);
                int b = __builtin_amdgcn_cvt_pk_fp8_f32(v.x * 8.f, v.y * 8.f, 0, false);
                b = __builtin_amdgcn_cvt_pk_fp8_f32(v.z * 8.f, v.w * 8.f, b, true);
                uo[q] = (unsigned)a; vo[q] = (unsigned)b;
            }
            const int e_ = i >> 6, c16 = i & 63;
            const size_t di = ((size_t)(c16 >> 3) * 16384 + e_) * 8 + (c16 & 7);
            ud[di] = make_uint4(uo[0], uo[1], uo[2], uo[3]);
            vd[di] = make_uint4(vo[0], vo[1], vo[2], vo[3]);
        }
    }
    {
        uint2* pd = (uint2*)(ws + OFF_PB);
        for (int i = gtid; i < NT * 64; i += gstride) {
            const float4 v = i < NTP * 64 ? ((const float4*)p.p_p)[i] : ((const float4*)p.p_s)[i - NTP * 64];
            uint2 a; a.x = pk2(v.x, v.y); a.y = pk2(v.z, v.w);
            pd[i] = a;
        }
    }
    {
        bf16_t* xb = (bf16_t*)(ws + OFF_XB);
        float* rs1 = (float*)(ws + OFF_RS1);
        for (int tok = gw; tok < NT; tok += nw) {
            const float4* xr = (const float4*)(tok < NTP ? p.x_p + (size_t)tok * 1024 : p.x_s + (size_t)(tok - NTP) * 1024);
            float s = 0.f;
            uint2* od = (uint2*)(xb + (size_t)tok * 1024);
#pragma unroll
            for (int j = 0; j < 4; ++j) {
                const float4 v = xr[lane + 64 * j];
                s += v.x * v.x + v.y * v.y + v.z * v.z + v.w * v.w;
                uint2 a; a.x = pk2(v.x, v.y); a.y = pk2(v.z, v.w);
                od[lane + 64 * j] = a;
            }
            s = wave_sum(s);
            if (lane == 0) rs1[tok] = frsq(s * (1.f / 1024.f) + EPS);
        }
    }
}

__device__ __forceinline__ void phase_inproj(const P& p, char* shm, const int wv) {
    char* ws = p.ws;
    const bf16_t* XB = (const bf16_t*)(ws + OFF_XB);
    const bf16_t* W = (const bf16_t*)(ws + OFF_WIN);
    const float* RS1 = (const float*)(ws + OFF_RS1);
    bf16_t* Q = (bf16_t*)(ws + OFF_Q);
    bf16_t* KB = (bf16_t*)(ws + OFF_KB);
    bf16_t* VB = (bf16_t*)(ws + OFF_VB);
    bf16_t* XR = (bf16_t*)(ws + OFF_XR);
    bf16_t* GR = (bf16_t*)(ws + OFF_GR);
    auto ld = [=](int row, int col) { return RS1[row]; };
    auto epi = [=](int row, int col, f32x4 v0, f32x4 v1, float rs) {
        v0 *= rs; v1 *= rs;
        if (col < 640) {
            const int pos = tok_pos(row);
            const int d0 = ((col & 63) >> 3) * 4;
            f32x4 o0, o1;
#pragma unroll
            for (int j = 0; j < 4; ++j) {
                const float invf = exp2f(-(float)(d0 + j) * 0.41524101186092029f);
                const float ang = (float)pos * invf;
                const float nrev = rintf(ang * 0.15915494309189535f);
                float rr = fmaf(-nrev, 6.28125f, ang);
                rr = fmaf(-nrev, 0.0019353071795864769f, rr);
                const float cs = __cosf(rr), sn = __sinf(rr);
                o0[j] = v0[j] * cs - v1[j] * sn;
                o1[j] = v1[j] * cs + v0[j] * sn;
            }
            if (col < 512) {
                o0 *= 0.125f; o1 *= 0.125f;
                bf16_t* dst = Q + (size_t)row * 512 + (col & ~63) + d0;
                st4bf(dst, o0); st4bf(dst + 32, o1);
            } else {
                bf16_t* dst = KB + (size_t)row * 128 + ((col - 512) & ~63) + d0;
                st4bf(dst, o0); st4bf(dst + 32, o1);
            }
        } else if (col < 768) {
            st8bf(VB + (size_t)row * 128 + (col - 640), v0, v1);
        } else if (col < 1280) {
            st8bf(XR + (size_t)row * 512 + (col - 768), v0, v1);
        } else {
            bf16_t* dst = GR + (size_t)row * 512 + (col - 1280);
            f32x4 g0, g1;
#pragma unroll
            for (int j = 0; j < 4; ++j) { g0[j] = gelu_tanh(v0[j]); g1[j] = gelu_tanh(v1[j]); }
            st8bf(dst, g0, g1);
        }
    };
    gemm_run<1>(XB, W, 1792, 1024, shm, wv, ld, epi);
}

__device__ __forceinline__ void attn_unit(const P& p, char* shm, int unit, const int wv) {
    char* ws = p.ws;
    const int blk = unit >> 1, kvh = unit & 1;
    int c, nc; tile_seq(blk, c, nc);
    const int g0 = blk * 128;
    bf16_t* Ks = (bf16_t*)shm;
    bf16_t* Vt = (bf16_t*)(shm + 55296);
    const bf16_t* KB = (const bf16_t*)(ws + OFF_KB);
    const bf16_t* VB = (const bf16_t*)(ws + OFF_VB);
    const bf16_t* Q = (const bf16_t*)(ws + OFF_Q);
    bf16_t* AT = (bf16_t*)(ws + OFF_AT);
    const int tid = opaque_tid(wv), w = tid >> 6, lane = tid & 63, half = lane >> 5, tl = lane & 31;
    __syncthreads();
    for (int item = tid; item < 384 * 8; item += NTHREADS) {
        const int key = item % 384, part = item / 384;
        const int ch = key >> 7;
        if ((ch == 0 && c == 0) || (ch == 2 && c == nc - 1)) continue;
        const size_t tok = (size_t)(g0 - 128 + key);
        const uint4 kv = *(const uint4*)(KB + tok * 128 + kvh * 64 + part * 8);
        *(uint4*)(Ks + key * 72 + part * 8) = kv;
        const uint4 vv = *(const uint4*)(VB + tok * 128 + kvh * 64 + part * 8);
        bf16_t* vd = Vt + (part * 8) * 388 + key;
        vd[0 * 388] = (bf16_t)(vv.x & 0xffff); vd[1 * 388] = (bf16_t)(vv.x >> 16);
        vd[2 * 388] = (bf16_t)(vv.y & 0xffff); vd[3 * 388] = (bf16_t)(vv.y >> 16);
        vd[4 * 388] = (bf16_t)(vv.z & 0xffff); vd[5 * 388] = (bf16_t)(vv.z >> 16);
        vd[6 * 388] = (bf16_t)(vv.w & 0xffff); vd[7 * 388] = (bf16_t)(vv.w >> 16);
    }
    __syncthreads();
    for (int it = 0; it < 2; ++it) {
        const int task = w + 8 * it;
        const int qhl = task & 3, rg = task >> 2;
        const int hq = kvh * 4 + qhl;
        const int qrow = rg * 32 + tl;
        const bf16_t* qp = Q + (size_t)(g0 + qrow) * 512 + hq * 64 + half * 8;
        bf16x8 qf[4];
#pragma unroll
        for (int ks = 0; ks < 4; ++ks) qf[ks] = *(const bf16x8*)(qp + ks * 16);
        float m = p.sink[hq];
        float l = half == 0 ? 1.f : 0.f;
        f32x16 O0, O1;
#pragma unroll
        for (int i = 0; i < 16; ++i) { O0[i] = 0.f; O1[i] = 0.f; }
        for (int ch = 0; ch < 3; ++ch) {
            if ((ch == 0 && c == 0) || (ch == 2 && c == nc - 1)) continue;
            f32x16 S[4];
#pragma unroll
            for (int kb = 0; kb < 4; ++kb) {
#pragma unroll
                for (int i = 0; i < 16; ++i) S[kb][i] = 0.f;
#pragma unroll
                for (int ks = 0; ks < 4; ++ks) {
                    const bf16x8 kf = *(const bf16x8*)(Ks + (ch * 128 + kb * 32 + tl) * 72 + ks * 16 + half * 8);
                    S[kb] = __builtin_amdgcn_mfma_f32_32x32x16_bf16(kf, qf[ks], S[kb], 0, 0, 0);
                }
            }
            float mx = -INFINITY;
#pragma unroll
            for (int kb = 0; kb < 4; ++kb)
#pragma unroll
                for (int i = 0; i < 16; ++i) {
                    const int kk = kb * 32 + 8 * (i >> 2) + 4 * half + (i & 3);
                    const bool valid = (ch == 1) || (ch == 0 ? kk >= qrow : kk <= qrow);
                    const float s = valid ? S[kb][i] : -INFINITY;
                    S[kb][i] = s;
                    mx = fmaxf(mx, s);
                }
            mx = fmaxf(mx, xor32(mx, lane));
            const float mn = fmaxf(m, mx);
            const float alpha = fexp(m - mn);
            m = mn;
            float ps = 0.f;
#pragma unroll
            for (int kb = 0; kb < 4; ++kb)
#pragma unroll
                for (int i = 0; i < 16; ++i) {
                    const float pv = fexp(S[kb][i] - mn);
                    S[kb][i] = pv;
                    ps += pv;
                }
            l = l * alpha + ps;
#pragma unroll
            for (int i = 0; i < 16; ++i) { O0[i] *= alpha; O1[i] *= alpha; }
#pragma unroll
            for (int kb = 0; kb < 4; ++kb)
#pragma unroll
                for (int s2 = 0; s2 < 2; ++s2) {
                    uint4 pw;
                    pw.x = pk2(S[kb][8 * s2 + 0], S[kb][8 * s2 + 1]); pw.y = pk2(S[kb][8 * s2 + 2], S[kb][8 * s2 + 3]);
                    pw.z = pk2(S[kb][8 * s2 + 4], S[kb][8 * s2 + 5]); pw.w = pk2(S[kb][8 * s2 + 6], S[kb][8 * s2 + 7]);
                    const bf16x8 pf = __builtin_bit_cast(bf16x8, pw);
                    const bf16_t* vp = Vt + tl * 388 + ch * 128 + kb * 32 + 16 * s2 + 4 * half;
                    uint4 vw;
                    uint2 a0 = *(const uint2*)vp, a1 = *(const uint2*)(vp + 8);
                    vw.x = a0.x; vw.y = a0.y; vw.z = a1.x; vw.w = a1.y;
                    O0 = __builtin_amdgcn_mfma_f32_32x32x16_bf16(__builtin_bit_cast(bf16x8, vw), pf, O0, 0, 0, 0);
                    const bf16_t* vp1 = vp + 32 * 388;
                    a0 = *(const uint2*)vp1; a1 = *(const uint2*)(vp1 + 8);
                    vw.x = a0.x; vw.y = a0.y; vw.z = a1.x; vw.w = a1.y;
                    O1 = __builtin_amdgcn_mfma_f32_32x32x16_bf16(__builtin_bit_cast(bf16x8, vw), pf, O1, 0, 0, 0);
                }
        }
        const float lt = l + xor32(l, lane);
        const float inv = frcp(lt);
        bf16_t* op = AT + (size_t)(g0 + qrow) * 512 + hq * 64 + 4 * half;
#pragma unroll
        for (int i4 = 0; i4 < 4; ++i4) {
            f32x4 a, b;
#pragma unroll
            for (int q = 0; q < 4; ++q) { a[q] = O0[4 * i4 + q] * inv; b[q] = O1[4 * i4 + q] * inv; }
            st4bf(op + 8 * i4, a);
            st4bf(op + 32 + 8 * i4, b);
        }
    }
}

#define WAVE_LDS_FENCE() asm volatile("s_waitcnt lgkmcnt(0)" ::: "memory")
template <bool FINAL>
__device__ __forceinline__ void lru_unit(const P& p, char* shm, int blk, const int wv) {
    char* ws = p.ws;
    int c, nc; tile_seq(blk, c, nc);
    const int g0 = blk * 128;
    const int seq_lo = g0 - c * 128, seq_hi = seq_lo + nc * 128;
    const int tid = opaque_tid(wv), w = wv, lane = tid & 63, half = lane >> 5, tl = lane & 31;
    float* abuf = (float*)shm + w * (2 * 32 * 68);
    float* ubuf = abuf + 32 * 68;
    bf16_t* xt = (bf16_t*)abuf;
    float* ssq = (float*)(shm + 139264);
    const bf16_t* XR = (const bf16_t*)(ws + OFF_XR);
    const bf16_t* GR = (const bf16_t*)(ws + OFF_GR);
    const bf16_t* LW = (const bf16_t*)(ws + OFF_LW);
    const float* LS = (const float*)(ws + OFF_LS);
    float* AGG = (float*)(ws + OFF_AGG);
    bf16_t* HF = (bf16_t*)(ws + OFF_HF);
    bf16_t* MRG = (bf16_t*)(ws + OFF_MRG);
    const int chn = w * 64 + lane;
    __syncthreads();

    for (int dir = 0; dir < 2; ++dir) {
        float h = 0.f, Ap = 1.f;
        if (FINAL) {
            if (dir == 0) {
#pragma unroll 8
                for (int cc = 0; cc < c; ++cc) {
                    const int tile = blk - c + cc;
                    const float A_ = AGG[(size_t)(tile * 2 + 0) * 1024 + chn], H_ = AGG[(size_t)(tile * 2 + 0) * 1024 + 512 + chn];
                    h = A_ * h + H_;
                }
            } else {
#pragma unroll 8
                for (int cc = nc - 1; cc > c; --cc) {
                    const int tile = blk - c + cc;
                    const float A_ = AGG[(size_t)(tile * 2 + 1) * 1024 + chn], H_ = AGG[(size_t)(tile * 2 + 1) * 1024 + 512 + chn];
                    h = A_ * h + H_;
                }
            }
        }
        uint4 xpre[5];
#define LRU_LOAD_X(tbase) do { _Pragma("unroll") for (int i = 0; i < 5; ++i) { \
                const int tt_ = (tbase) - 2 + (lane >> 3) + 8 * i; \
                xpre[i] = make_uint4(0u, 0u, 0u, 0u); \
                if (tt_ >= seq_lo && tt_ < seq_hi) xpre[i] = *(const uint4*)(XR + (size_t)tt_ * 512 + w * 64 + (lane & 7) * 8); } } while (0)
        if (!FINAL) LRU_LOAD_X(g0 + (dir ? 3 : 0) * 32);
        for (int ibi = 0; ibi < 4; ++ibi) {
            const int ib = dir ? 3 - ibi : ibi;
            const int t0 = g0 + ib * 32;
            if (FINAL) LRU_LOAD_X(t0);
            WAVE_LDS_FENCE();
#pragma unroll
            for (int i = 0; i < 5; ++i) {
                const int rowi = (lane >> 3) + 8 * i;
                uint2* d = (uint2*)(xt + rowi * 68 + (lane & 7) * 8);
                d[0] = make_uint2(xpre[i].x, xpre[i].y); d[1] = make_uint2(xpre[i].z, xpre[i].w);
            }
            if (!FINAL && ibi < 3) LRU_LOAD_X(g0 + (dir ? 2 - ibi : ibi + 1) * 32);
            WAVE_LDS_FENCE();
            float xcv[4][8];
#pragma unroll
            for (int ks = 0; ks < 4; ++ks)
#pragma unroll
                for (int grp = 0; grp < 2; ++grp) {
                    const int cl = 16 * ks + 8 * grp + 4 * half;
                    const int cb4 = w * 64 + cl;
                    f32x4 a = *(const f32x4*)(p.conv_b + cb4);
#pragma unroll
                    for (int j = 0; j < 4; ++j) {
                        const f32x4 xv = ld4bf(xt + (tl + j) * 68 + cl);
                        const f32x4 wv4 = *(const f32x4*)(p.conv_w + j * 512 + cb4);
                        a += wv4 * xv;
                    }
#pragma unroll
                    for (int q = 0; q < 4; ++q) xcv[ks][grp * 4 + q] = a[q];
                }
            bf16x8 xb[4];
#pragma unroll
            for (int ks = 0; ks < 4; ++ks) {
                uint4 pw;
                pw.x = pk2(xcv[ks][0], xcv[ks][1]); pw.y = pk2(xcv[ks][2], xcv[ks][3]);
                pw.z = pk2(xcv[ks][4], xcv[ks][5]); pw.w = pk2(xcv[ks][6], xcv[ks][7]);
                xb[ks] = __builtin_bit_cast(bf16x8, pw);
            }
            WAVE_LDS_FENCE();
#pragma unroll
            for (int cb = 0; cb < 2; ++cb) {
                f32x16 aa, ax;
#pragma unroll
                for (int i = 0; i < 16; ++i) { aa[i] = 0.f; ax[i] = 0.f; }
#pragma unroll
                for (int ks = 0; ks < 4; ++ks) {
                    const bf16x8 wa = *(const bf16x8*)(LW + ((size_t)((((dir * 2 + 0) * 8 + w) * 2 + cb) * 4 + ks) * 64 + lane) * 8);
                    const bf16x8 wx = *(const bf16x8*)(LW + ((size_t)((((dir * 2 + 1) * 8 + w) * 2 + cb) * 4 + ks) * 64 + lane) * 8);
                    aa = __builtin_amdgcn_mfma_f32_32x32x16_bf16(wa, xb[ks], aa, 0, 0, 0);
                    ax = __builtin_amdgcn_mfma_f32_32x32x16_bf16(wx, xb[ks], ax, 0, 0, 0);
                }
#pragma unroll
                for (int r4 = 0; r4 < 4; ++r4) {
                    const int j0 = cb * 32 + 8 * r4 + 4 * half;
                    const int ch4 = w * 64 + j0;
                    const f32x4 ba4 = *(const f32x4*)(p.lru_ba + dir * 512 + ch4);
                    const f32x4 bx4 = *(const f32x4*)(p.lru_bx + dir * 512 + ch4);
                    const f32x4 ls4 = *(const f32x4*)(LS + dir * 512 + ch4);
                    f32x4 av, uv;
#pragma unroll
                    for (int q = 0; q < 4; ++q) {
                        const int r = 4 * r4 + q;
                        const float xcval = xcv[2 * cb + (r4 >> 1)][4 * (r4 & 1) + q];
                        const float rgate = sigmoidf_(aa[r] + ba4[q]);
                        const float igate = sigmoidf_(ax[r] + bx4[q]);
                        const float la = 8.f * rgate * ls4[q];
                        av[q] = fexp(la);
                        uv[q] = fsqrt(fmaxf(0.f, 1.f - av[q] * av[q])) * igate * xcval;
                    }
                    *(f32x4*)(abuf + tl * 68 + j0) = av;
                    *(f32x4*)(ubuf + tl * 68 + j0) = uv;
                }
            }
            WAVE_LDS_FENCE();
            float val[32];
#pragma unroll
            for (int tt = 0; tt < 32; ++tt) {
                const int tloc = dir ? 31 - tt : tt;
                const float a = abuf[tloc * 68 + lane], u = ubuf[tloc * 68 + lane];
                h = a * h + u;
                Ap *= a;
                if (FINAL) {
                    const size_t off = (size_t)(t0 + tloc) * 512 + chn;
                    if (dir == 0) {
                        HF[off] = (bf16_t)(pk2(h, 0.f) & 0xffff);
                    } else {
                        const float hf = bf1(HF[off]);
                        const float gg = bf1(GR[off]);
                        const float v = gg * (hf + h);
                        val[tt] = v;
                        abuf[tloc * 68 + lane] = v;
                    }
                }
            }
            if (FINAL && dir == 1) {
                WAVE_LDS_FENCE();
                {
                    float s = 0.f;
#pragma unroll
                    for (int q = 0; q < 8; ++q) {
                        const f32x4 v4 = *(const f32x4*)(abuf + tl * 68 + half * 32 + q * 4);
                        s += v4[0] * v4[0] + v4[1] * v4[1] + v4[2] * v4[2] + v4[3] * v4[3];
                    }
                    ssq[(w * 2 + half) * 32 + tl] = s;
                }
                __syncthreads();
                if (tid < 32) {
                    float sacc = 0.f;
#pragma unroll
                    for (int q = 0; q < 16; ++q) sacc += ssq[q * 32 + tid];
                    ssq[512 + tid] = frsq(sacc * (1.f / 512.f) + EPS);
                }
                __syncthreads();
#pragma unroll
                for (int tt = 0; tt < 32; ++tt) {
                    const int tloc = 31 - tt;
                    const float rs = ssq[512 + tloc];
                    MRG[(size_t)(t0 + tloc) * 1024 + 512 + chn] = (bf16_t)(pk2(val[tt] * rs, 0.f) & 0xffff);
                }
                __syncthreads();
            }
        }
        if (!FINAL) {
            AGG[(size_t)(blk * 2 + dir) * 1024 + chn] = Ap;
            AGG[(size_t)(blk * 2 + dir) * 1024 + 512 + chn] = h;
        }
    }
}

__device__ __forceinline__ void lru_agg_unit(const P& p, char* shm, int blk, const int wv) {
    char* ws = p.ws;
    int c, nc; tile_seq(blk, c, nc);
    const int g0 = blk * 128;
    const int seq_lo = g0 - c * 128, seq_hi = seq_lo + nc * 128;
    const int tid = opaque_tid(wv), w = wv, lane = tid & 63, half = lane >> 5, tl = lane & 31;
    float* abuf = (float*)shm + w * (2 * 32 * 68);
    float* ubuf = abuf + 32 * 68;
    bf16_t* xt = (bf16_t*)abuf;
    const bf16_t* XR = (const bf16_t*)(ws + OFF_XR);
    const bf16_t* LW = (const bf16_t*)(ws + OFF_LW);
    const float* LS = (const float*)(ws + OFF_LS);
    float* AGG = (float*)(ws + OFF_AGG);
    const int chn = w * 64 + lane;
    __syncthreads();
    float hF = 0.f, ApF = 1.f, HcB = 0.f, AcB = 1.f;
    uint4 xpre[5];
#define LRUA_LOAD_X(tbase) do { _Pragma("unroll") for (int i = 0; i < 5; ++i) { \
            const int tt_ = (tbase) - 2 + (lane >> 3) + 8 * i; \
            xpre[i] = make_uint4(0u, 0u, 0u, 0u); \
            if (tt_ >= seq_lo && tt_ < seq_hi) xpre[i] = *(const uint4*)(XR + (size_t)tt_ * 512 + w * 64 + (lane & 7) * 8); } } while (0)
    LRUA_LOAD_X(g0);
    for (int ib = 0; ib < 4; ++ib) {
        WAVE_LDS_FENCE();
#pragma unroll
        for (int i = 0; i < 5; ++i) {
            const int rowi = (lane >> 3) + 8 * i;
            uint2* d = (uint2*)(xt + rowi * 68 + (lane & 7) * 8);
            d[0] = make_uint2(xpre[i].x, xpre[i].y); d[1] = make_uint2(xpre[i].z, xpre[i].w);
        }
        if (ib < 3) LRUA_LOAD_X(g0 + (ib + 1) * 32);
        WAVE_LDS_FENCE();
        float xcv[4][8];
#pragma unroll
        for (int ks = 0; ks < 4; ++ks)
#pragma unroll
            for (int grp = 0; grp < 2; ++grp) {
                const int cl = 16 * ks + 8 * grp + 4 * half;
                const int cb4 = w * 64 + cl;
                f32x4 a = *(const f32x4*)(p.conv_b + cb4);
#pragma unroll
                for (int j = 0; j < 4; ++j) {
                    const f32x4 xv = ld4bf(xt + (tl + j) * 68 + cl);
                    const f32x4 wv4 = *(const f32x4*)(p.conv_w + j * 512 + cb4);
                    a += wv4 * xv;
                }
#pragma unroll
                for (int q = 0; q < 4; ++q) xcv[ks][grp * 4 + q] = a[q];
            }
        bf16x8 xb[4];
#pragma unroll
        for (int ks = 0; ks < 4; ++ks) {
            uint4 pw;
            pw.x = pk2(xcv[ks][0], xcv[ks][1]); pw.y = pk2(xcv[ks][2], xcv[ks][3]);
            pw.z = pk2(xcv[ks][4], xcv[ks][5]); pw.w = pk2(xcv[ks][6], xcv[ks][7]);
            xb[ks] = __builtin_bit_cast(bf16x8, pw);
        }
        for (int dir = 0; dir < 2; ++dir) {
            WAVE_LDS_FENCE();
#pragma unroll
            for (int cb = 0; cb < 2; ++cb) {
                f32x16 aa, ax;
#pragma unroll
                for (int i = 0; i < 16; ++i) { aa[i] = 0.f; ax[i] = 0.f; }
#pragma unroll
                for (int ks = 0; ks < 4; ++ks) {
                    const bf16x8 wa = *(const bf16x8*)(LW + ((size_t)((((dir * 2 + 0) * 8 + w) * 2 + cb) * 4 + ks) * 64 + lane) * 8);
                    const bf16x8 wx = *(const bf16x8*)(LW + ((size_t)((((dir * 2 + 1) * 8 + w) * 2 + cb) * 4 + ks) * 64 + lane) * 8);
                    aa = __builtin_amdgcn_mfma_f32_32x32x16_bf16(wa, xb[ks], aa, 0, 0, 0);
                    ax = __builtin_amdgcn_mfma_f32_32x32x16_bf16(wx, xb[ks], ax, 0, 0, 0);
                }
#pragma unroll
                for (int r4 = 0; r4 < 4; ++r4) {
                    const int j0 = cb * 32 + 8 * r4 + 4 * half;
                    const int ch4 = w * 64 + j0;
                    const f32x4 ba4 = *(const f32x4*)(p.lru_ba + dir * 512 + ch4);
                    const f32x4 bx4 = *(const f32x4*)(p.lru_bx + dir * 512 + ch4);
                    const f32x4 ls4 = *(const f32x4*)(LS + dir * 512 + ch4);
                    f32x4 av, uv;
#pragma unroll
                    for (int q = 0; q < 4; ++q) {
                        const int r = 4 * r4 + q;
                        const float xcval = xcv[2 * cb + (r4 >> 1)][4 * (r4 & 1) + q];
                        const float rgate = sigmoidf_(aa[r] + ba4[q]);
                        const float igate = sigmoidf_(ax[r] + bx4[q]);
                        const float la = 8.f * rgate * ls4[q];
                        av[q] = fexp(la);
                        uv[q] = fsqrt(fmaxf(0.f, 1.f - av[q] * av[q])) * igate * xcval;
                    }
                    *(f32x4*)(abuf + tl * 68 + j0) = av;
                    *(f32x4*)(ubuf + tl * 68 + j0) = uv;
                }
            }
            WAVE_LDS_FENCE();
            if (dir == 0) {
#pragma unroll
                for (int tt = 0; tt < 32; ++tt) {
                    const float a = abuf[tt * 68 + lane], u = ubuf[tt * 68 + lane];
                    hF = a * hF + u;
                    ApF *= a;
                }
            } else {
                float hb = 0.f, ab = 1.f;
#pragma unroll
                for (int tt = 0; tt < 32; ++tt) {
                    const float a = abuf[(31 - tt) * 68 + lane], u = ubuf[(31 - tt) * 68 + lane];
                    hb = a * hb + u;
                    ab *= a;
                }
                HcB += AcB * hb;
                AcB *= ab;
                float* AGGB = (float*)(ws + OFF_AGGB);
                AGGB[(size_t)((blk * 4 + ib) * 2 + 0) * 512 + chn] = ab;
                AGGB[(size_t)((blk * 4 + ib) * 2 + 1) * 512 + chn] = hb;
            }
        }
    }
#undef LRUA_LOAD_X
    AGG[(size_t)(blk * 2 + 0) * 1024 + chn] = ApF;
    AGG[(size_t)(blk * 2 + 0) * 1024 + 512 + chn] = hF;
    AGG[(size_t)(blk * 2 + 1) * 1024 + chn] = AcB;
    AGG[(size_t)(blk * 2 + 1) * 1024 + 512 + chn] = HcB;
}

__device__ __forceinline__ void lru_final_unit(const P& p, char* shm, int blk, const int wv) {
    char* ws = p.ws;
    int c, nc; tile_seq(blk, c, nc);
    const int g0 = blk * 128;
    const int seq_lo = g0 - c * 128, seq_hi = seq_lo + nc * 128;
    const int tid = opaque_tid(wv), w = wv, lane = tid & 63, half = lane >> 5, tl = lane & 31;
    float* abuf = (float*)shm + w * (2 * 32 * 68);
    float* ubuf = abuf + 32 * 68;
    bf16_t* xt = (bf16_t*)abuf;
    float* ssq = (float*)(shm + 139264);
    const bf16_t* XR = (const bf16_t*)(ws + OFF_XR);
    const bf16_t* GR = (const bf16_t*)(ws + OFF_GR);
    const bf16_t* LW = (const bf16_t*)(ws + OFF_LW);
    const float* LS = (const float*)(ws + OFF_LS);
    const float* AGG = (const float*)(ws + OFF_AGG);
    const float* AGGB = (const float*)(ws + OFF_AGGB);
    bf16_t* MRG = (bf16_t*)(ws + OFF_MRG);
    const int chn = w * 64 + lane;
    __syncthreads();
    float hF = 0.f, cT = 0.f;
#pragma unroll 8
    for (int cc = 0; cc < c; ++cc) {
        const int tile = blk - c + cc;
        const float A_ = AGG[(size_t)(tile * 2 + 0) * 1024 + chn], H_ = AGG[(size_t)(tile * 2 + 0) * 1024 + 512 + chn];
        hF = A_ * hF + H_;
    }
#pragma unroll 8
    for (int cc = nc - 1; cc > c; --cc) {
        const int tile = blk - c + cc;
        const float A_ = AGG[(size_t)(tile * 2 + 1) * 1024 + chn], H_ = AGG[(size_t)(tile * 2 + 1) * 1024 + 512 + chn];
        cT = A_ * cT + H_;
    }
    const float c3 = cT;
    const float c2 = AGGB[(size_t)((blk * 4 + 3) * 2 + 0) * 512 + chn] * c3 + AGGB[(size_t)((blk * 4 + 3) * 2 + 1) * 512 + chn];
    const float c1 = AGGB[(size_t)((blk * 4 + 2) * 2 + 0) * 512 + chn] * c2 + AGGB[(size_t)((blk * 4 + 2) * 2 + 1) * 512 + chn];
    const float c0 = AGGB[(size_t)((blk * 4 + 1) * 2 + 0) * 512 + chn] * c1 + AGGB[(size_t)((blk * 4 + 1) * 2 + 1) * 512 + chn];
    uint4 xpre[5];
#define LRUF_LOAD_X(tbase) do { _Pragma("unroll") for (int i = 0; i < 5; ++i) { \
            const int tt_ = (tbase) - 2 + (lane >> 3) + 8 * i; \
            xpre[i] = make_uint4(0u, 0u, 0u, 0u); \
            if (tt_ >= seq_lo && tt_ < seq_hi) xpre[i] = *(const uint4*)(XR + (size_t)tt_ * 512 + w * 64 + (lane & 7) * 8); } } while (0)
    for (int ib = 0; ib < 4; ++ib) {
        const int t0 = g0 + ib * 32;
        LRUF_LOAD_X(t0);
        WAVE_LDS_FENCE();
#pragma unroll
        for (int i = 0; i < 5; ++i) {
            const int rowi = (lane >> 3) + 8 * i;
            uint2* d = (uint2*)(xt + rowi * 68 + (lane & 7) * 8);
            d[0] = make_uint2(xpre[i].x, xpre[i].y); d[1] = make_uint2(xpre[i].z, xpre[i].w);
        }
        WAVE_LDS_FENCE();
        float xcv[4][8];
#pragma unroll
        for (int ks = 0; ks < 4; ++ks)
#pragma unroll
            for (int grp = 0; grp < 2; ++grp) {
                const int cl = 16 * ks + 8 * grp + 4 * half;
                const int cb4 = w * 64 + cl;
                f32x4 a = *(const f32x4*)(p.conv_b + cb4);
#pragma unroll
                for (int j = 0; j < 4; ++j) {
                    const f32x4 xv = ld4bf(xt + (tl + j) * 68 + cl);
                    const f32x4 wv4 = *(const f32x4*)(p.conv_w + j * 512 + cb4);
                    a += wv4 * xv;
                }
#pragma unroll
                for (int q = 0; q < 4; ++q) xcv[ks][grp * 4 + q] = a[q];
            }
        bf16x8 xb[4];
#pragma unroll
        for (int ks = 0; ks < 4; ++ks) {
            uint4 pw;
            pw.x = pk2(xcv[ks][0], xcv[ks][1]); pw.y = pk2(xcv[ks][2], xcv[ks][3]);
            pw.z = pk2(xcv[ks][4], xcv[ks][5]); pw.w = pk2(xcv[ks][6], xcv[ks][7]);
            xb[ks] = __builtin_bit_cast(bf16x8, pw);
        }
        unsigned hfp[16];
        for (int dir = 0; dir < 2; ++dir) {
            WAVE_LDS_FENCE();
#pragma unroll
            for (int cb = 0; cb < 2; ++cb) {
                f32x16 aa, ax;
#pragma unroll
                for (int i = 0; i < 16; ++i) { aa[i] = 0.f; ax[i] = 0.f; }
#pragma unroll
                for (int ks = 0; ks < 4; ++ks) {
                    const bf16x8 wa = *(const bf16x8*)(LW + ((size_t)((((dir * 2 + 0) * 8 + w) * 2 + cb) * 4 + ks) * 64 + lane) * 8);
                    const bf16x8 wx = *(const bf16x8*)(LW + ((size_t)((((dir * 2 + 1) * 8 + w) * 2 + cb) * 4 + ks) * 64 + lane) * 8);
                    aa = __builtin_amdgcn_mfma_f32_32x32x16_bf16(wa, xb[ks], aa, 0, 0, 0);
                    ax = __builtin_amdgcn_mfma_f32_32x32x16_bf16(wx, xb[ks], ax, 0, 0, 0);
                }
#pragma unroll
                for (int r4 = 0; r4 < 4; ++r4) {
                    const int j0 = cb * 32 + 8 * r4 + 4 * half;
                    const int ch4 = w * 64 + j0;
                    const f32x4 ba4 = *(const f32x4*)(p.lru_ba + dir * 512 + ch4);
                    const f32x4 bx4 = *(const f32x4*)(p.lru_bx + dir * 512 + ch4);
                    const f32x4 ls4 = *(const f32x4*)(LS + dir * 512 + ch4);
                    f32x4 av, uv;
#pragma unroll
                    for (int q = 0; q < 4; ++q) {
                        const int r = 4 * r4 + q;
                        const float xcval = xcv[2 * cb + (r4 >> 1)][4 * (r4 & 1) + q];
                        const float rgate = sigmoidf_(aa[r] + ba4[q]);
                        const float igate = sigmoidf_(ax[r] + bx4[q]);
                        const float la = 8.f * rgate * ls4[q];
                        av[q] = fexp(la);
                        uv[q] = fsqrt(fmaxf(0.f, 1.f - av[q] * av[q])) * igate * xcval;
                    }
                    *(f32x4*)(abuf + tl * 68 + j0) = av;
                    *(f32x4*)(ubuf + tl * 68 + j0) = uv;
                }
            }
            WAVE_LDS_FENCE();
            if (dir == 0) {
#pragma unroll
                for (int t2 = 0; t2 < 16; ++t2) {
                    const float a0 = abuf[(2 * t2) * 68 + lane], u0 = ubuf[(2 * t2) * 68 + lane];
                    const float a1 = abuf[(2 * t2 + 1) * 68 + lane], u1 = ubuf[(2 * t2 + 1) * 68 + lane];
                    const float h0 = a0 * hF + u0;
                    hF = a1 * h0 + u1;
                    hfp[t2] = pk2(h0, hF);
                }
            } else {
                float hb = ib == 3 ? c3 : (ib == 2 ? c2 : (ib == 1 ? c1 : c0));
#pragma unroll
                for (int tt = 0; tt < 32; ++tt) {
                    const int tloc = 31 - tt;
                    const float a = abuf[tloc * 68 + lane], u = ubuf[tloc * 68 + lane];
                    hb = a * hb + u;
                    const float gg = bf1(GR[(size_t)(t0 + tloc) * 512 + chn]);
                    const float hfw = (tloc & 1) ? bfhi(hfp[tloc >> 1]) : bflo(hfp[tloc >> 1]);
                    abuf[tloc * 68 + lane] = gg * (hfw + hb);
                }
            }
        }
        WAVE_LDS_FENCE();
        float* sqb = ssq + (ib & 1) * 544;
        {
            float s = 0.f;
#pragma unroll
            for (int q = 0; q < 8; ++q) {
                const f32x4 v4 = *(const f32x4*)(abuf + tl * 68 + half * 32 + q * 4);
                s += v4[0] * v4[0] + v4[1] * v4[1] + v4[2] * v4[2] + v4[3] * v4[3];
            }
            sqb[(w * 2 + half) * 32 + tl] = s;
        }
        __syncthreads();
        {
            float sacc = 0.f;
#pragma unroll
            for (int q = 0; q < 16; ++q) sacc += sqb[q * 32 + tl];
            float* rsw = ssq + 1088 + w * 32;
            if (half == 0) rsw[tl] = frsq(sacc * (1.f / 512.f) + EPS);
            WAVE_LDS_FENCE();
#pragma unroll
            for (int tt = 0; tt < 32; ++tt)
                MRG[(size_t)(t0 + tt) * 1024 + 512 + chn] = (bf16_t)(pk2(abuf[tt * 68 + lane] * rsw[tt], 0.f) & 0xffff);
        }
    }
#undef LRUF_LOAD_X
}

__device__ __forceinline__ void score_unit(const P& p, char* shm, int unit, const int wv) {
    char* ws = p.ws;
    const int sp = unit & 15, tg = unit >> 4;
    const int tid = opaque_tid(wv), w = tid >> 6, lane = tid & 63, fr = lane & 15, fq = lane >> 4;
    bf16_t* KL = (bf16_t*)shm;
    const bf16_t* KEYS = (const bf16_t*)(ws + OFF_KEYS) + (size_t)sp * 16384;
    const bf16_t* QP = (const bf16_t*)(ws + OFF_QP);
    float* SUBS = (float*)(ws + OFF_SUBS);
    __syncthreads();
    for (int i = tid; i < 2048; i += NTHREADS) {
        const int r = i >> 4, cpart = i & 15;
        *(uint4*)(KL + r * 136 + cpart * 8) = *(const uint4*)(KEYS + r * 128 + cpart * 8);
    }
    __syncthreads();
    bf16x8 afn[4];
#pragma unroll
    for (int ks = 0; ks < 4; ++ks) afn[ks] = *(const bf16x8*)(QP + (size_t)((tg * 8) * 128 + w * 16 + fr) * 2048 + sp * 128 + ks * 32 + fq * 8);
    for (int tt = 0; tt < 8; ++tt) {
        const int gb = (tg * 8 + tt) * 128 + w * 16;
        bf16x8 af[4];
#pragma unroll
        for (int ks = 0; ks < 4; ++ks) af[ks] = afn[ks];
        if (tt < 7) {
#pragma unroll
            for (int ks = 0; ks < 4; ++ks) afn[ks] = *(const bf16x8*)(QP + (size_t)(gb + 128 + fr) * 2048 + sp * 128 + ks * 32 + fq * 8);
        }
        float v[4][8];
#pragma unroll
        for (int nb = 0; nb < 8; ++nb) {
            f32x4 acc = {0.f, 0.f, 0.f, 0.f};
#pragma unroll
            for (int ks = 0; ks < 4; ++ks) {
                const bf16x8 bf = *(const bf16x8*)(KL + (nb * 16 + fr) * 136 + ks * 32 + fq * 8);
                acc = __builtin_amdgcn_mfma_f32_16x16x32_bf16(af[ks], bf, acc, 0, 0, 0);
            }
#pragma unroll
            for (int i = 0; i < 4; ++i) v[i][nb] = __uint_as_float((__float_as_uint(acc[i]) & ~127u) | (unsigned)(nb * 16 + fr));
        }
#define CE_(a, b) do { const float hi_ = fmaxf(v[i][a], v[i][b]); const float lo_ = fminf(v[i][a], v[i][b]); v[i][a] = hi_; v[i][b] = lo_; } while (0)
#pragma unroll
        for (int i = 0; i < 4; ++i) {
            CE_(0, 1); CE_(2, 3); CE_(4, 5); CE_(6, 7);
            CE_(0, 2); CE_(1, 3); CE_(4, 6); CE_(5, 7);
            CE_(1, 2); CE_(5, 6);
            CE_(0, 4); CE_(1, 5); CE_(2, 6); CE_(3, 7);
            CE_(2, 4); CE_(3, 5);
            CE_(1, 2); CE_(3, 4); CE_(5, 6);
        }
#undef CE_
        float keep[4] = {0.f, 0.f, 0.f, 0.f};
        for (int r = 0; r < 16; ++r) {
#pragma unroll
            for (int i = 0; i < 4; ++i) {
                const float rm = row_max16(v[i][0]);
                keep[i] = (fr == r) ? rm : keep[i];
                const bool win = v[i][0] == rm;
#pragma unroll
                for (int nb = 0; nb < 7; ++nb) v[i][nb] = win ? v[i][nb + 1] : v[i][nb];
                v[i][7] = win ? -INFINITY : v[i][7];
            }
        }
#pragma unroll
        for (int i = 0; i < 4; ++i) SUBS[(size_t)(gb + 4 * fq + i) * 256 + sp * 16 + fr] = keep[i];
    }
}

__device__ __forceinline__ void phase_stage2(const P& p, const int wv) {
    char* ws = p.ws;
    const float* SUBS = (const float*)(ws + OFF_SUBS);
    int* PIDX = (int*)(ws + OFF_PIDX);
    float* PS = (float*)(ws + OFF_PS);
    const int gtid = blockIdx.x * NTHREADS + opaque_tid(wv), gstride = gridDim.x * NTHREADS;
    for (int idx = gtid; idx < NT * 8; idx += gstride) {
        const int tok = idx >> 3, hh = idx & 7;
        const float* s0p = SUBS + (size_t)tok * 256 + hh * 32;
        const float* s1p = s0p + 16;
        float s0[16], s1[16];
#pragma unroll
        for (int i = 0; i < 4; ++i) {
            const f32x4 a = *(const f32x4*)(s0p + 4 * i), b = *(const f32x4*)(s1p + 4 * i);
#pragma unroll
            for (int q = 0; q < 4; ++q) { s0[4 * i + q] = a[q]; s1[4 * i + q] = b[q]; }
        }
        float L[16];
#pragma unroll
        for (int i = 0; i < 16; ++i) L[i] = -INFINITY;
#pragma unroll
        for (int a = 0; a < 16; ++a)
#pragma unroll
            for (int b = 0; b < 16; ++b) {
                if ((a + 1) * (b + 1) <= 16) {
                    float nv = __uint_as_float((__float_as_uint(s0[a] + s1[b]) & ~255u) | (unsigned)(a * 16 + b));
#pragma unroll
                    for (int i = 0; i < 16; ++i) {
                        const float hi = fmaxf(L[i], nv);
                        nv = fminf(L[i], nv);
                        L[i] = hi;
                    }
                }
            }
        int ids[16];
#pragma unroll
        for (int k = 0; k < 16; ++k) {
            const unsigned code = __float_as_uint(L[k]) & 255u;
            const unsigned i0 = __float_as_uint(s0p[code >> 4]) & 127u;
            const unsigned i1 = __float_as_uint(s1p[code & 15]) & 127u;
            ids[k] = (int)(i0 * 128 + i1);
        }
        int* pi = PIDX + (size_t)tok * 128;
        f32x4* pf = (f32x4*)(PS + (size_t)tok * 128 + hh * 16);
#pragma unroll
        for (int k = 0; k < 16; ++k) pi[k * 8 + hh] = ids[k];
#pragma unroll
        for (int i = 0; i < 4; ++i) pf[i] = f32x4{L[4 * i], L[4 * i + 1], L[4 * i + 2], L[4 * i + 3]};
    }
}

__device__ __forceinline__ void unpack8(const uint4 w, float* f) {
    f[0] = bflo(w.x); f[1] = bfhi(w.x); f[2] = bflo(w.y); f[3] = bfhi(w.y);
    f[4] = bflo(w.z); f[5] = bfhi(w.z); f[6] = bflo(w.w); f[7] = bfhi(w.w);
}
__device__ __forceinline__ unsigned xcc_id() { return (unsigned)__builtin_amdgcn_s_getreg((3 << 11) | 20) & 0xFu; }
__device__ __forceinline__ float dpp_ror8(float v) {
    return __int_as_float(__builtin_amdgcn_update_dpp(0, __float_as_int(v), 0x128, 0xf, 0xf, true));
}
__device__ __forceinline__ float swz_x4(float v) { return __int_as_float(__builtin_amdgcn_ds_swizzle(__float_as_int(v), 0x101F)); }
__device__ __forceinline__ float swz_x16(float v) { return __int_as_float(__builtin_amdgcn_ds_swizzle(__float_as_int(v), 0x401F)); }

__device__ __forceinline__ void gather_item_a(const P& p, const int s, const int chunk, const int w, const int lane) {
    char* ws = p.ws;
    const bf16_t* H1B = (const bf16_t*)(ws + OFF_H1B);
    const int* PIDX = (const int*)(ws + OFF_PIDX);
    bf16_t* PART = (bf16_t*)(ws + OFF_PART);
    const int i8 = lane & 7, gq = lane >> 3;
    const unsigned char* UT = (const unsigned char*)(ws + OFF_UT) + (size_t)s * (16384 * 128) + i8 * 16;
    const bool b0 = (lane & 1) != 0, b1 = (lane & 2) != 0, b2 = (lane & 4) != 0;
    const int tok0 = chunk * 64 + w * 8;
    int4 idA[4], idB[4];
    uint4 UU[2][8], XQ[2][2];
#define LD_IDS(di, tk) do { const int4* ip_ = (const int4*)(PIDX + (size_t)(tk) * 128 + gq * 16); \
        _Pragma("unroll") for (int q_ = 0; q_ < 4; ++q_) di[q_] = ip_[q_]; } while (0)
#define LD_X(buf, tk) do { const uint4* hp_ = (const uint4*)(H1B + (size_t)(tk) * 1024 + s * 128 + i8 * 16); XQ[buf][0] = hp_[0]; XQ[buf][1] = hp_[1]; } while (0)
#define LD_U(buf, ia, ib) do { const int e_[8] = {ia.x, ia.y, ia.z, ia.w, ib.x, ib.y, ib.z, ib.w}; \
        _Pragma("unroll") for (int g_ = 0; g_ < 8; ++g_) UU[buf][g_] = *(const uint4*)(UT + ((size_t)e_[g_] << 7)); } while (0)
    LD_IDS(idA, tok0);
    LD_X(0, tok0);
    LD_U(0, idA[0], idA[1]);
    LD_IDS(idB, tok0 + 1);
#pragma unroll
    for (int j = 0; j < 8; ++j) {
        const int tok = tok0 + j;
        LD_U(1, idA[2], idA[3]);
        if (j < 7) LD_X((j + 1) & 1, tok + 1);
        __builtin_amdgcn_sched_barrier(0);
        float xs[16];
        unpack8(XQ[j & 1][0], xs); unpack8(XQ[j & 1][1], xs + 8);
        float d[16];
#pragma unroll
        for (int hf = 0; hf < 2; ++hf) {
            if (hf == 1) {
                if (j < 7) LD_U(0, idB[0], idB[1]);
                __builtin_amdgcn_sched_barrier(0);
            }
#pragma unroll
            for (int g = 0; g < 8; ++g) {
                const uint4 u4 = UU[hf][g];
                const unsigned wd[4] = {u4.x, u4.y, u4.z, u4.w};
                f32x2 d2 = {0.f, 0.f}, d3 = {0.f, 0.f};
#pragma unroll
                for (int q = 0; q < 4; ++q) {
                    const f32x2 lo = __builtin_amdgcn_cvt_pk_f32_fp8((int)wd[q], false);
                    const f32x2 hi = __builtin_amdgcn_cvt_pk_f32_fp8((int)wd[q], true);
                    const f32x2 xlo = {xs[q * 4 + 0], xs[q * 4 + 1]};
                    const f32x2 xhi = {xs[q * 4 + 2], xs[q * 4 + 3]};
                    d2 = lo * xlo + d2;
                    d3 = hi * xhi + d3;
                }
                d[hf * 8 + g] = (d2.x + d2.y) + (d3.x + d3.y);
            }
        }
        float t8[8], t4[4], t2[2];
#pragma unroll
        for (int q = 0; q < 8; ++q) {
            const float keep = b0 ? d[8 + q] : d[q], send = b0 ? d[q] : d[8 + q];
            t8[q] = keep + dppf(send, 0);
        }
#pragma unroll
        for (int q = 0; q < 4; ++q) {
            const float keep = b1 ? t8[4 + q] : t8[q], send = b1 ? t8[q] : t8[4 + q];
            t4[q] = keep + dppf(send, 1);
        }
#pragma unroll
        for (int q = 0; q < 2; ++q) {
            const float keep = b2 ? t4[2 + q] : t4[q], send = b2 ? t4[q] : t4[2 + q];
            t2[q] = keep + swz_x4(send);
        }
        const int itb = (b0 ? 8 : 0) + (b1 ? 4 : 0) + (b2 ? 2 : 0);
        *(unsigned*)(PART + ((size_t)tok * 8 + s) * 128 + gq * 16 + itb) = pk2(t2[0], t2[1]);
        if (j < 7) {
#pragma unroll
            for (int q = 0; q < 4; ++q) idA[q] = idB[q];
        }
        if (j < 6) LD_IDS(idB, tok + 2);
    }
#undef LD_IDS
#undef LD_X
#undef LD_U
}

__device__ __forceinline__ void gather_item_b(const P& p, const int s, const int chunk, const int w, const int lane) {
    char* ws = p.ws;
    const bf16_t* H1B = (const bf16_t*)(ws + OFF_H1B);
    const int* PIDX = (const int*)(ws + OFF_PIDX);
    const float* WGT = (const float*)(ws + OFF_WGT);
    bf16_t* H2B = (bf16_t*)(ws + OFF_H2B);
    float* SSQ3 = (float*)(ws + OFF_SSQ3);
    const int i8 = lane & 7, gq = lane >> 3;
    const unsigned char* VT = (const unsigned char*)(ws + OFF_VT) + (size_t)s * (16384 * 128) + i8 * 16;
    const bool b5 = (lane & 32) != 0, b4 = (lane & 16) != 0, b3 = (lane & 8) != 0;
    const int dloc = s * 128 + i8 * 16 + (b5 ? 8 : 0) + (b4 ? 4 : 0) + (b3 ? 2 : 0);
    const int tok0 = chunk * 64 + w * 8;
    int4 idA[4], idB[4];
    f32x4 wgA[4], wgB[4];
    uint4 VV[2][8];
#define LD_IW(di, dw, tk) do { const int4* ip_ = (const int4*)(PIDX + (size_t)(tk) * 128 + gq * 16); const f32x4* wp_ = (const f32x4*)(WGT + (size_t)(tk) * 128 + gq * 16); \
        _Pragma("unroll") for (int q_ = 0; q_ < 4; ++q_) { di[q_] = ip_[q_]; dw[q_] = wp_[q_]; } } while (0)
#define LD_V(buf, ia, ib) do { const int e_[8] = {ia.x, ia.y, ia.z, ia.w, ib.x, ib.y, ib.z, ib.w}; \
        _Pragma("unroll") for (int g_ = 0; g_ < 8; ++g_) VV[buf][g_] = *(const uint4*)(VT + ((size_t)e_[g_] << 7)); } while (0)
    LD_IW(idA, wgA, tok0);
    LD_V(0, idA[0], idA[1]);
    LD_IW(idB, wgB, tok0 + 1);
#pragma unroll
    for (int j = 0; j < 8; ++j) {
        const int tok = tok0 + j;
        LD_V(1, idA[2], idA[3]);
        const unsigned hw = *(const unsigned*)(H1B + (size_t)tok * 1024 + dloc);
        __builtin_amdgcn_sched_barrier(0);
        f32x2 acc[8];
#pragma unroll
        for (int q = 0; q < 8; ++q) acc[q] = f32x2{0.f, 0.f};
#pragma unroll
        for (int hf = 0; hf < 2; ++hf) {
            if (hf == 1) {
                if (j < 7) LD_V(0, idB[0], idB[1]);
                __builtin_amdgcn_sched_barrier(0);
            }
#pragma unroll
            for (int g = 0; g < 8; ++g) {
                const uint4 v4 = VV[hf][g];
                const unsigned wd[4] = {v4.x, v4.y, v4.z, v4.w};
                const float wsc = wgA[hf * 2 + (g >> 2)][g & 3];
                const f32x2 w2 = {wsc, wsc};
#pragma unroll
                for (int q = 0; q < 4; ++q) {
                    const f32x2 lo = __builtin_amdgcn_cvt_pk_f32_fp8((int)wd[q], false);
                    const f32x2 hi = __builtin_amdgcn_cvt_pk_f32_fp8((int)wd[q], true);
                    acc[2 * q] = lo * w2 + acc[2 * q];
                    acc[2 * q + 1] = hi * w2 + acc[2 * q + 1];
                }
            }
        }
        float a16[16];
#pragma unroll
        for (int q = 0; q < 8; ++q) { a16[2 * q] = acc[q].x; a16[2 * q + 1] = acc[q].y; }
        float t8[8], t4[4], t2[2];
#pragma unroll
        for (int q = 0; q < 8; ++q) {
            const float keep = b5 ? a16[8 + q] : a16[q], send = b5 ? a16[q] : a16[8 + q];
            t8[q] = keep + xor32(send, lane);
        }
#pragma unroll
        for (int q = 0; q < 4; ++q) {
            const float keep = b4 ? t8[4 + q] : t8[q], send = b4 ? t8[q] : t8[4 + q];
            t4[q] = keep + swz_x16(send);
        }
#pragma unroll
        for (int q = 0; q < 2; ++q) {
            const float keep = b3 ? t4[2 + q] : t4[q], send = b3 ? t4[q] : t4[2 + q];
            t2[q] = keep + dpp_ror8(send);
        }
        const float o0 = bflo(hw) + t2[0], o1 = bfhi(hw) + t2[1];
        *(unsigned*)(H2B + (size_t)tok * 1024 + dloc) = pk2(o0, o1);
        const float sq = wave_sum(o0 * o0 + o1 * o1);
        if (lane == 0) SSQ3[(size_t)tok * 8 + s] = sq;
        if (j < 7) {
#pragma unroll
            for (int q = 0; q < 4; ++q) { idA[q] = idB[q]; wgA[q] = wgB[q]; }
        }
        if (j < 6) LD_IW(idB, wgB, tok + 2);
    }
#undef LD_IW
#undef LD_V
}

template <int PASS>
__device__ __forceinline__ void phase_gather_sliced(const P& p, char* shm, const int wv) {
    const int tid = opaque_tid(wv), w = wv, lane = tid & 63;
    unsigned* q = (unsigned*)(p.ws + OFF_CTL) + 16 + PASS * 8;
    volatile int* sh = (volatile int*)(shm + 139392);
    const int home = (int)(xcc_id() & 7u);
    constexpr int NCH = NT / 64;
    for (int k = 0; k < 8; ++k) {
        const int s = (home + k) & 7;
        __syncthreads();
        if (tid == 0) sh[0] = (int)__hip_atomic_fetch_add(q + s, 1u, __ATOMIC_RELAXED, __HIP_MEMORY_SCOPE_AGENT);
        __syncthreads();
        int cur = sh[0];
        while (cur < NCH) {
            __syncthreads();
            if (tid == 0) sh[0] = (int)__hip_atomic_fetch_add(q + s, 1u, __ATOMIC_RELAXED, __HIP_MEMORY_SCOPE_AGENT);
            if (PASS == 0) gather_item_a(p, s, cur, w, lane); else gather_item_b(p, s, cur, w, lane);
            __syncthreads();
            cur = sh[0];
        }
    }
}

__device__ __forceinline__ void phase_gather_mid(const P& p, const int wv) {
    char* ws = p.ws;
    const int tid = opaque_tid(wv), w = wv, lane = tid & 63;
    const int gw = blockIdx.x * 8 + w, nw = gridDim.x * 8;
    const bf16_t* H1B = (const bf16_t*)(ws + OFF_H1B);
    const bf16_t* PART = (const bf16_t*)(ws + OFF_PART);
    const float* PS = (const float*)(ws + OFF_PS);
    float* WGT = (float*)(ws + OFF_WGT);
    for (int tok = gw; tok < NT; tok += nw) {
        const uint4* hp = (const uint4*)(H1B + (size_t)tok * 1024);
        float xf[16];
        unpack8(hp[lane], xf); unpack8(hp[64 + lane], xf + 8);
        float s = 0.f;
#pragma unroll
        for (int i = 0; i < 16; ++i) s += xf[i] * xf[i];
        s = wave_sum(s);
        const float rs2 = frsq(s * (1.f / 1024.f) + EPS);
        float wout[2];
        int pos[2];
#pragma unroll
        for (int hsel = 0; hsel < 2; ++hsel) {
            const int e = lane + 64 * hsel;
            const int ppos = (e & 15) * 8 + (e >> 4);
            float d = 0.f;
#pragma unroll
            for (int sl = 0; sl < 8; ++sl) d += bf1(PART[((size_t)tok * 8 + sl) * 128 + ppos]);
            const float sc = PS[(size_t)tok * 128 + e] * rs2;
            const float m = row_max16(sc);
            const float pe = fexp(sc - m);
            const float g = pe * frcp(row_sum16(pe));
            wout[hsel] = g * gelu_tanh(d * rs2 * (1.f / 64.f)) * 0.125f;
            pos[hsel] = ppos;
        }
        WGT[(size_t)tok * 128 + pos[0]] = wout[0];
        WGT[(size_t)tok * 128 + pos[1]] = wout[1];
    }
}

__global__ void __launch_bounds__(NTHREADS, 2) mega(P p) {
    extern __shared__ __attribute__((aligned(1024))) char shm[];
    cg::grid_group grid = cg::this_grid();
    char* ws = p.ws;
    const int wv = __builtin_amdgcn_readfirstlane((int)(threadIdx.x >> 6));
    const int w = wv;
    const int gw = blockIdx.x * 8 + w, nw = gridDim.x * 8;
    unsigned* bar_cnt = (unsigned*)(ws + OFF_CTL);

    phase_prep(p, wv);
    asm volatile("s_waitcnt vmcnt(0)" ::: "memory");
    __syncthreads();
    grid.sync();
    phase_inproj(p, shm, wv);
    grid_bar(bar_cnt, (unsigned)(1 * gridDim.x), wv);
    for (int rp = 0; rp < REP_MIX; ++rp)
    for (int u = blockIdx.x; u < 1536 + 768; u += gridDim.x) {
        if (u < 1536) attn_unit(p, shm, u, wv); else lru_agg_unit(p, shm, u - 1536, wv);
    }
    grid_bar(bar_cnt, (unsigned)(2 * gridDim.x), wv);
    for (int rp = 0; rp < REP_MIX; ++rp)
    for (int u = blockIdx.x; u < 768; u += gridDim.x) lru_final_unit(p, shm, u, wv);
    {
        const bf16_t* AT = (const bf16_t*)(ws + OFF_AT);
        bf16_t* MRG = (bf16_t*)(ws + OFF_MRG);
        const int lane = opaque_tid(wv) & 63;
        for (int tok = gw; tok < NT; tok += nw) {
            const uint4 a = ((const uint4*)(AT + (size_t)tok * 512))[lane];
            float f[8];
            unpack8(a, f);
            float s = 0.f;
#pragma unroll
            for (int i = 0; i < 8; ++i) s += f[i] * f[i];
            s = wave_sum(s);
            const float rs = frsq(s * (1.f / 512.f) + EPS);
            uint4 o;
            o.x = pk2(f[0] * rs, f[1] * rs); o.y = pk2(f[2] * rs, f[3] * rs); o.z = pk2(f[4] * rs, f[5] * rs); o.w = pk2(f[6] * rs, f[7] * rs);
            ((uint4*)(MRG + (size_t)tok * 1024))[lane] = o;
        }
    }
    grid_bar(bar_cnt, (unsigned)(3 * gridDim.x), wv);
    {
        const bf16_t* MRG = (const bf16_t*)(ws + OFF_MRG);
        const bf16_t* W = (const bf16_t*)(ws + OFF_WOUT);
        bf16_t* H1B = (bf16_t*)(ws + OFF_H1B);
        const bf16_t* XB = (const bf16_t*)(ws + OFF_XB);
        auto ld = [=](int row, int col) { return *(const uint4*)(XB + (size_t)row * 1024 + col); };
        auto epi = [=](int row, int col, f32x4 v0, f32x4 v1, uint4 xw) {
            f32x4 x0, x1;
            x0[0] = bflo(xw.x); x0[1] = bfhi(xw.x); x0[2] = bflo(xw.y); x0[3] = bfhi(xw.y);
            x1[0] = bflo(xw.z); x1[1] = bfhi(xw.z); x1[2] = bflo(xw.w); x1[3] = bfhi(xw.w);
            st8bf(H1B + (size_t)row * 1024 + col, v0 + x0, v1 + x1);
        };
        gemm_run<1>(MRG, W, 1024, 1024, shm, wv, ld, epi);
    }
    grid_bar(bar_cnt, (unsigned)(4 * gridDim.x), wv);
    {
        const bf16_t* H1B = (const bf16_t*)(ws + OFF_H1B);
        const bf16_t* W = (const bf16_t*)(ws + OFF_WQ);
        bf16_t* QP = (bf16_t*)(ws + OFF_QP);
        auto ld = [=](int row, int col) { return 0; };
        auto epi = [=](int row, int col, f32x4 v0, f32x4 v1, int) {
            st8bf(QP + (size_t)row * 2048 + col, v0, v1);
        };
        gemm_run<1>(H1B, W, 2048, 1024, shm, wv, ld, epi);
    }
    grid_bar(bar_cnt, (unsigned)(5 * gridDim.x), wv);
    for (int rp = 0; rp < REP_PEER; ++rp)
    for (int u = blockIdx.x; u < 1536; u += gridDim.x) score_unit(p, shm, u, wv);
    grid_bar(bar_cnt, (unsigned)(6 * gridDim.x), wv);
    phase_stage2(p, wv);
    grid_bar(bar_cnt, (unsigned)(7 * gridDim.x), wv);
    phase_gather_sliced<0>(p, shm, wv);
    grid_bar(bar_cnt, (unsigned)(8 * gridDim.x), wv);
    phase_gather_mid(p, wv);
    grid_bar(bar_cnt, (unsigned)(9 * gridDim.x), wv);
    phase_gather_sliced<1>(p, shm, wv);
    grid_bar(bar_cnt, (unsigned)(10 * gridDim.x), wv);
    {
        const bf16_t* H2B = (const bf16_t*)(ws + OFF_H2B);
        const bf16_t* WG = (const bf16_t*)(ws + OFF_WG);
        const bf16_t* PB = (const bf16_t*)(ws + OFF_PB);
        const bf16_t* WP = (const bf16_t*)(ws + OFF_WP);
        const float* SSQ3 = (const float*)(ws + OFF_SSQ3);
        bf16_t* G = (bf16_t*)(ws + OFF_G);
        bf16_t* H3 = (bf16_t*)(ws + OFF_H3);
        auto ld_g = [=](int row, int col) { return 0; };
        auto epi_g = [=](int row, int col, f32x4 v0, f32x4 v1, int) {
            pg8::Pre2x4 sp; sp.a = *(const f32x4*)(SSQ3 + (size_t)row * 8); sp.b = *(const f32x4*)(SSQ3 + (size_t)row * 8 + 4);
            const float ssq = ((sp.a[0] + sp.a[1]) + (sp.a[2] + sp.a[3])) + ((sp.b[0] + sp.b[1]) + (sp.b[2] + sp.b[3]));
            const float rs = frsq(ssq * (1.f / 1024.f) + EPS);
            f32x4 a, b;
#pragma unroll
            for (int j = 0; j < 4; ++j) { a[j] = sigmoidf_(v0[j] * rs); b[j] = sigmoidf_(v1[j] * rs); }
            st8bf(G + (size_t)row * 1024 + col, a, b);
        };
        auto ld_p = [=](int row, int col) {
            const size_t off = (size_t)row * 1024 + col;
            pg8::Pre2u4 r; r.a = *(const uint4*)(G + off); r.b = *(const uint4*)(H2B + off);
            return r;
        };
        auto epi_p = [=](int row, int col, f32x4 v0, f32x4 v1, pg8::Pre2u4 pr) {
            const size_t off = (size_t)row * 1024 + col;
            f32x4 g0, g1, h0, h1;
            g0[0] = bflo(pr.a.x); g0[1] = bfhi(pr.a.x); g0[2] = bflo(pr.a.y); g0[3] = bfhi(pr.a.y);
            g1[0] = bflo(pr.a.z); g1[1] = bfhi(pr.a.z); g1[2] = bflo(pr.a.w); g1[3] = bfhi(pr.a.w);
            h0[0] = bflo(pr.b.x); h0[1] = bfhi(pr.b.x); h0[2] = bflo(pr.b.y); h0[3] = bfhi(pr.b.y);
            h1[0] = bflo(pr.b.z); h1[1] = bfhi(pr.b.z); h1[2] = bflo(pr.b.w); h1[3] = bfhi(pr.b.w);
            st8bf(H3 + off, h0 + g0 * v0, h1 + g1 * v1);
        };
        gemm_run<1>(H2B, WG, 1024, 1024, shm, wv, ld_g, epi_g);
        gemm_run<2>(PB, WP, 1024, 256, shm, wv, ld_p, epi_p);
    }
    grid_bar(bar_cnt, (unsigned)(11 * gridDim.x), wv);
    {
        const bf16_t* H3 = (const bf16_t*)(ws + OFF_H3);
        const int lane = opaque_tid(wv) & 63;
        for (int tok = gw; tok < NT; tok += nw) {
            const uint2* hp = (const uint2*)(H3 + (size_t)tok * 1024);
            float f[16];
            float s = 0.f;
#pragma unroll
            for (int j = 0; j < 4; ++j) {
                const uint2 a = hp[lane + 64 * j];
                f[4 * j] = bflo(a.x); f[4 * j + 1] = bfhi(a.x); f[4 * j + 2] = bflo(a.y); f[4 * j + 3] = bfhi(a.y);
            }
#pragma unroll
            for (int i = 0; i < 16; ++i) s += f[i] * f[i];
            s = wave_sum(s);
            const float rs = frsq(s * (1.f / 1024.f) + EPS);
            float4* op = (float4*)(p.out + (size_t)tok * 1024);
#pragma unroll
            for (int j = 0; j < 4; ++j) {
                const float4 g = ((const float4*)p.fin_g)[lane + 64 * j];
                float4 o;
                o.x = f[4 * j] * rs * g.x; o.y = f[4 * j + 1] * rs * g.y; o.z = f[4 * j + 2] * rs * g.z; o.w = f[4 * j + 3] * rs * g.w;
                op[lane + 64 * j] = o;
            }
        }
    }
}

extern "C" void kernel_launch(void* const* d_in, const int* in_sizes, int n_in, void* d_out, int out_size, void* d_ws, size_t ws_size,
                              hipStream_t stream) {
    static int grid = 0;
    if (grid == 0) {
        if (n_in != 26 || ws_size < WS_END) {
            fprintf(stderr, "kernel_launch: unexpected n_in %d or ws_size %zu (< %zu)\n", n_in, ws_size, (size_t)WS_END);
            grid = -1;
            return;
        }
        int dev = 0, cus = 0, per_cu = 0;
        hipGetDevice(&dev);
        hipDeviceGetAttribute(&cus, hipDeviceAttributeMultiprocessorCount, dev);
        hipFuncSetAttribute((const void*)mega, hipFuncAttributeMaxDynamicSharedMemorySize, LDS_BYTES);
        hipOccupancyMaxActiveBlocksPerMultiprocessor(&per_cu, (const void*)mega, NTHREADS, LDS_BYTES);
        if (per_cu < 1) { fprintf(stderr, "kernel_launch: occupancy query says %d blocks/CU\n", per_cu); per_cu = 1; }
        grid = cus * 1;
        (void)hipGetLastError();
    }
    if (grid < 0) return;
    if (hipMemsetAsync((char*)d_ws + OFF_CTL, 0, 256, stream) != hipSuccess) fprintf(stderr, "kernel_launch: memset failed\n");
    P p{};
    const float** pp = (const float**)&p;
    for (int i = 0; i < 26; ++i) pp[i] = (const float*)d_in[i];
    p.out = (float*)d_out;
    p.ws = (char*)d_ws;
    void* args[] = {&p};
    hipError_t e = hipLaunchCooperativeKernel((const void*)mega, dim3(grid), dim3(NTHREADS), args, LDS_BYTES, stream);
    if (e != hipSuccess) fprintf(stderr, "cooperative launch failed: %s (grid %d)\n", hipGetErrorString(e), grid);
}
```

```cpp
#include <hip/hip_runtime.h>
#include <hip/hip_cooperative_groups.h>
#include <cstdio>
#include <cstdint>
namespace cg = cooperative_groups;

typedef unsigned short bf16_t;
typedef __bf16 bf16x8 __attribute__((ext_vector_type(8)));
typedef __bf16 bf16x2v __attribute__((ext_vector_type(2)));
typedef float f32x4 __attribute__((ext_vector_type(4)));
typedef float f32x16 __attribute__((ext_vector_type(16)));
typedef float f32x2 __attribute__((ext_vector_type(2)));

constexpr int NT = 98304;
constexpr int NTP = 65536;
constexpr float EPS = 1e-6f;
constexpr int LDS_BYTES = 147456;
constexpr int NTHREADS = 512;
#define REP_GEMM 1
#define REP_MIX 1
#define REP_PEER 1

constexpr size_t MiB = 1ull << 20;
constexpr size_t OFF_R0 = 0;
constexpr size_t OFF_R1 = 192 * MiB;
constexpr size_t OFF_R2 = 576 * MiB;
constexpr size_t OFF_R3 = 768 * MiB;
constexpr size_t OFF_WIN = OFF_R3;
constexpr size_t OFF_WOUT = OFF_WIN + 1792ull * 1024 * 2;
constexpr size_t OFF_WQ = OFF_WOUT + 1024ull * 1024 * 2;
constexpr size_t OFF_WG = OFF_WQ + 2048ull * 1024 * 2;
constexpr size_t OFF_WP = OFF_WG + 1024ull * 1024 * 2;
constexpr size_t OFF_KEYS = OFF_WP + 1024ull * 256 * 2;
constexpr size_t OFF_UT = OFF_KEYS + 16ull * 128 * 128 * 2;
constexpr size_t OFF_VT = OFF_UT + 16384ull * 1024 * 2;
constexpr size_t OFF_LW = OFF_VT + 16384ull * 1024 * 2;
constexpr size_t OFF_LS = OFF_LW + 2ull * 2 * 8 * 64 * 64 * 2;
constexpr size_t OFF_PB = OFF_LS + 4096;
constexpr size_t OFF_RS1 = OFF_PB + (size_t)NT * 256 * 2;
constexpr size_t OFF_RS3 = OFF_RS1 + (size_t)NT * 4;
constexpr size_t OFF_AGG = OFF_RS3 + (size_t)NT * 4;
constexpr size_t OFF_SSQ3 = OFF_AGG + 768ull * 2 * 1024 * 4;
constexpr size_t OFF_CTL = OFF_SSQ3 + (size_t)NT * 8 * 4;
constexpr size_t OFF_AGGB = OFF_CTL + 256;
constexpr size_t WS_END = OFF_AGGB + 768ull * 4 * 2 * 512 * 4;
constexpr size_t OFF_XR = OFF_R1;
constexpr size_t OFF_GR = OFF_R1 + 96 * MiB;
constexpr size_t OFF_Q = OFF_R1 + 192 * MiB;
constexpr size_t OFF_KB = OFF_R1 + 288 * MiB;
constexpr size_t OFF_VB = OFF_R1 + 312 * MiB;
constexpr size_t OFF_QP = OFF_R1;
constexpr size_t OFF_H2B = OFF_R1;
constexpr size_t OFF_G = OFF_R1 + 192 * MiB;
constexpr size_t OFF_PART = OFF_R1 + 192 * MiB;
constexpr size_t OFF_AT = OFF_R2;
constexpr size_t OFF_HF = OFF_R2 + 96 * MiB;
constexpr size_t OFF_H1B = OFF_R2;
constexpr size_t OFF_XB = OFF_R0;
constexpr size_t OFF_MRG = OFF_R1 + 192 * MiB;
constexpr size_t OFF_SUBS = OFF_R0;
constexpr size_t OFF_WGT = OFF_R0;
constexpr size_t OFF_PIDX = OFF_R0 + 96 * MiB;
constexpr size_t OFF_PS = OFF_R0 + 144 * MiB;
constexpr size_t OFF_H3 = OFF_R0;

struct P {
    const float *x_p, *x_s, *p_p, *p_s, *mix_g, *w_in, *sink, *conv_w, *conv_b, *lru_wa, *lru_ba, *lru_wx, *lru_bx, *lru_lam,
        *attn_g, *lru_g, *w_out, *ffn_g, *peer_wq, *peer_keys, *peer_u, *peer_v, *ple_g, *ple_wg, *ple_wp, *fin_g;
    float* out;
    char* ws;
};

__device__ __forceinline__ int opaque_tid(int wv) { unsigned z = 0; asm volatile("" : "+v"(z)); int l = __builtin_amdgcn_mbcnt_hi(~0u, __builtin_amdgcn_mbcnt_lo(~0u, z)); return wv * 64 + l; }
__device__ __forceinline__ unsigned pk2(float lo, float hi) {
    unsigned r;
    asm("v_cvt_pk_bf16_f32 %0, %1, %2" : "=v"(r) : "v"(lo), "v"(hi));
    return r;
}
__device__ __forceinline__ float bflo(unsigned w) { return __uint_as_float(w << 16); }
__device__ __forceinline__ float bfhi(unsigned w) { return __uint_as_float(w & 0xffff0000u); }
__device__ __forceinline__ float bf1(bf16_t h) { return __uint_as_float((unsigned)h << 16); }
__device__ __forceinline__ void st4bf(bf16_t* dst, f32x4 v) {
    uint2 o; o.x = pk2(v[0], v[1]); o.y = pk2(v[2], v[3]);
    *(uint2*)dst = o;
}
__device__ __forceinline__ void st8bf(bf16_t* dst, f32x4 a, f32x4 b) {
    uint4 o; o.x = pk2(a[0], a[1]); o.y = pk2(a[2], a[3]); o.z = pk2(b[0], b[1]); o.w = pk2(b[2], b[3]);
    *(uint4*)dst = o;
}
__device__ __forceinline__ void ld8bf(const bf16_t* src, f32x4& a, f32x4& b) {
    const uint4 o = *(const uint4*)src;
    a[0] = bflo(o.x); a[1] = bfhi(o.x); a[2] = bflo(o.y); a[3] = bfhi(o.y);
    b[0] = bflo(o.z); b[1] = bfhi(o.z); b[2] = bflo(o.w); b[3] = bfhi(o.w);
}
__device__ __forceinline__ f32x4 ld4bf(const bf16_t* src) {
    uint2 o = *(const uint2*)src;
    f32x4 v; v[0] = bflo(o.x); v[1] = bfhi(o.x); v[2] = bflo(o.y); v[3] = bfhi(o.y);
    return v;
}
__device__ __forceinline__ float dppf(float v, const int ctrl_sel) {
    int t = 0;
    if (ctrl_sel == 0) t = __builtin_amdgcn_update_dpp(0, __float_as_int(v), 0xB1, 0xf, 0xf, true);
    else if (ctrl_sel == 1) t = __builtin_amdgcn_update_dpp(0, __float_as_int(v), 0x4E, 0xf, 0xf, true);
    else if (ctrl_sel == 2) t = __builtin_amdgcn_update_dpp(0, __float_as_int(v), 0x141, 0xf, 0xf, true);
    else t = __builtin_amdgcn_update_dpp(0, __float_as_int(v), 0x140, 0xf, 0xf, true);
    return __int_as_float(t);
}
__device__ __forceinline__ float row_max16(float v) {
    v = fmaxf(v, dppf(v, 0)); v = fmaxf(v, dppf(v, 1)); v = fmaxf(v, dppf(v, 2)); v = fmaxf(v, dppf(v, 3));
    return v;
}
__device__ __forceinline__ float row_sum16(float v) {
    v += dppf(v, 0); v += dppf(v, 1); v += dppf(v, 2); v += dppf(v, 3);
    return v;
}
__device__ __forceinline__ float wave_sum(float v) {
    v = row_sum16(v);
    v += __int_as_float(__builtin_amdgcn_ds_swizzle(__float_as_int(v), 0x401F));
    return __int_as_float(__builtin_amdgcn_readlane(__float_as_int(v), 0)) + __int_as_float(__builtin_amdgcn_readlane(__float_as_int(v), 32));
}
__device__ __forceinline__ float xor32(float v, int lane) {
    return __int_as_float(__builtin_amdgcn_ds_bpermute((lane ^ 32) << 2, __float_as_int(v)));
}
__device__ __forceinline__ void grid_bar(unsigned* cnt, const unsigned target, const int wv) {
    asm volatile("s_waitcnt vmcnt(0)" ::: "memory");
    __syncthreads();
    if (wv == 0) {
        const int l = opaque_tid(0);
        if (l == 0) {
            __builtin_amdgcn_fence(__ATOMIC_RELEASE, "agent");
            asm volatile("s_waitcnt vmcnt(0)" ::: "memory");
            __hip_atomic_fetch_add(cnt, 1u, __ATOMIC_RELAXED, __HIP_MEMORY_SCOPE_AGENT);
            while (__hip_atomic_load(cnt, __ATOMIC_RELAXED, __HIP_MEMORY_SCOPE_AGENT) < target) __builtin_amdgcn_s_sleep(2);
            __builtin_amdgcn_fence(__ATOMIC_ACQUIRE, "agent");
            asm volatile("s_waitcnt vmcnt(0)" ::: "memory");
        }
    }
    __syncthreads();
}
__device__ __forceinline__ float fexp(float x) { return __builtin_amdgcn_exp2f(x * 1.4426950408889634f); }
__device__ __forceinline__ float frcp(float x) { return __builtin_amdgcn_rcpf(x); }
__device__ __forceinline__ float fsqrt(float x) { return __builtin_amdgcn_sqrtf(x); }
__device__ __forceinline__ float frsq(float x) { return __builtin_amdgcn_rsqf(x); }
__device__ __forceinline__ float sigmoidf_(float x) { return frcp(1.f + fexp(-x)); }
__device__ __forceinline__ float gelu_tanh(float x) {
    const float y2 = 1.5957691216057308f * (x + 0.044715f * x * x * x);
    return x * frcp(1.f + fexp(-y2));
}
__device__ __forceinline__ int tok_pos(int g) { return g < NTP ? (g & 2047) : (g & 16383); }
__device__ __forceinline__ void tile_seq(int blk, int& c, int& nc) {
    if (blk < 512) { c = blk & 15; nc = 16; } else { c = (blk - 512) & 127; nc = 128; }
}
__device__ __forceinline__ float dot2bf(unsigned a, unsigned b, float acc) {
    return __builtin_amdgcn_fdot2_f32_bf16(__builtin_bit_cast(bf16x2v, a), __builtin_bit_cast(bf16x2v, b), acc, false);
}

namespace pg8 {
#define PG8_LAS __attribute__((address_space(3)))
typedef short bf16x8 __attribute__((ext_vector_type(8)));
typedef float f32x4 __attribute__((ext_vector_type(4)));
constexpr int BM = 256, BK = 64, HALF = 128, HTB = HALF * BK * 2, STAGE_BYTES = 8 * HTB, NXCD = 8, WGM = 8;
__device__ __forceinline__ int lds_byte(int r, int c) { const int st = (r >> 4) * 2 + (c >> 5), rr = r & 15, cc = c & 31, ob = rr * 64 + cc * 2; return st * 1024 + (ob ^ (((ob >> 9) & 1) << 5)); }
__device__ __forceinline__ void stage_rc(int b, int& R, int& C) { const int st = b / 1024, sb = b % 1024, swz = sb ^ (((sb >> 9) & 1) << 5); R = (st >> 1) * 16 + swz / 64; C = (st & 1) * 32 + (swz % 64) / 2; }
__device__ __forceinline__ int perm32(int rho) { const int n = rho >> 4, i = rho & 15; return 8 * (i >> 2) + 4 * n + (i & 3); }
struct Unit { int pm, pn; };
struct Gemm { const bf16_t* A; const bf16_t* Bt; int M, N, K; };
struct StaticOrder {
    int nM, nN, nwg, G, c;
    __device__ void init(int M, int N, int G_, int c_) { nM = M / BM; nN = N / BM; nwg = nM * nN; G = G_; c = c_; }
    __device__ bool next(int i, Unit& u) const {
        const long L = (long)i * G + c; if (L >= nwg) return false;
        int wgid = (int)L; { const int q = nwg / NXCD, r = nwg % NXCD, xcd = wgid % NXCD, off = wgid / NXCD; wgid = (xcd < r ? xcd * (q + 1) : r * (q + 1) + (xcd - r) * q) + off; }
        const int nig = WGM * nN, gid = wgid / nig, fm = gid * WGM, gsz = (nM - fm) < WGM ? (nM - fm) : WGM;
        u.pm = fm + ((wgid % nig) % gsz); u.pn = (wgid % nig) / gsz; return true;
    }
    __device__ __forceinline__ void a_ready(const Unit&) const {}
    __device__ __forceinline__ void done(const Unit&) const {}
};
template <class Epi, class Sched, bool STAMP = false>
__device__ __forceinline__ void gemm_phase(PG8_LAS unsigned char* lds, const Gemm g, const Sched& S, const Epi& E, unsigned long long* stamps, const int wv) {
    const int tid = opaque_tid(wv), wid = wv, lane = tid & 63, wr = wid >> 2, wc = wid & 3, fr = lane & 15, fq = lane >> 4;
    const int K = g.K, nt = K / BK;
    int ts_lo = 0, ts_hi = 0, nts = 0; const unsigned long long rt_entry = STAMP ? (unsigned long long)wall_clock64() : 0ull;
#define PG8_STAMP() do { if (STAMP && wid == 0 && nts < 64) { const unsigned long long _c = (unsigned long long)clock64(); \
        ts_lo = (lane == nts) ? (int)(unsigned)_c : ts_lo; ts_hi = (lane == nts) ? (int)(unsigned)(_c >> 32) : ts_hi; ++nts; } } while (0)
    PG8_STAMP();
    unsigned voffA[2], voffB[2];
#pragma unroll
    for (int i = 0; i < 2; ++i) { int R, C; stage_rc(tid * 16 + i * 8192, R, C); const int Rb = Epi::PERM ? ((R & ~31) + perm32(R & 31)) : R;
        voffA[i] = (unsigned)(R * K + C) * 2u; voffB[i] = (unsigned)(Rb * K + C) * 2u; }
    const size_t kstep = (size_t)(BK * 2);
    const size_t hstep = (size_t)HALF * K * 2;
    const size_t tstep = 2 * hstep;
    const unsigned ldsw = (unsigned)wid * 1024u;
    const int aoff = lds_byte(wr * 64 + fr, fq * 8), boff = lds_byte(wc * 32 + fr, fq * 8);
#define PG8_SA(b, h) (((b) * 2 + (h)) * HTB)
#define PG8_SB(b, h) ((4 + (b) * 2 + (h)) * HTB)
#define PG8_STAGE(bufoff, gbase, voff) do { _Pragma("unroll") for (int _i = 0; _i < 2; ++_i) \
        __builtin_amdgcn_global_load_lds((const unsigned*)((const char*)(gbase) + (voff)[_i]), (PG8_LAS unsigned*)(lds + (bufoff) + ldsw + _i * 8192), 16, 0, 0); } while (0)
#define PG8_LDA(dst, b, h) do { _Pragma("unroll") for (int m = 0; m < 4; ++m) _Pragma("unroll") for (int k = 0; k < 2; ++k) dst[m][k] = *(const PG8_LAS bf16x8*)(lds + PG8_SA(b, h) + aoff + m * 2048 + k * 1024); } while (0)
#define PG8_LDB(dst, b, h) do { _Pragma("unroll") for (int n = 0; n < 2; ++n) _Pragma("unroll") for (int k = 0; k < 2; ++k) dst[n][k] = *(const PG8_LAS bf16x8*)(lds + PG8_SB(b, h) + boff + n * 2048 + k * 1024); } while (0)
#define PG8_MMA(ai, bj, At, Bt) do { __builtin_amdgcn_s_setprio(1); _Pragma("unroll") for (int m = 0; m < 4; ++m) _Pragma("unroll") for (int n = 0; n < 2; ++n) _Pragma("unroll") for (int k = 0; k < 2; ++k) \
        acc[ai][bj][m][n] = __builtin_amdgcn_mfma_f32_16x16x32_bf16(Bt[n][k], At[m][k], acc[ai][bj][m][n], 0, 0, 0); __builtin_amdgcn_s_setprio(0); } while (0)
#define PG8_WAIT_V(n) asm volatile("s_waitcnt vmcnt(" #n ")" ::: "memory")
#define PG8_WAIT_L(n) asm volatile("s_waitcnt lgkmcnt(" #n ")" ::: "memory")
#define PG8_BAR __builtin_amdgcn_s_barrier()
#define PG8_SCHED __builtin_amdgcn_sched_barrier(0)
    Unit cur, nxt; int ui = 0;
    if (!S.next(0, cur)) return;
    f32x4 acc[2][2][4][2];
#pragma unroll
    for (int a = 0; a < 2; ++a)
#pragma unroll
        for (int b = 0; b < 2; ++b)
#pragma unroll
            for (int m = 0; m < 4; ++m)
#pragma unroll
                for (int n = 0; n < 2; ++n) acc[a][b][m][n] = (f32x4){0.f, 0.f, 0.f, 0.f};
    bf16x8 At[4][2], B0[2][2], B1[2][2];
    const char* cA = (const char*)g.A + (size_t)cur.pm * tstep; const char* cB = (const char*)g.Bt + (size_t)cur.pn * tstep;
    S.a_ready(cur);
    PG8_STAGE(PG8_SB(0, 0), cB, voffB); PG8_STAGE(PG8_SA(0, 0), cA, voffA); PG8_STAGE(PG8_SB(0, 1), cB + hstep, voffB); PG8_STAGE(PG8_SA(0, 1), cA + hstep, voffA);
    if (wr == 1) PG8_BAR;
    PG8_WAIT_V(4); PG8_BAR;
    PG8_STAGE(PG8_SB(1, 0), cB + kstep, voffB); PG8_STAGE(PG8_SA(1, 0), cA + kstep, voffA); PG8_STAGE(PG8_SB(1, 1), cB + hstep + kstep, voffB);
    PG8_WAIT_V(6); PG8_BAR;
    PG8_STAMP();
    for (;;) {
        const bool has_next = S.next(ui + 1, nxt);
        const char* nA = has_next ? (const char*)g.A + (size_t)nxt.pm * tstep : cA; const char* nB = has_next ? (const char*)g.Bt + (size_t)nxt.pn * tstep : cB;
        for (int t = 0; t < nt; t += 2) {
            const bool last = (t == nt - 2);
            const char* a1 = cA + (size_t)(t + 1) * kstep;
            const char* a2 = last ? nA : cA + (size_t)(t + 2) * kstep; const char* b2 = last ? nB : cB + (size_t)(t + 2) * kstep;
            const char* a3 = a2 + kstep; const char* b3 = b2 + kstep;
            if (last && has_next) S.a_ready(nxt);
            PG8_LDB(B0, 0, 0); PG8_SCHED; PG8_LDA(At, 0, 0); PG8_STAGE(PG8_SA(1, 1), a1 + hstep, voffA);
            PG8_WAIT_L(8); PG8_BAR; PG8_WAIT_L(0); PG8_MMA(0, 0, At, B0); PG8_BAR; PG8_SCHED;
            PG8_LDB(B1, 0, 1); PG8_STAGE(PG8_SB(0, 0), b2, voffB);
            PG8_BAR; PG8_WAIT_L(0); PG8_MMA(0, 1, At, B1); PG8_BAR;
            PG8_LDA(At, 0, 1); PG8_STAGE(PG8_SA(0, 0), a2, voffA);
            PG8_BAR; PG8_WAIT_L(0); PG8_MMA(1, 0, At, B0); PG8_BAR; PG8_SCHED;
            PG8_STAGE(PG8_SB(0, 1), b2 + hstep, voffB);
            PG8_WAIT_V(6); PG8_BAR; PG8_MMA(1, 1, At, B1); PG8_BAR;
            PG8_LDB(B0, 1, 0); PG8_SCHED; PG8_LDA(At, 1, 0); PG8_STAGE(PG8_SA(0, 1), a2 + hstep, voffA);
            PG8_WAIT_L(8); PG8_BAR; PG8_WAIT_L(0); PG8_MMA(0, 0, At, B0); PG8_BAR; PG8_SCHED;
            PG8_LDB(B1, 1, 1); PG8_STAGE(PG8_SB(1, 0), b3, voffB);
            PG8_BAR; PG8_WAIT_L(0); PG8_MMA(0, 1, At, B1); PG8_BAR;
            PG8_LDA(At, 1, 1); PG8_STAGE(PG8_SA(1, 0), a3, voffA);
            PG8_BAR; PG8_WAIT_L(0); PG8_MMA(1, 0, At, B0); PG8_BAR; PG8_SCHED;
            PG8_STAGE(PG8_SB(1, 1), b3 + hstep, voffB);
            PG8_WAIT_V(6); PG8_BAR; PG8_MMA(1, 1, At, B1); PG8_BAR;
        }
        PG8_STAMP();
        if constexpr (!Epi::AFTER_DRAIN) { E(acc, cur, wr, wc, fr, fq); S.done(cur); }
        PG8_STAMP();
        if (!has_next) break;
#pragma unroll
        for (int a = 0; a < 2; ++a)
#pragma unroll
            for (int b = 0; b < 2; ++b)
#pragma unroll
                for (int m = 0; m < 4; ++m)
#pragma unroll
                    for (int n = 0; n < 2; ++n) acc[a][b][m][n] = (f32x4){0.f, 0.f, 0.f, 0.f};
        cur = nxt; cA = nA; cB = nB; ++ui;
    }
    PG8_WAIT_V(0);
    if (wr == 0) PG8_BAR;
    PG8_BAR;
    if constexpr (Epi::AFTER_DRAIN) { E.fused(acc, cur, wr, wc, fr, fq, lds, wid, lane); S.done(cur); }
    PG8_STAMP();
    if (STAMP && wid == 0) { stamps[lane] = lane < nts ? (((unsigned long long)(unsigned)ts_hi << 32) | (unsigned)ts_lo) : 0ull;
        if (lane == 62) stamps[62] = rt_entry; if (lane == 63) stamps[63] = (unsigned long long)wall_clock64(); }
#undef PG8_STAMP
#undef PG8_SA
#undef PG8_SB
#undef PG8_STAGE
#undef PG8_LDA
#undef PG8_LDB
#undef PG8_MMA
#undef PG8_WAIT_V
#undef PG8_WAIT_L
#undef PG8_BAR
#undef PG8_SCHED
}
__device__ __forceinline__ void pin_pre(const float& v) { asm volatile("" ::"v"(v)); }
__device__ __forceinline__ void pin_pre(const int&) {}
__device__ __forceinline__ void pin_pre(const uint4& v) { asm volatile("" ::"v"(v.x), "v"(v.y), "v"(v.z), "v"(v.w)); }
struct Pre2u4 { uint4 a, b; };
struct Pre2x4 { f32x4 a, b; };
__device__ __forceinline__ void pin_pre(const Pre2x4& v) { asm volatile("" ::"v"(v.a), "v"(v.b)); }
__device__ __forceinline__ void pin_pre(const Pre2u4& v) { pin_pre(v.a); pin_pre(v.b); }
template <class L, class A, int NB> struct EpiFn {
    static constexpr bool PERM = true, AFTER_DRAIN = false;
    L ld; A ap;
    __device__ __forceinline__ void operator()(const f32x4 (&acc)[2][2][4][2], const Unit& u, int wr, int wc, int fr, int fq) const {
        const int row0 = u.pm * BM + wr * 64 + fr, col0 = u.pn * BM + wc * 32 + 8 * fq;
        constexpr int PER = 16 / NB;
#pragma unroll
        for (int b = 0; b < NB; ++b) {
            decltype(ld(0, 0)) pre[PER];
#pragma unroll
            for (int k = 0; k < PER; ++k) {
                const int idx = b * PER + k, ai = idx >> 3, m = (idx >> 1) & 3, bj = idx & 1;
                pre[k] = ld(row0 + ai * HALF + m * 16, col0 + bj * HALF);
            }
#pragma unroll
            for (int k = 0; k < PER; ++k) pin_pre(pre[k]);
#pragma unroll
            for (int k = 0; k < PER; ++k) {
                const int idx = b * PER + k, ai = idx >> 3, m = (idx >> 1) & 3, bj = idx & 1;
                ap(row0 + ai * HALF + m * 16, col0 + bj * HALF, acc[ai][bj][m][0], acc[ai][bj][m][1], pre[k]);
            }
        }
    }
};
}

template <int NB, class L, class A>
__device__ __forceinline__ void gemm_run(const bf16_t* Am, const bf16_t* Bt, int N, int K, char* shm, const int wv, L ld, A ap) {
    pg8::Gemm g{Am, Bt, NT, N, K};
    pg8::StaticOrder S; S.init(NT, N, (int)gridDim.x, (int)blockIdx.x);
    pg8::EpiFn<L, A, NB> E{ld, ap};
    __syncthreads();
    pg8::gemm_phase<pg8::EpiFn<L, A, NB>, pg8::StaticOrder, false>((PG8_LAS unsigned char*)shm, g, S, E, nullptr, wv);
    __syncthreads();
}

template <class NMap, class Scale>
__device__ __forceinline__ void prep_wT(const float* __restrict__ src, bf16_t* __restrict__ dst, int K, int N, int gtid, int gstride,
                                        NMap nmap, Scale scale) {
    const int items = N * (K / 8);
    for (int it = gtid; it < items; it += gstride) {
        const int n = it % N, k0 = (it / N) * 8;
        const int ns = nmap(n);
        float v[8];
#pragma unroll
        for (int i = 0; i < 8; ++i) v[i] = src[(size_t)(k0 + i) * N + ns] * scale(k0 + i);
        uint4 o; o.x = pk2(v[0], v[1]); o.y = pk2(v[2], v[3]); o.z = pk2(v[4], v[5]); o.w = pk2(v[6], v[7]);
        *(uint4*)(dst + (size_t)n * K + k0) = o;
    }
}

__device__ __forceinline__ void phase_prep(const P& p, const int wv) {
    const int gtid = blockIdx.x * NTHREADS + opaque_tid(wv), gstride = gridDim.x * NTHREADS;
    const int lane = gtid & 63, gw = gtid >> 6, nw = gstride >> 6;
    char* ws = p.ws;
    {
        const float* g = p.mix_g;
        prep_wT(p.w_in, (bf16_t*)(ws + OFF_WIN), 1024, 1792, gtid, gstride,
                [](int n) { if (n >= 640) return n; int pp = n & 63; return (n & ~63) + (pp >> 3) * 4 + (pp & 3) + ((pp >> 2) & 1) * 32; },
                [g](int k) { return g[k]; });
    }
    {
        const float *ga = p.attn_g, *gl = p.lru_g;
        prep_wT(p.w_out, (bf16_t*)(ws + OFF_WOUT), 1024, 1024, gtid, gstride, [](int n) { return n; },
                [ga, gl](int k) { return k < 512 ? ga[k] : gl[k - 512]; });
    }
    {
        const float* g = p.ffn_g;
        prep_wT(p.peer_wq, (bf16_t*)(ws + OFF_WQ), 1024, 2048, gtid, gstride, [](int n) { return n; }, [g](int k) { return g[k]; });
    }
    {
        const float* g = p.ple_g;
        prep_wT(p.ple_wg, (bf16_t*)(ws + OFF_WG), 1024, 1024, gtid, gstride, [](int n) { return n; }, [g](int k) { return g[k]; });
    }
    prep_wT(p.ple_wp, (bf16_t*)(ws + OFF_WP), 256, 1024, gtid, gstride, [](int n) { return n; }, [](int) { return 1.f; });
    {
        bf16_t* kb = (bf16_t*)(ws + OFF_KEYS);
        for (int i = gtid; i < 16 * 128 * 128 / 2; i += gstride) {
            float2 v = ((const float2*)p.peer_keys)[i];
            ((unsigned*)kb)[i] = pk2(v.x, v.y);
        }
    }
    {
        bf16_t* lw = (bf16_t*)(ws + OFF_LW);
        for (int i = gtid; i < 2 * 2 * 8 * 64 * 64; i += gstride) {
            const int e = i & 7, ln = (i >> 3) & 63, ks = (i >> 9) & 3, cb = (i >> 11) & 1, h = (i >> 12) & 7, mat = (i >> 15) & 1, dir = (i >> 16) & 1;
            const int tl = ln & 31, hf = ln >> 5;
            const int j = cb * 32 + tl;
            const int ii = 16 * ks + 8 * (e >> 2) + 4 * hf + (e & 3);
            const float* srcw = mat ? p.lru_wx : p.lru_wa;
            const float v = srcw[(((size_t)dir * 8 + h) * 64 + ii) * 64 + j];
            lw[i] = (bf16_t)(pk2(v, 0.f) & 0xffff);
        }
        float* ls = (float*)(ws + OFF_LS);
        for (int i = gtid; i < 1024; i += gstride) {
            const float lam = p.lru_lam[i];
            ls[i] = lam >= 0.f ? -log1pf(expf(-lam)) : lam - log1pf(expf(lam));
        }
    }
    {
        const float* g = p.ffn_g;
        const float4* us = (const float4*)p.peer_u;
        const float4* vs = (const float4*)p.peer_v;
        uint4* ud = (uint4*)(ws + OFF_UT);
        uint4* vd = (uint4*)(ws + OFF_VT);
        for (int i = gtid; i < 16384 * 64; i += gstride) {
            unsigned uo[4], vo[4];
#pragma unroll
            for (int q = 0; q < 4; ++q) {
                const float4 u = us[(size_t)i * 4 + q], v = vs[(size_t)i * 4 + q];
                const float4 gg = ((const float4*)g)[(i * 4 + q) & 255];
                int a = __builtin_amdgcn_cvt_pk_fp8_f32(u.x * gg.x * 64.f, u.y * gg.y * 64.f, 0, false);
                a = __builtin_amdgcn_cvt_pk_fp8_f32(u.z * gg.z * 64.f, u.w * gg.w * 64.f, a, true);
                int b = __builtin_amdgcn_cvt_pk_fp8_f32(v.x * 8.f, v.y * 8.f, 0, false);
                b = __builtin_amdgcn_cvt_pk_fp8_f32(v.z * 8.f, v.w * 8.f, b, true);
                uo[q] = (unsigned)a; vo[q] = (unsigned)b;
            }
            const int e_ = i >> 6, c16 = i & 63;
            const size_t di = ((size_t)(c16 >> 3) * 16384 + e_) * 8 + (c16 & 7);
            ud[di] = make_uint4(uo[0], uo[1], uo[2], uo[3]);
            vd[di] = make_uint4(vo[0], vo[1], vo[2], vo[3]);
        }
    }
    {
        uint2* pd = (uint2*)(ws + OFF_PB);
        for (int i = gtid; i < NT * 64; i += gstride) {
            const float4 v = i < NTP * 64 ? ((const float4*)p.p_p)[i] : ((const float4*)p.p_s)[i - NTP * 64];
            uint2 a; a.x = pk2(v.x, v.y); a.y = pk2(v.z, v.w);
            pd[i] = a;
        }
    }
    {
        bf16_t* xb = (bf16_t*)(ws + OFF_XB);
        float* rs1 = (float*)(ws + OFF_RS1);
        for (int tok0 = gw; tok0 < NT; tok0 += 2 * nw) {
            float4 v[2][4];
            bool act[2];
#pragma unroll
            for (int t = 0; t < 2; ++t) {
                const int tok = tok0 + t * nw;
                act[t] = tok < NT;
                const int tk = act[t] ? tok : tok0;
                const float4* xr = (const float4*)(tk < NTP ? p.x_p + (size_t)tk * 1024 : p.x_s + (size_t)(tk - NTP) * 1024);
#pragma unroll
                for (int j = 0; j < 4; ++j) v[t][j] = xr[lane + 64 * j];
            }
#pragma unroll
            for (int t = 0; t < 2; ++t) {
                const int tok = tok0 + t * nw;
                if (!act[t]) continue;
                float s = 0.f;
                uint2* od = (uint2*)(xb + (size_t)tok * 1024);
#pragma unroll
                for (int j = 0; j < 4; ++j) {
                    const float4 q = v[t][j];
                    s += q.x * q.x + q.y * q.y + q.z * q.z + q.w * q.w;
                    uint2 a; a.x = pk2(q.x, q.y); a.y = pk2(q.z, q.w);
                    od[lane + 64 * j] = a;
                }
                s = wave_sum(s);
                if (lane == 0) rs1[tok] = frsq(s * (1.f / 1024.f) + EPS);
            }
        }
    }
}

__device__ __forceinline__ void phase_inproj(const P& p, char* shm, const int wv) {
    char* ws = p.ws;
    const bf16_t* XB = (const bf16_t*)(ws + OFF_XB);
    const bf16_t* W = (const bf16_t*)(ws + OFF_WIN);
    const float* RS1 = (const float*)(ws + OFF_RS1);
    bf16_t* Q = (bf16_t*)(ws + OFF_Q);
    bf16_t* KB = (bf16_t*)(ws + OFF_KB);
    bf16_t* VB = (bf16_t*)(ws + OFF_VB);
    bf16_t* XR = (bf16_t*)(ws + OFF_XR);
    bf16_t* GR = (bf16_t*)(ws + OFF_GR);
    auto ld = [=](int row, int col) { return RS1[row]; };
    auto epi = [=](int row, int col, f32x4 v0, f32x4 v1, float rs) {
        v0 *= rs; v1 *= rs;
        if (col < 640) {
            const int pos = tok_pos(row);
            const int d0 = ((col & 63) >> 3) * 4;
            f32x4 o0, o1;
#pragma unroll
            for (int j = 0; j < 4; ++j) {
                const float invf = exp2f(-(float)(d0 + j) * 0.41524101186092029f);
                const float ang = (float)pos * invf;
                const float nrev = rintf(ang * 0.15915494309189535f);
                float rr = fmaf(-nrev, 6.28125f, ang);
                rr = fmaf(-nrev, 0.0019353071795864769f, rr);
                const float cs = __cosf(rr), sn = __sinf(rr);
                o0[j] = v0[j] * cs - v1[j] * sn;
                o1[j] = v1[j] * cs + v0[j] * sn;
            }
            if (col < 512) {
                o0 *= 0.125f; o1 *= 0.125f;
                bf16_t* dst = Q + (size_t)row * 512 + (col & ~63) + d0;
                st4bf(dst, o0); st4bf(dst + 32, o1);
            } else {
                bf16_t* dst = KB + (size_t)row * 128 + ((col - 512) & ~63) + d0;
                st4bf(dst, o0); st4bf(dst + 32, o1);
            }
        } else if (col < 768) {
            st8bf(VB + (size_t)row * 128 + (col - 640), v0, v1);
        } else if (col < 1280) {
            st8bf(XR + (size_t)row * 512 + (col - 768), v0, v1);
        } else {
            bf16_t* dst = GR + (size_t)row * 512 + (col - 1280);
            f32x4 g0, g1;
#pragma unroll
            for (int j = 0; j < 4; ++j) { g0[j] = gelu_tanh(v0[j]); g1[j] = gelu_tanh(v1[j]); }
            st8bf(dst, g0, g1);
        }
    };
    gemm_run<1>(XB, W, 1792, 1024, shm, wv, ld, epi);
}

__device__ __forceinline__ void attn_unit(const P& p, char* shm, int unit, const int wv) {
    char* ws = p.ws;
    const int blk = unit >> 1, kvh = unit & 1;
    int c, nc; tile_seq(blk, c, nc);
    const int g0 = blk * 128;
    bf16_t* Ks = (bf16_t*)shm;
    bf16_t* Vt = (bf16_t*)(shm + 55296);
    const bf16_t* KB = (const bf16_t*)(ws + OFF_KB);
    const bf16_t* VB = (const bf16_t*)(ws + OFF_VB);
    const bf16_t* Q = (const bf16_t*)(ws + OFF_Q);
    bf16_t* AT = (bf16_t*)(ws + OFF_AT);
    const int tid = opaque_tid(wv), w = tid >> 6, lane = tid & 63, half = lane >> 5, tl = lane & 31;
    __syncthreads();
    for (int item = tid; item < 384 * 8; item += NTHREADS) {
        const int key = item % 384, part = item / 384;
        const int ch = key >> 7;
        if ((ch == 0 && c == 0) || (ch == 2 && c == nc - 1)) continue;
        const size_t tok = (size_t)(g0 - 128 + key);
        const uint4 kv = *(const uint4*)(KB + tok * 128 + kvh * 64 + part * 8);
        *(uint4*)(Ks + key * 72 + part * 8) = kv;
        const uint4 vv = *(const uint4*)(VB + tok * 128 + kvh * 64 + part * 8);
        bf16_t* vd = Vt + (part * 8) * 388 + key;
        vd[0 * 388] = (bf16_t)(vv.x & 0xffff); vd[1 * 388] = (bf16_t)(vv.x >> 16);
        vd[2 * 388] = (bf16_t)(vv.y & 0xffff); vd[3 * 388] = (bf16_t)(vv.y >> 16);
        vd[4 * 388] = (bf16_t)(vv.z & 0xffff); vd[5 * 388] = (bf16_t)(vv.z >> 16);
        vd[6 * 388] = (bf16_t)(vv.w & 0xffff); vd[7 * 388] = (bf16_t)(vv.w >> 16);
    }
    __syncthreads();
    for (int it = 0; it < 2; ++it) {
        const int task = w + 8 * it;
        const int qhl = task & 3, rg = task >> 2;
        const int hq = kvh * 4 + qhl;
        const int qrow = rg * 32 + tl;
        const bf16_t* qp = Q + (size_t)(g0 + qrow) * 512 + hq * 64 + half * 8;
        bf16x8 qf[4];
#pragma unroll
        for (int ks = 0; ks < 4; ++ks) qf[ks] = *(const bf16x8*)(qp + ks * 16);
        float m = p.sink[hq];
        float l = half == 0 ? 1.f : 0.f;
        f32x16 O0, O1;
#pragma unroll
        for (int i = 0; i < 16; ++i) { O0[i] = 0.f; O1[i] = 0.f; }
        for (int ch = 0; ch < 3; ++ch) {
            if ((ch == 0 && c == 0) || (ch == 2 && c == nc - 1)) continue;
            f32x16 S[4];
#pragma unroll
            for (int kb = 0; kb < 4; ++kb) {
#pragma unroll
                for (int i = 0; i < 16; ++i) S[kb][i] = 0.f;
#pragma unroll
                for (int ks = 0; ks < 4; ++ks) {
                    const bf16x8 kf = *(const bf16x8*)(Ks + (ch * 128 + kb * 32 + tl) * 72 + ks * 16 + half * 8);
                    S[kb] = __builtin_amdgcn_mfma_f32_32x32x16_bf16(kf, qf[ks], S[kb], 0, 0, 0);
                }
            }
            float mx = -INFINITY;
#pragma unroll
            for (int kb = 0; kb < 4; ++kb)
#pragma unroll
                for (int i = 0; i < 16; ++i) {
                    const int kk = kb * 32 + 8 * (i >> 2) + 4 * half + (i & 3);
                    const bool valid = (ch == 1) || (ch == 0 ? kk >= qrow : kk <= qrow);
                    const float s = valid ? S[kb][i] : -INFINITY;
                    S[kb][i] = s;
                    mx = fmaxf(mx, s);
                }
            mx = fmaxf(mx, xor32(mx, lane));
            const float mn = fmaxf(m, mx);
            const float alpha = fexp(m - mn);
            m = mn;
            float ps = 0.f;
#pragma unroll
            for (int kb = 0; kb < 4; ++kb)
#pragma unroll
                for (int i = 0; i < 16; ++i) {
                    const float pv = fexp(S[kb][i] - mn);
                    S[kb][i] = pv;
                    ps += pv;
                }
            l = l * alpha + ps;
#pragma unroll
            for (int i = 0; i < 16; ++i) { O0[i] *= alpha; O1[i] *= alpha; }
#pragma unroll
            for (int kb = 0; kb < 4; ++kb)
#pragma unroll
                for (int s2 = 0; s2 < 2; ++s2) {
                    uint4 pw;
                    pw.x = pk2(S[kb][8 * s2 + 0], S[kb][8 * s2 + 1]); pw.y = pk2(S[kb][8 * s2 + 2], S[kb][8 * s2 + 3]);
                    pw.z = pk2(S[kb][8 * s2 + 4], S[kb][8 * s2 + 5]); pw.w = pk2(S[kb][8 * s2 + 6], S[kb][8 * s2 + 7]);
                    const bf16x8 pf = __builtin_bit_cast(bf16x8, pw);
                    const bf16_t* vp = Vt + tl * 388 + ch * 128 + kb * 32 + 16 * s2 + 4 * half;
                    uint4 vw;
                    uint2 a0 = *(const uint2*)vp, a1 = *(const uint2*)(vp + 8);
                    vw.x = a0.x; vw.y = a0.y; vw.z = a1.x; vw.w = a1.y;
                    O0 = __builtin_amdgcn_mfma_f32_32x32x16_bf16(__builtin_bit_cast(bf16x8, vw), pf, O0, 0, 0, 0);
                    const bf16_t* vp1 = vp + 32 * 388;
                    a0 = *(const uint2*)vp1; a1 = *(const uint2*)(vp1 + 8);
                    vw.x = a0.x; vw.y = a0.y; vw.z = a1.x; vw.w = a1.y;
                    O1 = __builtin_amdgcn_mfma_f32_32x32x16_bf16(__builtin_bit_cast(bf16x8, vw), pf, O1, 0, 0, 0);
                }
        }
        const float lt = l + xor32(l, lane);
        const float inv = frcp(lt);
        bf16_t* op = AT + (size_t)(g0 + qrow) * 512 + hq * 64 + 4 * half;
#pragma unroll
        for (int i4 = 0; i4 < 4; ++i4) {
            f32x4 a, b;
#pragma unroll
            for (int q = 0; q < 4; ++q) { a[q] = O0[4 * i4 + q] * inv; b[q] = O1[4 * i4 + q] * inv; }
            st4bf(op + 8 * i4, a);
            st4bf(op + 32 + 8 * i4, b);
        }
    }
}

#define WAVE_LDS_FENCE() asm volatile("s_waitcnt lgkmcnt(0)" ::: "memory")
template <bool FINAL>
__device__ __forceinline__ void lru_unit(const P& p, char* shm, int blk, const int wv) {
    char* ws = p.ws;
    int c, nc; tile_seq(blk, c, nc);
    const int g0 = blk * 128;
    const int seq_lo = g0 - c * 128, seq_hi = seq_lo + nc * 128;
    const int tid = opaque_tid(wv), w = wv, lane = tid & 63, half = lane >> 5, tl = lane & 31;
    float* abuf = (float*)shm + w * (2 * 32 * 68);
    float* ubuf = abuf + 32 * 68;
    bf16_t* xt = (bf16_t*)abuf;
    float* ssq = (float*)(shm + 139264);
    const bf16_t* XR = (const bf16_t*)(ws + OFF_XR);
    const bf16_t* GR = (const bf16_t*)(ws + OFF_GR);
    const bf16_t* LW = (const bf16_t*)(ws + OFF_LW);
    const float* LS = (const float*)(ws + OFF_LS);
    float* AGG = (float*)(ws + OFF_AGG);
    bf16_t* HF = (bf16_t*)(ws + OFF_HF);
    bf16_t* MRG = (bf16_t*)(ws + OFF_MRG);
    const int chn = w * 64 + lane;
    __syncthreads();

    for (int dir = 0; dir < 2; ++dir) {
        float h = 0.f, Ap = 1.f;
        if (FINAL) {
            if (dir == 0) {
#pragma unroll 8
                for (int cc = 0; cc < c; ++cc) {
                    const int tile = blk - c + cc;
                    const float A_ = AGG[(size_t)(tile * 2 + 0) * 1024 + chn], H_ = AGG[(size_t)(tile * 2 + 0) * 1024 + 512 + chn];
                    h = A_ * h + H_;
                }
            } else {
#pragma unroll 8
                for (int cc = nc - 1; cc > c; --cc) {
                    const int tile = blk - c + cc;
                    const float A_ = AGG[(size_t)(tile * 2 + 1) * 1024 + chn], H_ = AGG[(size_t)(tile * 2 + 1) * 1024 + 512 + chn];
                    h = A_ * h + H_;
                }
            }
        }
        uint4 xpre[5];
#define LRU_LOAD_X(tbase) do { _Pragma("unroll") for (int i = 0; i < 5; ++i) { \
                const int tt_ = (tbase) - 2 + (lane >> 3) + 8 * i; \
                xpre[i] = make_uint4(0u, 0u, 0u, 0u); \
                if (tt_ >= seq_lo && tt_ < seq_hi) xpre[i] = *(const uint4*)(XR + (size_t)tt_ * 512 + w * 64 + (lane & 7) * 8); } } while (0)
        if (!FINAL) LRU_LOAD_X(g0 + (dir ? 3 : 0) * 32);
        for (int ibi = 0; ibi < 4; ++ibi) {
            const int ib = dir ? 3 - ibi : ibi;
            const int t0 = g0 + ib * 32;
            if (FINAL) LRU_LOAD_X(t0);
            WAVE_LDS_FENCE();
#pragma unroll
            for (int i = 0; i < 5; ++i) {
                const int rowi = (lane >> 3) + 8 * i;
                uint2* d = (uint2*)(xt + rowi * 68 + (lane & 7) * 8);
                d[0] = make_uint2(xpre[i].x, xpre[i].y); d[1] = make_uint2(xpre[i].z, xpre[i].w);
            }
            if (!FINAL && ibi < 3) LRU_LOAD_X(g0 + (dir ? 2 - ibi : ibi + 1) * 32);
            WAVE_LDS_FENCE();
            float xcv[4][8];
#pragma unroll
            for (int ks = 0; ks < 4; ++ks)
#pragma unroll
                for (int grp = 0; grp < 2; ++grp) {
                    const int cl = 16 * ks + 8 * grp + 4 * half;
                    const int cb4 = w * 64 + cl;
                    f32x4 a = *(const f32x4*)(p.conv_b + cb4);
#pragma unroll
                    for (int j = 0; j < 4; ++j) {
                        const f32x4 xv = ld4bf(xt + (tl + j) * 68 + cl);
                        const f32x4 wv4 = *(const f32x4*)(p.conv_w + j * 512 + cb4);
                        a += wv4 * xv;
                    }
#pragma unroll
                    for (int q = 0; q < 4; ++q) xcv[ks][grp * 4 + q] = a[q];
                }
            bf16x8 xb[4];
#pragma unroll
            for (int ks = 0; ks < 4; ++ks) {
                uint4 pw;
                pw.x = pk2(xcv[ks][0], xcv[ks][1]); pw.y = pk2(xcv[ks][2], xcv[ks][3]);
                pw.z = pk2(xcv[ks][4], xcv[ks][5]); pw.w = pk2(xcv[ks][6], xcv[ks][7]);
                xb[ks] = __builtin_bit_cast(bf16x8, pw);
            }
            WAVE_LDS_FENCE();
#pragma unroll
            for (int cb = 0; cb < 2; ++cb) {
                f32x16 aa, ax;
#pragma unroll
                for (int i = 0; i < 16; ++i) { aa[i] = 0.f; ax[i] = 0.f; }
#pragma unroll
                for (int ks = 0; ks < 4; ++ks) {
                    const bf16x8 wa = *(const bf16x8*)(LW + ((size_t)((((dir * 2 + 0) * 8 + w) * 2 + cb) * 4 + ks) * 64 + lane) * 8);
                    const bf16x8 wx = *(const bf16x8*)(LW + ((size_t)((((dir * 2 + 1) * 8 + w) * 2 + cb) * 4 + ks) * 64 + lane) * 8);
                    aa = __builtin_amdgcn_mfma_f32_32x32x16_bf16(wa, xb[ks], aa, 0, 0, 0);
                    ax = __builtin_amdgcn_mfma_f32_32x32x16_bf16(wx, xb[ks], ax, 0, 0, 0);
                }
#pragma unroll
                for (int r4 = 0; r4 < 4; ++r4) {
                    const int j0 = cb * 32 + 8 * r4 + 4 * half;
                    const int ch4 = w * 64 + j0;
                    const f32x4 ba4 = *(const f32x4*)(p.lru_ba + dir * 512 + ch4);
                    const f32x4 bx4 = *(const f32x4*)(p.lru_bx + dir * 512 + ch4);
                    const f32x4 ls4 = *(const f32x4*)(LS + dir * 512 + ch4);
                    f32x4 av, uv;
#pragma unroll
                    for (int q = 0; q < 4; ++q) {
                        const int r = 4 * r4 + q;
                        const float xcval = xcv[2 * cb + (r4 >> 1)][4 * (r4 & 1) + q];
                        const float rgate = sigmoidf_(aa[r] + ba4[q]);
                        const float igate = sigmoidf_(ax[r] + bx4[q]);
                        const float la = 8.f * rgate * ls4[q];
                        av[q] = fexp(la);
                        uv[q] = fsqrt(fmaxf(0.f, 1.f - av[q] * av[q])) * igate * xcval;
                    }
                    *(f32x4*)(abuf + tl * 68 + j0) = av;
                    *(f32x4*)(ubuf + tl * 68 + j0) = uv;
                }
            }
            WAVE_LDS_FENCE();
            float val[32];
#pragma unroll
            for (int tt = 0; tt < 32; ++tt) {
                const int tloc = dir ? 31 - tt : tt;
                const float a = abuf[tloc * 68 + lane], u = ubuf[tloc * 68 + lane];
                h = a * h + u;
                Ap *= a;
                if (FINAL) {
                    const size_t off = (size_t)(t0 + tloc) * 512 + chn;
                    if (dir == 0) {
                        HF[off] = (bf16_t)(pk2(h, 0.f) & 0xffff);
                    } else {
                        const float hf = bf1(HF[off]);
                        const float gg = bf1(GR[off]);
                        const float v = gg * (hf + h);
                        val[tt] = v;
                        abuf[tloc * 68 + lane] = v;
                    }
                }
            }
            if (FINAL && dir == 1) {
                WAVE_LDS_FENCE();
                {
                    float s = 0.f;
#pragma unroll
                    for (int q = 0; q < 8; ++q) {
                        const f32x4 v4 = *(const f32x4*)(abuf + tl * 68 + half * 32 + q * 4);
                        s += v4[0] * v4[0] + v4[1] * v4[1] + v4[2] * v4[2] + v4[3] * v4[3];
                    }
                    ssq[(w * 2 + half) * 32 + tl] = s;
                }
                __syncthreads();
                if (tid < 32) {
                    float sacc = 0.f;
#pragma unroll
                    for (int q = 0; q < 16; ++q) sacc += ssq[q * 32 + tid];
                    ssq[512 + tid] = frsq(sacc * (1.f / 512.f) + EPS);
                }
                __syncthreads();
#pragma unroll
                for (int tt = 0; tt < 32; ++tt) {
                    const int tloc = 31 - tt;
                    const float rs = ssq[512 + tloc];
                    MRG[(size_t)(t0 + tloc) * 1024 + 512 + chn] = (bf16_t)(pk2(val[tt] * rs, 0.f) & 0xffff);
                }
                __syncthreads();
            }
        }
        if (!FINAL) {
            AGG[(size_t)(blk * 2 + dir) * 1024 + chn] = Ap;
            AGG[(size_t)(blk * 2 + dir) * 1024 + 512 + chn] = h;
        }
    }
}

__device__ __forceinline__ void lru_agg_unit(const P& p, char* shm, int blk, const int wv) {
    char* ws = p.ws;
    int c, nc; tile_seq(blk, c, nc);
    const int g0 = blk * 128;
    const int seq_lo = g0 - c * 128, seq_hi = seq_lo + nc * 128;
    const int tid = opaque_tid(wv), w = wv, lane = tid & 63, half = lane >> 5, tl = lane & 31;
    float* abuf = (float*)shm + w * (2 * 32 * 68);
    float* ubuf = abuf + 32 * 68;
    bf16_t* xt = (bf16_t*)abuf;
    const bf16_t* XR = (const bf16_t*)(ws + OFF_XR);
    const bf16_t* LW = (const bf16_t*)(ws + OFF_LW);
    const float* LS = (const float*)(ws + OFF_LS);
    float* AGG = (float*)(ws + OFF_AGG);
    const int chn = w * 64 + lane;
    __syncthreads();
    float hF = 0.f, ApF = 1.f, HcB = 0.f, AcB = 1.f;
    uint4 xpre[5];
#define LRUA_LOAD_X(tbase) do { _Pragma("unroll") for (int i = 0; i < 5; ++i) { \
            const int tt_ = (tbase) - 2 + (lane >> 3) + 8 * i; \
            xpre[i] = make_uint4(0u, 0u, 0u, 0u); \
            if (tt_ >= seq_lo && tt_ < seq_hi) xpre[i] = *(const uint4*)(XR + (size_t)tt_ * 512 + w * 64 + (lane & 7) * 8); } } while (0)
    LRUA_LOAD_X(g0);
    for (int ib = 0; ib < 4; ++ib) {
        WAVE_LDS_FENCE();
#pragma unroll
        for (int i = 0; i < 5; ++i) {
            const int rowi = (lane >> 3) + 8 * i;
            uint2* d = (uint2*)(xt + rowi * 68 + (lane & 7) * 8);
            d[0] = make_uint2(xpre[i].x, xpre[i].y); d[1] = make_uint2(xpre[i].z, xpre[i].w);
        }
        if (ib < 3) LRUA_LOAD_X(g0 + (ib + 1) * 32);
        WAVE_LDS_FENCE();
        float xcv[4][8];
#pragma unroll
        for (int ks = 0; ks < 4; ++ks)
#pragma unroll
            for (int grp = 0; grp < 2; ++grp) {
                const int cl = 16 * ks + 8 * grp + 4 * half;
                const int cb4 = w * 64 + cl;
                f32x4 a = *(const f32x4*)(p.conv_b + cb4);
#pragma unroll
                for (int j = 0; j < 4; ++j) {
                    const f32x4 xv = ld4bf(xt + (tl + j) * 68 + cl);
                    const f32x4 wv4 = *(const f32x4*)(p.conv_w + j * 512 + cb4);
                    a += wv4 * xv;
                }
#pragma unroll
                for (int q = 0; q < 4; ++q) xcv[ks][grp * 4 + q] = a[q];
            }
        bf16x8 xb[4];
#pragma unroll
        for (int ks = 0; ks < 4; ++ks) {
            uint4 pw;
            pw.x = pk2(xcv[ks][0], xcv[ks][1]); pw.y = pk2(xcv[ks][2], xcv[ks][3]);
            pw.z = pk2(xcv[ks][4], xcv[ks][5]); pw.w = pk2(xcv[ks][6], xcv[ks][7]);
            xb[ks] = __builtin_bit_cast(bf16x8, pw);
        }
        for (int dir = 0; dir < 2; ++dir) {
            WAVE_LDS_FENCE();
#pragma unroll
            for (int cb = 0; cb < 2; ++cb) {
                f32x16 aa, ax;
#pragma unroll
                for (int i = 0; i < 16; ++i) { aa[i] = 0.f; ax[i] = 0.f; }
#pragma unroll
                for (int ks = 0; ks < 4; ++ks) {
                    const bf16x8 wa = *(const bf16x8*)(LW + ((size_t)((((dir * 2 + 0) * 8 + w) * 2 + cb) * 4 + ks) * 64 + lane) * 8);
                    const bf16x8 wx = *(const bf16x8*)(LW + ((size_t)((((dir * 2 + 1) * 8 + w) * 2 + cb) * 4 + ks) * 64 + lane) * 8);
                    aa = __builtin_amdgcn_mfma_f32_32x32x16_bf16(wa, xb[ks], aa, 0, 0, 0);
                    ax = __builtin_amdgcn_mfma_f32_32x32x16_bf16(wx, xb[ks], ax, 0, 0, 0);
                }
#pragma unroll
                for (int r4 = 0; r4 < 4; ++r4) {
                    const int j0 = cb * 32 + 8 * r4 + 4 * half;
                    const int ch4 = w * 64 + j0;
                    const f32x4 ba4 = *(const f32x4*)(p.lru_ba + dir * 512 + ch4);
                    const f32x4 bx4 = *(const f32x4*)(p.lru_bx + dir * 512 + ch4);
                    const f32x4 ls4 = *(const f32x4*)(LS + dir * 512 + ch4);
                    f32x4 av, uv;
#pragma unroll
                    for (int q = 0; q < 4; ++q) {
                        const int r = 4 * r4 + q;
                        const float xcval = xcv[2 * cb + (r4 >> 1)][4 * (r4 & 1) + q];
                        const float rgate = sigmoidf_(aa[r] + ba4[q]);
                        const float igate = sigmoidf_(ax[r] + bx4[q]);
                        const float la = 8.f * rgate * ls4[q];
                        av[q] = fexp(la);
                        uv[q] = fsqrt(fmaxf(0.f, 1.f - av[q] * av[q])) * igate * xcval;
                    }
                    *(f32x4*)(abuf + tl * 68 + j0) = av;
                    *(f32x4*)(ubuf + tl * 68 + j0) = uv;
                }
            }
            WAVE_LDS_FENCE();
            if (dir == 0) {
#pragma unroll
                for (int tt = 0; tt < 32; ++tt) {
                    const float a = abuf[tt * 68 + lane], u = ubuf[tt * 68 + lane];
                    hF = a * hF + u;
                    ApF *= a;
                }
            } else {
                float hb = 0.f, ab = 1.f;
#pragma unroll
                for (int tt = 0; tt < 32; ++tt) {
                    const float a = abuf[(31 - tt) * 68 + lane], u = ubuf[(31 - tt) * 68 + lane];
                    hb = a * hb + u;
                    ab *= a;
                }
                HcB += AcB * hb;
                AcB *= ab;
                float* AGGB = (float*)(ws + OFF_AGGB);
                AGGB[(size_t)((blk * 4 + ib) * 2 + 0) * 512 + chn] = ab;
                AGGB[(size_t)((blk * 4 + ib) * 2 + 1) * 512 + chn] = hb;
            }
        }
    }
#undef LRUA_LOAD_X
    AGG[(size_t)(blk * 2 + 0) * 1024 + chn] = ApF;
    AGG[(size_t)(blk * 2 + 0) * 1024 + 512 + chn] = hF;
    AGG[(size_t)(blk * 2 + 1) * 1024 + chn] = AcB;
    AGG[(size_t)(blk * 2 + 1) * 1024 + 512 + chn] = HcB;
}

__device__ __forceinline__ void lru_final_unit(const P& p, char* shm, int blk, const int wv) {
    char* ws = p.ws;
    int c, nc; tile_seq(blk, c, nc);
    const int g0 = blk * 128;
    const int seq_lo = g0 - c * 128, seq_hi = seq_lo + nc * 128;
    const int tid = opaque_tid(wv), w = wv, lane = tid & 63, half = lane >> 5, tl = lane & 31;
    float* abuf = (float*)shm + w * (2 * 32 * 68);
    float* ubuf = abuf + 32 * 68;
    bf16_t* xt = (bf16_t*)abuf;
    float* ssq = (float*)(shm + 139264);
    const bf16_t* XR = (const bf16_t*)(ws + OFF_XR);
    const bf16_t* GR = (const bf16_t*)(ws + OFF_GR);
    const bf16_t* LW = (const bf16_t*)(ws + OFF_LW);
    const float* LS = (const float*)(ws + OFF_LS);
    const float* AGG = (const float*)(ws + OFF_AGG);
    const float* AGGB = (const float*)(ws + OFF_AGGB);
    bf16_t* MRG = (bf16_t*)(ws + OFF_MRG);
    const int chn = w * 64 + lane;
    __syncthreads();
    float hF = 0.f, cT = 0.f;
#pragma unroll 8
    for (int cc = 0; cc < c; ++cc) {
        const int tile = blk - c + cc;
        const float A_ = AGG[(size_t)(tile * 2 + 0) * 1024 + chn], H_ = AGG[(size_t)(tile * 2 + 0) * 1024 + 512 + chn];
        hF = A_ * hF + H_;
    }
#pragma unroll 8
    for (int cc = nc - 1; cc > c; --cc) {
        const int tile = blk - c + cc;
        const float A_ = AGG[(size_t)(tile * 2 + 1) * 1024 + chn], H_ = AGG[(size_t)(tile * 2 + 1) * 1024 + 512 + chn];
        cT = A_ * cT + H_;
    }
    const float c3 = cT;
    const float c2 = AGGB[(size_t)((blk * 4 + 3) * 2 + 0) * 512 + chn] * c3 + AGGB[(size_t)((blk * 4 + 3) * 2 + 1) * 512 + chn];
    const float c1 = AGGB[(size_t)((blk * 4 + 2) * 2 + 0) * 512 + chn] * c2 + AGGB[(size_t)((blk * 4 + 2) * 2 + 1) * 512 + chn];
    const float c0 = AGGB[(size_t)((blk * 4 + 1) * 2 + 0) * 512 + chn] * c1 + AGGB[(size_t)((blk * 4 + 1) * 2 + 1) * 512 + chn];
    uint4 xpre[5];
#define LRUF_LOAD_X(tbase) do { _Pragma("unroll") for (int i = 0; i < 5; ++i) { \
            const int tt_ = (tbase) - 2 + (lane >> 3) + 8 * i; \
            xpre[i] = make_uint4(0u, 0u, 0u, 0u); \
            if (tt_ >= seq_lo && tt_ < seq_hi) xpre[i] = *(const uint4*)(XR + (size_t)tt_ * 512 + w * 64 + (lane & 7) * 8); } } while (0)
    for (int ib = 0; ib < 4; ++ib) {
        const int t0 = g0 + ib * 32;
        LRUF_LOAD_X(t0);
        WAVE_LDS_FENCE();
#pragma unroll
        for (int i = 0; i < 5; ++i) {
            const int rowi = (lane >> 3) + 8 * i;
            uint2* d = (uint2*)(xt + rowi * 68 + (lane & 7) * 8);
            d[0] = make_uint2(xpre[i].x, xpre[i].y); d[1] = make_uint2(xpre[i].z, xpre[i].w);
        }
        WAVE_LDS_FENCE();
        float xcv[4][8];
#pragma unroll
        for (int ks = 0; ks < 4; ++ks)
#pragma unroll
            for (int grp = 0; grp < 2; ++grp) {
                const int cl = 16 * ks + 8 * grp + 4 * half;
                const int cb4 = w * 64 + cl;
                f32x4 a = *(const f32x4*)(p.conv_b + cb4);
#pragma unroll
                for (int j = 0; j < 4; ++j) {
                    const f32x4 xv = ld4bf(xt + (tl + j) * 68 + cl);
                    const f32x4 wv4 = *(const f32x4*)(p.conv_w + j * 512 + cb4);
                    a += wv4 * xv;
                }
#pragma unroll
                for (int q = 0; q < 4; ++q) xcv[ks][grp * 4 + q] = a[q];
            }
        bf16x8 xb[4];
#pragma unroll
        for (int ks = 0; ks < 4; ++ks) {
            uint4 pw;
            pw.x = pk2(xcv[ks][0], xcv[ks][1]); pw.y = pk2(xcv[ks][2], xcv[ks][3]);
            pw.z = pk2(xcv[ks][4], xcv[ks][5]); pw.w = pk2(xcv[ks][6], xcv[ks][7]);
            xb[ks] = __builtin_bit_cast(bf16x8, pw);
        }
        unsigned hfp[16];
        for (int dir = 0; dir < 2; ++dir) {
            WAVE_LDS_FENCE();
#pragma unroll
            for (int cb = 0; cb < 2; ++cb) {
                f32x16 aa, ax;
#pragma unroll
                for (int i = 0; i < 16; ++i) { aa[i] = 0.f; ax[i] = 0.f; }
#pragma unroll
                for (int ks = 0; ks < 4; ++ks) {
                    const bf16x8 wa = *(const bf16x8*)(LW + ((size_t)((((dir * 2 + 0) * 8 + w) * 2 + cb) * 4 + ks) * 64 + lane) * 8);
                    const bf16x8 wx = *(const bf16x8*)(LW + ((size_t)((((dir * 2 + 1) * 8 + w) * 2 + cb) * 4 + ks) * 64 + lane) * 8);
                    aa = __builtin_amdgcn_mfma_f32_32x32x16_bf16(wa, xb[ks], aa, 0, 0, 0);
                    ax = __builtin_amdgcn_mfma_f32_32x32x16_bf16(wx, xb[ks], ax, 0, 0, 0);
                }
#pragma unroll
                for (int r4 = 0; r4 < 4; ++r4) {
                    const int j0 = cb * 32 + 8 * r4 + 4 * half;
                    const int ch4 = w * 64 + j0;
                    const f32x4 ba4 = *(const f32x4*)(p.lru_ba + dir * 512 + ch4);
                    const f32x4 bx4 = *(const f32x4*)(p.lru_bx + dir * 512 + ch4);
                    const f32x4 ls4 = *(const f32x4*)(LS + dir * 512 + ch4);
                    f32x4 av, uv;
#pragma unroll
                    for (int q = 0; q < 4; ++q) {
                        const int r = 4 * r4 + q;
                        const float xcval = xcv[2 * cb + (r4 >> 1)][4 * (r4 & 1) + q];
                        const float rgate = sigmoidf_(aa[r] + ba4[q]);
                        const float igate = sigmoidf_(ax[r] + bx4[q]);
                        const float la = 8.f * rgate * ls4[q];
                        av[q] = fexp(la);
                        uv[q] = fsqrt(fmaxf(0.f, 1.f - av[q] * av[q])) * igate * xcval;
                    }
                    *(f32x4*)(abuf + tl * 68 + j0) = av;
                    *(f32x4*)(ubuf + tl * 68 + j0) = uv;
                }
            }
            WAVE_LDS_FENCE();
            if (dir == 0) {
#pragma unroll
                for (int t2 = 0; t2 < 16; ++t2) {
                    const float a0 = abuf[(2 * t2) * 68 + lane], u0 = ubuf[(2 * t2) * 68 + lane];
                    const float a1 = abuf[(2 * t2 + 1) * 68 + lane], u1 = ubuf[(2 * t2 + 1) * 68 + lane];
                    const float h0 = a0 * hF + u0;
                    hF = a1 * h0 + u1;
                    hfp[t2] = pk2(h0, hF);
                }
            } else {
                float hb = ib == 3 ? c3 : (ib == 2 ? c2 : (ib == 1 ? c1 : c0));
#pragma unroll
                for (int tt = 0; tt < 32; ++tt) {
                    const int tloc = 31 - tt;
                    const float a = abuf[tloc * 68 + lane], u = ubuf[tloc * 68 + lane];
                    hb = a * hb + u;
                    const float gg = bf1(GR[(size_t)(t0 + tloc) * 512 + chn]);
                    const float hfw = (tloc & 1) ? bfhi(hfp[tloc >> 1]) : bflo(hfp[tloc >> 1]);
                    abuf[tloc * 68 + lane] = gg * (hfw + hb);
                }
            }
        }
        WAVE_LDS_FENCE();
        float* sqb = ssq + (ib & 1) * 544;
        {
            float s = 0.f;
#pragma unroll
            for (int q = 0; q < 8; ++q) {
                const f32x4 v4 = *(const f32x4*)(abuf + tl * 68 + half * 32 + q * 4);
                s += v4[0] * v4[0] + v4[1] * v4[1] + v4[2] * v4[2] + v4[3] * v4[3];
            }
            sqb[(w * 2 + half) * 32 + tl] = s;
        }
        __syncthreads();
        {
            float sacc = 0.f;
#pragma unroll
            for (int q = 0; q < 16; ++q) sacc += sqb[q * 32 + tl];
            float* rsw = ssq + 1088 + w * 32;
            if (half == 0) rsw[tl] = frsq(sacc * (1.f / 512.f) + EPS);
            WAVE_LDS_FENCE();
#pragma unroll
            for (int tt = 0; tt < 32; ++tt)
                MRG[(size_t)(t0 + tt) * 1024 + 512 + chn] = (bf16_t)(pk2(abuf[tt * 68 + lane] * rsw[tt], 0.f) & 0xffff);
        }
    }
#undef LRUF_LOAD_X
}

__device__ __forceinline__ void score_unit(const P& p, char* shm, int unit, const int wv) {
    char* ws = p.ws;
    const int sp = unit & 15, tg = unit >> 4;
    const int tid = opaque_tid(wv), w = tid >> 6, lane = tid & 63, fr = lane & 15, fq = lane >> 4;
    bf16_t* KL = (bf16_t*)shm;
    const bf16_t* KEYS = (const bf16_t*)(ws + OFF_KEYS) + (size_t)sp * 16384;
    const bf16_t* QP = (const bf16_t*)(ws + OFF_QP);
    float* SUBS = (float*)(ws + OFF_SUBS);
    __syncthreads();
    for (int i = tid; i < 2048; i += NTHREADS) {
        const int r = i >> 4, cpart = i & 15;
        *(uint4*)(KL + r * 136 + cpart * 8) = *(const uint4*)(KEYS + r * 128 + cpart * 8);
    }
    __syncthreads();
    for (int tt = 0; tt < 8; ++tt) {
        const int gb = (tg * 8 + tt) * 128 + w * 16;
        bf16x8 af[4];
#pragma unroll
        for (int ks = 0; ks < 4; ++ks) af[ks] = *(const bf16x8*)(QP + (size_t)(gb + fr) * 2048 + sp * 128 + ks * 32 + fq * 8);
        float v[4][8];
#pragma unroll
        for (int nb = 0; nb < 8; ++nb) {
            f32x4 acc = {0.f, 0.f, 0.f, 0.f};
#pragma unroll
            for (int ks = 0; ks < 4; ++ks) {
                const bf16x8 bf = *(const bf16x8*)(KL + (nb * 16 + fr) * 136 + ks * 32 + fq * 8);
                acc = __builtin_amdgcn_mfma_f32_16x16x32_bf16(af[ks], bf, acc, 0, 0, 0);
            }
#pragma unroll
            for (int i = 0; i < 4; ++i) v[i][nb] = __uint_as_float((__float_as_uint(acc[i]) & ~127u) | (unsigned)(nb * 16 + fr));
        }
#define CE_(a, b) do { const float hi_ = fmaxf(v[i][a], v[i][b]); const float lo_ = fminf(v[i][a], v[i][b]); v[i][a] = hi_; v[i][b] = lo_; } while (0)
#pragma unroll
        for (int i = 0; i < 4; ++i) {
            CE_(0, 1); CE_(2, 3); CE_(4, 5); CE_(6, 7);
            CE_(0, 2); CE_(1, 3); CE_(4, 6); CE_(5, 7);
            CE_(1, 2); CE_(5, 6);
            CE_(0, 4); CE_(1, 5); CE_(2, 6); CE_(3, 7);
            CE_(2, 4); CE_(3, 5);
            CE_(1, 2); CE_(3, 4); CE_(5, 6);
        }
#undef CE_
        float keep[4] = {0.f, 0.f, 0.f, 0.f};
        for (int r = 0; r < 16; ++r) {
#pragma unroll
            for (int i = 0; i < 4; ++i) {
                const float rm = row_max16(v[i][0]);
                keep[i] = (fr == r) ? rm : keep[i];
                const bool win = v[i][0] == rm;
#pragma unroll
                for (int nb = 0; nb < 7; ++nb) v[i][nb] = win ? v[i][nb + 1] : v[i][nb];
                v[i][7] = win ? -INFINITY : v[i][7];
            }
        }
#pragma unroll
        for (int i = 0; i < 4; ++i) SUBS[(size_t)(gb + 4 * fq + i) * 256 + sp * 16 + fr] = keep[i];
    }
}

__device__ __forceinline__ void phase_stage2(const P& p, const int wv) {
    char* ws = p.ws;
    const float* SUBS = (const float*)(ws + OFF_SUBS);
    int* PIDX = (int*)(ws + OFF_PIDX);
    float* PS = (float*)(ws + OFF_PS);
    const int gtid = blockIdx.x * NTHREADS + opaque_tid(wv), gstride = gridDim.x * NTHREADS;
    for (int idx = gtid; idx < NT * 8; idx += gstride) {
        const int tok = idx >> 3, hh = idx & 7;
        const float* s0p = SUBS + (size_t)tok * 256 + hh * 32;
        const float* s1p = s0p + 16;
        float s0[16], s1[16];
#pragma unroll
        for (int i = 0; i < 4; ++i) {
            const f32x4 a = *(const f32x4*)(s0p + 4 * i), b = *(const f32x4*)(s1p + 4 * i);
#pragma unroll
            for (int q = 0; q < 4; ++q) { s0[4 * i + q] = a[q]; s1[4 * i + q] = b[q]; }
        }
        float L[16];
#pragma unroll
        for (int i = 0; i < 16; ++i) L[i] = -INFINITY;
#pragma unroll
        for (int a = 0; a < 16; ++a)
#pragma unroll
            for (int b = 0; b < 16; ++b) {
                if ((a + 1) * (b + 1) <= 16) {
                    float nv = __uint_as_float((__float_as_uint(s0[a] + s1[b]) & ~255u) | (unsigned)(a * 16 + b));
#pragma unroll
                    for (int i = 0; i < 16; ++i) {
                        const float hi = fmaxf(L[i], nv);
                        nv = fminf(L[i], nv);
                        L[i] = hi;
                    }
                }
            }
        int ids[16];
#pragma unroll
        for (int k = 0; k < 16; ++k) {
            const unsigned code = __float_as_uint(L[k]) & 255u;
            const unsigned i0 = __float_as_uint(s0p[code >> 4]) & 127u;
            const unsigned i1 = __float_as_uint(s1p[code & 15]) & 127u;
            ids[k] = (int)(i0 * 128 + i1);
        }
        int* pi = PIDX + (size_t)tok * 128;
        f32x4* pf = (f32x4*)(PS + (size_t)tok * 128 + hh * 16);
#pragma unroll
        for (int k = 0; k < 16; ++k) pi[k * 8 + hh] = ids[k];
#pragma unroll
        for (int i = 0; i < 4; ++i) pf[i] = f32x4{L[4 * i], L[4 * i + 1], L[4 * i + 2], L[4 * i + 3]};
    }
}

__device__ __forceinline__ void unpack8(const uint4 w, float* f) {
    f[0] = bflo(w.x); f[1] = bfhi(w.x); f[2] = bflo(w.y); f[3] = bfhi(w.y);
    f[4] = bflo(w.z); f[5] = bfhi(w.z); f[6] = bflo(w.w); f[7] = bfhi(w.w);
}
__device__ __forceinline__ unsigned xcc_id() { return (unsigned)__builtin_amdgcn_s_getreg((3 << 11) | 20) & 0xFu; }
__device__ __forceinline__ float dpp_ror8(float v) {
    return __int_as_float(__builtin_amdgcn_update_dpp(0, __float_as_int(v), 0x128, 0xf, 0xf, true));
}
__device__ __forceinline__ float swz_x4(float v) { return __int_as_float(__builtin_amdgcn_ds_swizzle(__float_as_int(v), 0x101F)); }
__device__ __forceinline__ float swz_x16(float v) { return __int_as_float(__builtin_amdgcn_ds_swizzle(__float_as_int(v), 0x401F)); }

__device__ __forceinline__ void gather_item_a(const P& p, const int s, const int chunk, const int w, const int lane) {
    char* ws = p.ws;
    const bf16_t* H1B = (const bf16_t*)(ws + OFF_H1B);
    const int* PIDX = (const int*)(ws + OFF_PIDX);
    bf16_t* PART = (bf16_t*)(ws + OFF_PART);
    const int i8 = lane & 7, gq = lane >> 3;
    const unsigned char* UT = (const unsigned char*)(ws + OFF_UT) + (size_t)s * (16384 * 128) + i8 * 16;
    const bool b0 = (lane & 1) != 0, b1 = (lane & 2) != 0, b2 = (lane & 4) != 0;
    const int tok0 = chunk * 64 + w * 8;
    int4 idA[4], idB[4];
    uint4 UU[2][8], XQ[2][2];
#define LD_IDS(di, tk) do { const int4* ip_ = (const int4*)(PIDX + (size_t)(tk) * 128 + gq * 16); \
        _Pragma("unroll") for (int q_ = 0; q_ < 4; ++q_) di[q_] = ip_[q_]; } while (0)
#define LD_X(buf, tk) do { const uint4* hp_ = (const uint4*)(H1B + (size_t)(tk) * 1024 + s * 128 + i8 * 16); XQ[buf][0] = hp_[0]; XQ[buf][1] = hp_[1]; } while (0)
#define LD_U(buf, ia, ib) do { const int e_[8] = {ia.x, ia.y, ia.z, ia.w, ib.x, ib.y, ib.z, ib.w}; \
        _Pragma("unroll") for (int g_ = 0; g_ < 8; ++g_) UU[buf][g_] = *(const uint4*)(UT + ((size_t)e_[g_] << 7)); } while (0)
    LD_IDS(idA, tok0);
    LD_X(0, tok0);
    LD_U(0, idA[0], idA[1]);
    LD_IDS(idB, tok0 + 1);
#pragma unroll
    for (int j = 0; j < 8; ++j) {
        const int tok = tok0 + j;
        LD_U(1, idA[2], idA[3]);
        if (j < 7) LD_X((j + 1) & 1, tok + 1);
        __builtin_amdgcn_sched_barrier(0);
        float xs[16];
        unpack8(XQ[j & 1][0], xs); unpack8(XQ[j & 1][1], xs + 8);
        float d[16];
#pragma unroll
        for (int hf = 0; hf < 2; ++hf) {
            if (hf == 1) {
                if (j < 7) LD_U(0, idB[0], idB[1]);
                __builtin_amdgcn_sched_barrier(0);
            }
#pragma unroll
            for (int g = 0; g < 8; ++g) {
                const uint4 u4 = UU[hf][g];
                const unsigned wd[4] = {u4.x, u4.y, u4.z, u4.w};
                f32x2 d2 = {0.f, 0.f}, d3 = {0.f, 0.f};
#pragma unroll
                for (int q = 0; q < 4; ++q) {
                    const f32x2 lo = __builtin_amdgcn_cvt_pk_f32_fp8((int)wd[q], false);
                    const f32x2 hi = __builtin_amdgcn_cvt_pk_f32_fp8((int)wd[q], true);
                    const f32x2 xlo = {xs[q * 4 + 0], xs[q * 4 + 1]};
                    const f32x2 xhi = {xs[q * 4 + 2], xs[q * 4 + 3]};
                    d2 = lo * xlo + d2;
                    d3 = hi * xhi + d3;
                }
                d[hf * 8 + g] = (d2.x + d2.y) + (d3.x + d3.y);
            }
        }
        float t8[8], t4[4], t2[2];
#pragma unroll
        for (int q = 0; q < 8; ++q) {
            const float keep = b0 ? d[8 + q] : d[q], send = b0 ? d[q] : d[8 + q];
            t8[q] = keep + dppf(send, 0);
        }
#pragma unroll
        for (int q = 0; q < 4; ++q) {
            const float keep = b1 ? t8[4 + q] : t8[q], send = b1 ? t8[q] : t8[4 + q];
            t4[q] = keep + dppf(send, 1);
        }
#pragma unroll
        for (int q = 0; q < 2; ++q) {
            const float keep = b2 ? t4[2 + q] : t4[q], send = b2 ? t4[q] : t4[2 + q];
            t2[q] = keep + swz_x4(send);
        }
        const int itb = (b0 ? 8 : 0) + (b1 ? 4 : 0) + (b2 ? 2 : 0);
        *(unsigned*)(PART + ((size_t)tok * 8 + s) * 128 + gq * 16 + itb) = pk2(t2[0], t2[1]);
        if (j < 7) {
#pragma unroll
            for (int q = 0; q < 4; ++q) idA[q] = idB[q];
        }
        if (j < 6) LD_IDS(idB, tok + 2);
    }
#undef LD_IDS
#undef LD_X
#undef LD_U
}

__device__ __forceinline__ void gather_item_b(const P& p, const int s, const int chunk, const int w, const int lane) {
    char* ws = p.ws;
    const bf16_t* H1B = (const bf16_t*)(ws + OFF_H1B);
    const int* PIDX = (const int*)(ws + OFF_PIDX);
    const float* WGT = (const float*)(ws + OFF_WGT);
    bf16_t* H2B = (bf16_t*)(ws + OFF_H2B);
    float* SSQ3 = (float*)(ws + OFF_SSQ3);
    const int i8 = lane & 7, gq = lane >> 3;
    const unsigned char* VT = (const unsigned char*)(ws + OFF_VT) + (size_t)s * (16384 * 128) + i8 * 16;
    const bool b5 = (lane & 32) != 0, b4 = (lane & 16) != 0, b3 = (lane & 8) != 0;
    const int dloc = s * 128 + i8 * 16 + (b5 ? 8 : 0) + (b4 ? 4 : 0) + (b3 ? 2 : 0);
    const int tok0 = chunk * 64 + w * 8;
    int4 idA[4], idB[4];
    f32x4 wgA[4], wgB[4];
    uint4 VV[2][8];
#define LD_IW(di, dw, tk) do { const int4* ip_ = (const int4*)(PIDX + (size_t)(tk) * 128 + gq * 16); const f32x4* wp_ = (const f32x4*)(WGT + (size_t)(tk) * 128 + gq * 16); \
        _Pragma("unroll") for (int q_ = 0; q_ < 4; ++q_) { di[q_] = ip_[q_]; dw[q_] = wp_[q_]; } } while (0)
#define LD_V(buf, ia, ib) do { const int e_[8] = {ia.x, ia.y, ia.z, ia.w, ib.x, ib.y, ib.z, ib.w}; \
        _Pragma("unroll") for (int g_ = 0; g_ < 8; ++g_) VV[buf][g_] = *(const uint4*)(VT + ((size_t)e_[g_] << 7)); } while (0)
    LD_IW(idA, wgA, tok0);
    LD_V(0, idA[0], idA[1]);
    LD_IW(idB, wgB, tok0 + 1);
#pragma unroll
    for (int j = 0; j < 8; ++j) {
        const int tok = tok0 + j;
        LD_V(1, idA[2], idA[3]);
        const unsigned hw = *(const unsigned*)(H1B + (size_t)tok * 1024 + dloc);
        __builtin_amdgcn_sched_barrier(0);
        f32x2 acc[8];
#pragma unroll
        for (int q = 0; q < 8; ++q) acc[q] = f32x2{0.f, 0.f};
#pragma unroll
        for (int hf = 0; hf < 2; ++hf) {
            if (hf == 1) {
                if (j < 7) LD_V(0, idB[0], idB[1]);
                __builtin_amdgcn_sched_barrier(0);
            }
#pragma unroll
            for (int g = 0; g < 8; ++g) {
                const uint4 v4 = VV[hf][g];
                const unsigned wd[4] = {v4.x, v4.y, v4.z, v4.w};
                const float wsc = wgA[hf * 2 + (g >> 2)][g & 3];
                const f32x2 w2 = {wsc, wsc};
#pragma unroll
                for (int q = 0; q < 4; ++q) {
                    const f32x2 lo = __builtin_amdgcn_cvt_pk_f32_fp8((int)wd[q], false);
                    const f32x2 hi = __builtin_amdgcn_cvt_pk_f32_fp8((int)wd[q], true);
                    acc[2 * q] = lo * w2 + acc[2 * q];
                    acc[2 * q + 1] = hi * w2 + acc[2 * q + 1];
                }
            }
        }
        float a16[16];
#pragma unroll
        for (int q = 0; q < 8; ++q) { a16[2 * q] = acc[q].x; a16[2 * q + 1] = acc[q].y; }
        float t8[8], t4[4], t2[2];
#pragma unroll
        for (int q = 0; q < 8; ++q) {
            const float keep = b5 ? a16[8 + q] : a16[q], send = b5 ? a16[q] : a16[8 + q];
            t8[q] = keep + xor32(send, lane);
        }
#pragma unroll
        for (int q = 0; q < 4; ++q) {
            const float keep = b4 ? t8[4 + q] : t8[q], send = b4 ? t8[q] : t8[4 + q];
            t4[q] = keep + swz_x16(send);
        }
#pragma unroll
        for (int q = 0; q < 2; ++q) {
            const float keep = b3 ? t4[2 + q] : t4[q], send = b3 ? t4[q] : t4[2 + q];
            t2[q] = keep + dpp_ror8(send);
        }
        const float o0 = bflo(hw) + t2[0], o1 = bfhi(hw) + t2[1];
        *(unsigned*)(H2B + (size_t)tok * 1024 + dloc) = pk2(o0, o1);
        const float sq = wave_sum(o0 * o0 + o1 * o1);
        if (lane == 0) SSQ3[(size_t)tok * 8 + s] = sq;
        if (j < 7) {
#pragma unroll
            for (int q = 0; q < 4; ++q) { idA[q] = idB[q]; wgA[q] = wgB[q]; }
        }
        if (j < 6) LD_IW(idB, wgB, tok + 2);
    }
#undef LD_IW
#undef LD_V
}

template <int PASS>
__device__ __forceinline__ void phase_gather_sliced(const P& p, char* shm, const int wv) {
    const int tid = opaque_tid(wv), w = wv, lane = tid & 63;
    unsigned* q = (unsigned*)(p.ws + OFF_CTL) + 16 + PASS * 8;
    volatile int* sh = (volatile int*)(shm + 139392);
    const int home = (int)(xcc_id() & 7u);
    constexpr int NCH = NT / 64;
    for (int k = 0; k < 8; ++k) {
        const int s = (home + k) & 7;
        __syncthreads();
        if (tid == 0) sh[0] = (int)__hip_atomic_fetch_add(q + s, 1u, __ATOMIC_RELAXED, __HIP_MEMORY_SCOPE_AGENT);
        __syncthreads();
        int cur = sh[0];
        while (cur < NCH) {
            __syncthreads();
            if (tid == 0) sh[0] = (int)__hip_atomic_fetch_add(q + s, 1u, __ATOMIC_RELAXED, __HIP_MEMORY_SCOPE_AGENT);
            if (PASS == 0) gather_item_a(p, s, cur, w, lane); else gather_item_b(p, s, cur, w, lane);
            __syncthreads();
            cur = sh[0];
        }
    }
}

__device__ __forceinline__ void phase_gather_mid(const P& p, const int wv) {
    char* ws = p.ws;
    const int tid = opaque_tid(wv), w = wv, lane = tid & 63;
    const int gw = blockIdx.x * 8 + w, nw = gridDim.x * 8;
    const bf16_t* H1B = (const bf16_t*)(ws + OFF_H1B);
    const bf16_t* PART = (const bf16_t*)(ws + OFF_PART);
    const float* PS = (const float*)(ws + OFF_PS);
    float* WGT = (float*)(ws + OFF_WGT);
    for (int tok = gw; tok < NT; tok += nw) {
        const uint4* hp = (const uint4*)(H1B + (size_t)tok * 1024);
        float xf[16];
        unpack8(hp[lane], xf); unpack8(hp[64 + lane], xf + 8);
        float s = 0.f;
#pragma unroll
        for (int i = 0; i < 16; ++i) s += xf[i] * xf[i];
        s = wave_sum(s);
        const float rs2 = frsq(s * (1.f / 1024.f) + EPS);
        float wout[2];
        int pos[2];
#pragma unroll
        for (int hsel = 0; hsel < 2; ++hsel) {
            const int e = lane + 64 * hsel;
            const int ppos = (e & 15) * 8 + (e >> 4);
            float d = 0.f;
#pragma unroll
            for (int sl = 0; sl < 8; ++sl) d += bf1(PART[((size_t)tok * 8 + sl) * 128 + ppos]);
            const float sc = PS[(size_t)tok * 128 + e] * rs2;
            const float m = row_max16(sc);
            const float pe = fexp(sc - m);
            const float g = pe * frcp(row_sum16(pe));
            wout[hsel] = g * gelu_tanh(d * rs2 * (1.f / 64.f)) * 0.125f;
            pos[hsel] = ppos;
        }
        WGT[(size_t)tok * 128 + pos[0]] = wout[0];
        WGT[(size_t)tok * 128 + pos[1]] = wout[1];
    }
}

__global__ void __launch_bounds__(NTHREADS, 2) mega(P p) {
    extern __shared__ __attribute__((aligned(1024))) char shm[];
    cg::grid_group grid = cg::this_grid();
    char* ws = p.ws;
    const int wv = __builtin_amdgcn_readfirstlane((int)(threadIdx.x >> 6));
    const int w = wv;
    const int gw = blockIdx.x * 8 + w, nw = gridDim.x * 8;
    unsigned* bar_cnt = (unsigned*)(ws + OFF_CTL);

    phase_prep(p, wv);
    asm volatile("s_waitcnt vmcnt(0)" ::: "memory");
    __syncthreads();
    grid.sync();
    phase_inproj(p, shm, wv);
    grid_bar(bar_cnt, (unsigned)(1 * gridDim.x), wv);
    for (int rp = 0; rp < REP_MIX; ++rp)
    for (int u = blockIdx.x; u < 1536 + 768; u += gridDim.x) {
        if (u < 1536) attn_unit(p, shm, u, wv); else lru_agg_unit(p, shm, u - 1536, wv);
    }
    grid_bar(bar_cnt, (unsigned)(2 * gridDim.x), wv);
    for (int rp = 0; rp < REP_MIX; ++rp)
    for (int u = blockIdx.x; u < 768; u += gridDim.x) lru_final_unit(p, shm, u, wv);
    {
        const bf16_t* AT = (const bf16_t*)(ws + OFF_AT);
        bf16_t* MRG = (bf16_t*)(ws + OFF_MRG);
        const int lane = opaque_tid(wv) & 63;
        for (int tok = gw; tok < NT; tok += nw) {
            const uint4 a = ((const uint4*)(AT + (size_t)tok * 512))[lane];
            float f[8];
            unpack8(a, f);
            float s = 0.f;
#pragma unroll
            for (int i = 0; i < 8; ++i) s += f[i] * f[i];
            s = wave_sum(s);
            const float rs = frsq(s * (1.f / 512.f) + EPS);
            uint4 o;
            o.x = pk2(f[0] * rs, f[1] * rs); o.y = pk2(f[2] * rs, f[3] * rs); o.z = pk2(f[4] * rs, f[5] * rs); o.w = pk2(f[6] * rs, f[7] * rs);
            ((uint4*)(MRG + (size_t)tok * 1024))[lane] = o;
        }
    }
    grid_bar(bar_cnt, (unsigned)(3 * gridDim.x), wv);
    {
        const bf16_t* MRG = (const bf16_t*)(ws + OFF_MRG);
        const bf16_t* W = (const bf16_t*)(ws + OFF_WOUT);
        bf16_t* H1B = (bf16_t*)(ws + OFF_H1B);
        const bf16_t* XB = (const bf16_t*)(ws + OFF_XB);
        auto ld = [=](int row, int col) { return *(const uint4*)(XB + (size_t)row * 1024 + col); };
        auto epi = [=](int row, int col, f32x4 v0, f32x4 v1, uint4 xw) {
            f32x4 x0, x1;
            x0[0] = bflo(xw.x); x0[1] = bfhi(xw.x); x0[2] = bflo(xw.y); x0[3] = bfhi(xw.y);
            x1[0] = bflo(xw.z); x1[1] = bfhi(xw.z); x1[2] = bflo(xw.w); x1[3] = bfhi(xw.w);
            st8bf(H1B + (size_t)row * 1024 + col, v0 + x0, v1 + x1);
        };
        gemm_run<1>(MRG, W, 1024, 1024, shm, wv, ld, epi);
    }
    grid_bar(bar_cnt, (unsigned)(4 * gridDim.x), wv);
    {
        const bf16_t* H1B = (const bf16_t*)(ws + OFF_H1B);
        const bf16_t* W = (const bf16_t*)(ws + OFF_WQ);
        bf16_t* QP = (bf16_t*)(ws + OFF_QP);
        auto ld = [=](int row, int col) { return 0; };
        auto epi = [=](int row, int col, f32x4 v0, f32x4 v1, int) {
            st8bf(QP + (size_t)row * 2048 + col, v0, v1);
        };
        gemm_run<1>(H1B, W, 2048, 1024, shm, wv, ld, epi);
    }
    grid_bar(bar_cnt, (unsigned)(5 * gridDim.x), wv);
    for (int rp = 0; rp < REP_PEER; ++rp)
    for (int u = blockIdx.x; u < 1536; u += gridDim.x) score_unit(p, shm, u, wv);
    grid_bar(bar_cnt, (unsigned)(6 * gridDim.x), wv);
    phase_stage2(p, wv);
    grid_bar(bar_cnt, (unsigned)(7 * gridDim.x), wv);
    phase_gather_sliced<0>(p, shm, wv);
    grid_bar(bar_cnt, (unsigned)(8 * gridDim.x), wv);
    phase_gather_mid(p, wv);
    grid_bar(bar_cnt, (unsigned)(9 * gridDim.x), wv);
    phase_gather_sliced<1>(p, shm, wv);
    grid_bar(bar_cnt, (unsigned)(10 * gridDim.x), wv);
    {
        const bf16_t* H2B = (const bf16_t*)(ws + OFF_H2B);
        const bf16_t* WG = (const bf16_t*)(ws + OFF_WG);
        const bf16_t* PB = (const bf16_t*)(ws + OFF_PB);
        const bf16_t* WP = (const bf16_t*)(ws + OFF_WP);
        const float* SSQ3 = (const float*)(ws + OFF_SSQ3);
        bf16_t* G = (bf16_t*)(ws + OFF_G);
        bf16_t* H3 = (bf16_t*)(ws + OFF_H3);
        auto ld_g = [=](int row, int col) { return 0; };
        auto epi_g = [=](int row, int col, f32x4 v0, f32x4 v1, int) {
            pg8::Pre2x4 sp; sp.a = *(const f32x4*)(SSQ3 + (size_t)row * 8); sp.b = *(const f32x4*)(SSQ3 + (size_t)row * 8 + 4);
            const float ssq = ((sp.a[0] + sp.a[1]) + (sp.a[2] + sp.a[3])) + ((sp.b[0] + sp.b[1]) + (sp.b[2] + sp.b[3]));
            const float rs = frsq(ssq * (1.f / 1024.f) + EPS);
            f32x4 a, b;
#pragma unroll
            for (int j = 0; j < 4; ++j) { a[j] = sigmoidf_(v0[j] * rs); b[j] = sigmoidf_(v1[j] * rs); }
            st8bf(G + (size_t)row * 1024 + col, a, b);
        };
        auto ld_p = [=](int row, int col) {
            const size_t off = (size_t)row * 1024 + col;
            pg8::Pre2u4 r; r.a = *(const uint4*)(G + off); r.b = *(const uint4*)(H2B + off);
            return r;
        };
        auto epi_p = [=](int row, int col, f32x4 v0, f32x4 v1, pg8::Pre2u4 pr) {
            const size_t off = (size_t)row * 1024 + col;
            f32x4 g0, g1, h0, h1;
            g0[0] = bflo(pr.a.x); g0[1] = bfhi(pr.a.x); g0[2] = bflo(pr.a.y); g0[3] = bfhi(pr.a.y);
            g1[0] = bflo(pr.a.z); g1[1] = bfhi(pr.a.z); g1[2] = bflo(pr.a.w); g1[3] = bfhi(pr.a.w);
            h0[0] = bflo(pr.b.x); h0[1] = bfhi(pr.b.x); h0[2] = bflo(pr.b.y); h0[3] = bfhi(pr.b.y);
            h1[0] = bflo(pr.b.z); h1[1] = bfhi(pr.b.z); h1[2] = bflo(pr.b.w); h1[3] = bfhi(pr.b.w);
            st8bf(H3 + off, h0 + g0 * v0, h1 + g1 * v1);
        };
        gemm_run<1>(H2B, WG, 1024, 1024, shm, wv, ld_g, epi_g);
        gemm_run<2>(PB, WP, 1024, 256, shm, wv, ld_p, epi_p);
    }
    grid_bar(bar_cnt, (unsigned)(11 * gridDim.x), wv);
    {
        const bf16_t* H3 = (const bf16_t*)(ws + OFF_H3);
        const int lane = opaque_tid(wv) & 63;
        for (int tok = gw; tok < NT; tok += nw) {
            const uint2* hp = (const uint2*)(H3 + (size_t)tok * 1024);
            float f[16];
            float s = 0.f;
#pragma unroll
            for (int j = 0; j < 4; ++j) {
                const uint2 a = hp[lane + 64 * j];
                f[4 * j] = bflo(a.x); f[4 * j + 1] = bfhi(a.x); f[4 * j + 2] = bflo(a.y); f[4 * j + 3] = bfhi(a.y);
            }
#pragma unroll
            for (int i = 0; i < 16; ++i) s += f[i] * f[i];
            s = wave_sum(s);
            const float rs = frsq(s * (1.f / 1024.f) + EPS);
            float4* op = (float4*)(p.out + (size_t)tok * 1024);
#pragma unroll
            for (int j = 0; j < 4; ++j) {
                const float4 g = ((const float4*)p.fin_g)[lane + 64 * j];
                float4 o;
                o.x = f[4 * j] * rs * g.x; o.y = f[4 * j + 1] * rs * g.y; o.z = f[4 * j + 2] * rs * g.z; o.w = f[4 * j + 3] * rs * g.w;
                op[lane + 64 * j] = o;
            }
        }
    }
}

extern "C" void kernel_launch(void* const* d_in, const int* in_sizes, int n_in, void* d_out, int out_size, void* d_ws, size_t ws_size,
                              hipStream_t stream) {
    static int grid = 0;
    if (grid == 0) {
        if (n_in != 26 || ws_size < WS_END) {
            fprintf(stderr, "kernel_launch: unexpected n_in %d or ws_size %zu (< %zu)\n", n_in, ws_size, (size_t)WS_END);
            grid = -1;
            return;
        }
        int dev = 0, cus = 0, per_cu = 0;
        hipGetDevice(&dev);
        hipDeviceGetAttribute(&cus, hipDeviceAttributeMultiprocessorCount, dev);
        hipFuncSetAttribute((const void*)mega, hipFuncAttributeMaxDynamicSharedMemorySize, LDS_BYTES);
        hipOccupancyMaxActiveBlocksPerMultiprocessor(&per_cu, (const void*)mega, NTHREADS, LDS_BYTES);
        if (per_cu < 1) { fprintf(stderr, "kernel_launch: occupancy query says %d blocks/CU\n", per_cu); per_cu = 1; }
        grid = cus * 1;
        (void)hipGetLastError();
    }
    if (grid < 0) return;
    if (hipMemsetAsync((char*)d_ws + OFF_CTL, 0, 256, stream) != hipSuccess) fprintf(stderr, "kernel_launch: memset failed\n");
    P p{};
    const float** pp = (const float**)&p;
    for (int i = 0; i < 26; ++i) pp[i] = (const float*)d_in[i];
    p.out = (float*)d_out;
    p.ws = (char*)d_ws;
    void* args[] = {&p};
    hipError_t e = hipLaunchCooperativeKernel((const void*)mega, dim3(grid), dim3(NTHREADS), args, LDS_BYTES, stream);
    if (e != hipSuccess) fprintf(stderr, "cooperative launch failed: %s (grid %d)\n", hipGetErrorString(e), grid);
}
```
